# Optimizing an MI355X kernel written in HIP

```python
import math
import jax, jax.numpy as jnp
from jax import lax
import numpy as np

D_MODEL = 1024
BATCH = 8
SEQ = 8192
DEPTH = 2

GRID_W = 64
CTX_LEN = 256
EPS = 1e-6

DA_HEADS = 4
DA_HEAD_DIM = 64
DA_V_DIM = 2 * DA_HEAD_DIM
DA_QK_W = DA_HEADS * 2 * DA_HEAD_DIM
DA_V_W = DA_HEADS * DA_V_DIM
Q_BLOCK = 128
ROPE_BASE = 10000.0

SC_W = 512
SC_K = 3

FN_W = 512
FN_GROUPS = 4

POOL_WINDOWS = (2, 4, 8, 16)
POOL_W = 512
POOL_G = len(POOL_WINDOWS)
POOL_GW = POOL_W // POOL_G

N_BRANCH = 4
BRANCH_W = 512

COL_WIDTHS = (DA_QK_W, DA_QK_W, DA_V_W, SC_W, SC_W, SC_W, FN_W, POOL_W)
IN_W = sum(COL_WIDTHS)
COL_SPLITS = tuple(sum(COL_WIDTHS[:i + 1]) for i in range(len(COL_WIDTHS) - 1))
KV_LO = DA_QK_W
KV_HI = 2 * DA_QK_W + DA_V_W

N_EXPERTS = 32
TOP_K = 4
D_EXPERT = D_MODEL
SWIGLU_LIMIT = 7.0
SWIGLU_ALPHA = 1.702

kernel_name = "hybrid_parallel_diffusion_block"


def rmsnorm(x, g):
    xf = x.astype(jnp.float32)
    y = xf * lax.rsqrt(jnp.mean(xf * xf, axis=-1, keepdims=True) + EPS)
    return (y * g.astype(jnp.float32)).astype(x.dtype)


def adaln(cv, w, b):
    m = jax.nn.silu(cv) @ w + b
    return m.reshape(m.shape[:-1] + (6, w.shape[0]))


def modulate(h, shift, scale):
    return h * (1 + scale) + shift


def axial_rope(n):
    rows = n // GRID_W
    row = jnp.repeat(jnp.arange(rows), GRID_W).astype(jnp.float32)
    col = jnp.tile(jnp.arange(GRID_W), rows).astype(jnp.float32)
    half = DA_HEAD_DIM // 2
    inv = ROPE_BASE ** (-jnp.arange(0, half, 2, dtype=jnp.float32) / half)
    ar = row[:, None] * inv
    ac = col[:, None] * inv
    ang = jnp.concatenate([ar, ar, ac, ac], axis=-1)
    return jnp.cos(ang), jnp.sin(ang)


def apply_rope(x, cos, sin):
    x0, x1, x2, x3 = jnp.split(x, 4, axis=-1)
    rot = jnp.concatenate([-x1, x0, -x3, x2], axis=-1)
    return x * cos + rot * sin


def split_qk(t):
    b, n, _ = t.shape
    return t.reshape(b, n, DA_HEADS, 2, DA_HEAD_DIM).transpose(0, 2, 3, 1, 4)


def split_v(t):
    b, n, _ = t.shape
    return t.reshape(b, n, DA_HEADS, DA_V_DIM).transpose(0, 2, 1, 3)


def diff_lambda(lam, lam_init):
    lf = lam.astype(jnp.float32)
    return jnp.exp(jnp.sum(lf[0] * lf[1])) - jnp.exp(jnp.sum(lf[2] * lf[3])) + lam_init


def diff_attend(q, k, v, lam):
    s = jnp.einsum('bhiqd,bhikd->bhiqk', q, k).astype(jnp.float32) * (DA_HEAD_DIM ** -0.5)
    p = jax.nn.softmax(s, axis=-1)
    a = p[:, :, 0] - lam * p[:, :, 1]
    return jnp.einsum('bhqk,bhkv->bhqv', a.astype(v.dtype), v)


def latent_diff_attention(q, k_all, v_all, lam):
    b, h, _, s, d = q.shape
    nb = s // Q_BLOCK
    qb = q.reshape(b, h, 2, nb, Q_BLOCK, d).transpose(3, 0, 1, 2, 4, 5)
    ob = lax.map(lambda qq: diff_attend(qq, k_all, v_all, lam), qb)
    return ob.transpose(1, 2, 0, 3, 4).reshape(b, h, s, DA_V_DIM)


def diff_head_out(o, g_sub, lam_init):
    o = rmsnorm(o, g_sub) * (1 - lam_init)
    b, h, n, dv = o.shape
    return o.transpose(0, 2, 1, 3).reshape(b, n, h * dv)


def short_conv(xin, bgate, cgate, w):
    u = cgate * xin
    up = jnp.pad(u, ((0, 0), (1, 1), (0, 0)))
    y = w[0] * up[:, :-2] + w[1] * up[:, 1:-1] + w[2] * up[:, 2:]
    return bgate * y


def fourier_mix(xf):
    b, n, w = xf.shape
    g = xf.astype(jnp.float32).reshape(b, n, FN_GROUPS, w // FN_GROUPS)
    y = jnp.fft.fftn(g, axes=(1, 3), norm='ortho').real
    return y.reshape(b, n, w).astype(xf.dtype)


def multiscale_pool(xp, w_grp, scale):
    b, n, w = xp.shape
    xf = xp.reshape(b, n, POOL_G, POOL_GW).astype(jnp.float32)
    cs = jnp.concatenate([jnp.zeros_like(xf[:, :1]), jnp.cumsum(xf, axis=1)], axis=1)
    t = jnp.arange(n)[:, None]
    half = jnp.array([wd // 2 for wd in POOL_WINDOWS])[None, :]
    lo = jnp.clip(t - half, 0, n)
    hi = jnp.clip(t + half, 0, n)
    gi = jnp.arange(POOL_G)[None, :]
    win_sum = cs[:, hi, gi] - cs[:, lo, gi]
    cnt = (hi - lo).astype(jnp.float32)[None, :, :, None]
    pooled = (win_sum / cnt - xf).astype(xp.dtype)
    y = jnp.einsum('bngc,gcd->bngd', pooled, w_grp)
    return y.reshape(b, n, w) * scale


def merge_branches(ys, h, w_branch, w_gate, b_gate, w_out):
    p = jnp.einsum('bnkc,kcd->bnkd', ys, w_branch)
    g = jax.nn.sigmoid(h @ w_gate + b_gate).reshape(p.shape)
    return jnp.sum(g * p, axis=2) @ w_out


def moe_ffn(h, w_router, b_router, w_g, b_g, w_u, b_u, w_d, b_d):
    shp = h.shape
    t = h.reshape(-1, shp[-1])
    logits = (t @ w_router + b_router).astype(jnp.float32)
    top_v, top_i = lax.top_k(logits, TOP_K)
    top_w = jax.nn.softmax(top_v, axis=-1)
    comb = jnp.sum(jax.nn.one_hot(top_i, N_EXPERTS, dtype=jnp.float32) * top_w[..., None], axis=1)
    comb = comb.astype(h.dtype)

    def expert_step(acc, ex):
        wg, bg, wu, bu, wd, bd, ce = ex
        a = jnp.minimum(t @ wg + bg, SWIGLU_LIMIT)
        u = jnp.clip(t @ wu + bu, -SWIGLU_LIMIT, SWIGLU_LIMIT)
        y = (a * jax.nn.sigmoid(SWIGLU_ALPHA * a) * (u + 1)) @ wd + bd
        return acc + ce[:, None] * y, None

    acc, _ = lax.scan(expert_step, jnp.zeros_like(t), (w_g, b_g, w_u, b_u, w_d, b_d, comb.T))
    return acc.reshape(shp)


def setup_inputs(seed: int = 0) -> dict:
    key = jax.random.key(seed)
    ks = jax.random.split(key, 32)
    f32 = jnp.float32

    def nrm(k, shape, s):
        return jax.random.normal(k, shape, f32) * s

    L, D, E, F = DEPTH, D_MODEL, N_EXPERTS, D_EXPERT
    return {
        "x": nrm(ks[0], (BATCH, SEQ, D), 1.0),
        "c": nrm(ks[1], (BATCH, D), 1.0),
        "ctx": nrm(ks[2], (BATCH, CTX_LEN, D), 1.0),
        "c_ctx": nrm(ks[3], (D,), 1.0),
        "w_ada": nrm(ks[4], (L, D, 6 * D), 0.5 * D ** -0.5),
        "b_ada": nrm(ks[5], (L, 6 * D), 0.02),
        "g_norm1": 1.0 + nrm(ks[6], (L, D), 0.05),
        "w_in": nrm(ks[7], (L, D, IN_W), D ** -0.5),
        "da_lambda": nrm(ks[8], (L, 4, DA_HEAD_DIM), 0.1),
        "g_subln": 1.0 + nrm(ks[9], (L, DA_V_DIM), 0.05),
        "w_conv": nrm(ks[10], (L, SC_K, SC_W), SC_K ** -0.5),
        "w_pool": nrm(ks[11], (L, POOL_G, POOL_GW, POOL_GW), POOL_GW ** -0.5),
        "pool_scale": 1.0 + nrm(ks[12], (L, POOL_W), 0.1),
        "w_branch": nrm(ks[13], (L, N_BRANCH, BRANCH_W, D), BRANCH_W ** -0.5),
        "w_mgate": nrm(ks[14], (L, D, N_BRANCH * D), D ** -0.5),
        "b_mgate": nrm(ks[15], (L, N_BRANCH * D), 0.02),
        "w_out": nrm(ks[16], (L, D, D), D ** -0.5),
        "g_norm2": 1.0 + nrm(ks[17], (L, D), 0.05),
        "w_router": nrm(ks[18], (L, D, E), D ** -0.5),
        "b_router": nrm(ks[19], (L, E), 0.01),
        "w_e_gate": nrm(ks[20], (L, E, D, F), D ** -0.5),
        "b_e_gate": nrm(ks[21], (L, E, F), 0.01),
        "w_e_up": nrm(ks[22], (L, E, D, F), D ** -0.5),
        "b_e_up": nrm(ks[23], (L, E, F), 0.01),
        "w_e_down": nrm(ks[24], (L, E, F, D), F ** -0.5),
        "b_e_down": nrm(ks[25], (L, E, D), 0.01),
        "g_final": 1.0 + nrm(ks[26], (D,), 0.05),
    }


def reference(x, c, ctx, c_ctx, w_ada, b_ada, g_norm1, w_in, da_lambda, g_subln, w_conv, w_pool,
              pool_scale, w_branch, w_mgate, b_mgate, w_out, g_norm2, w_router, b_router,
              w_e_gate, b_e_gate, w_e_up, b_e_up, w_e_down, b_e_down, g_final):
    dt = x.dtype
    n_lat = x.shape[1]
    cos, sin = axial_rope(n_lat)
    cos = cos.astype(dt)
    sin = sin.astype(dt)

    for l in range(DEPTH):
        last = l == DEPTH - 1
        lam_init = 0.8 - 0.6 * math.exp(-0.3 * l)
        lam = diff_lambda(da_lambda[l], lam_init)
        m_lat = adaln(c, w_ada[l], b_ada[l])[:, None]
        m_ctx = adaln(c_ctx, w_ada[l], b_ada[l])

        h_lat = modulate(rmsnorm(x, g_norm1[l]), m_lat[..., 0, :], m_lat[..., 1, :])
        h_ctx = modulate(rmsnorm(ctx, g_norm1[l]), m_ctx[0], m_ctx[1])

        q, k, v, sx, sb, sc, fx, px = jnp.split(h_lat @ w_in[l], COL_SPLITS, axis=-1)
        if last:
            ck, cv = jnp.split(h_ctx @ w_in[l][:, KV_LO:KV_HI], [DA_QK_W], axis=-1)
        else:
            cq, ck, cv, csx, csb, csc, cfx, cpx = jnp.split(h_ctx @ w_in[l], COL_SPLITS, axis=-1)

        ck_h = split_qk(ck)
        cv_h = split_v(cv)
        q_lat = apply_rope(split_qk(q), cos, sin)
        k_all = jnp.concatenate([ck_h, apply_rope(split_qk(k), cos, sin)], axis=3)
        v_all = jnp.concatenate([cv_h, split_v(v)], axis=2)
        a_lat = diff_head_out(latent_diff_attention(q_lat, k_all, v_all, lam), g_subln[l], lam_init)

        y_lat = jnp.stack([
            a_lat,
            short_conv(sx, sb, sc, w_conv[l]),
            fourier_mix(fx),
            multiscale_pool(px, w_pool[l], pool_scale[l]),
        ], axis=2)
        x = x + m_lat[..., 2, :] * merge_branches(y_lat, h_lat, w_branch[l], w_mgate[l], b_mgate[l], w_out[l])

        if not last:
            a_ctx = diff_head_out(diff_attend(split_qk(cq), ck_h, cv_h, lam), g_subln[l], lam_init)
            y_ctx = jnp.stack([
                a_ctx,
                short_conv(csx, csb, csc, w_conv[l]),
                fourier_mix(cfx),
                multiscale_pool(cpx, w_pool[l], pool_scale[l]),
            ], axis=2)
            ctx = ctx + m_ctx[2] * merge_branches(y_ctx, h_ctx, w_branch[l], w_mgate[l], b_mgate[l], w_out[l])

        h2 = modulate(rmsnorm(x, g_norm2[l]), m_lat[..., 3, :], m_lat[..., 4, :])
        x = x + m_lat[..., 5, :] * moe_ffn(h2, w_router[l], b_router[l], w_e_gate[l], b_e_gate[l],
                                           w_e_up[l], b_e_up[l], w_e_down[l], b_e_down[l])
        if not last:
            h2c = modulate(rmsnorm(ctx, g_norm2[l]), m_ctx[3], m_ctx[4])
            ctx = ctx + m_ctx[5] * moe_ffn(h2c, w_router[l], b_router[l], w_e_gate[l], b_e_gate[l],
                                           w_e_up[l], b_e_up[l], w_e_down[l], b_e_down[l])

    return rmsnorm(x, g_final)
```

```cpp
#include <hip/hip_runtime.h>
#include <stdint.h>
#include <stdio.h>

#define LAS __attribute__((address_space(3)))
typedef unsigned short bf16_t;
typedef short bf16x8 __attribute__((ext_vector_type(8)));
typedef short s16x4 __attribute__((ext_vector_type(4)));
typedef float f32x2 __attribute__((ext_vector_type(2)));
typedef float f32x4 __attribute__((ext_vector_type(4)));
typedef float f32x16 __attribute__((ext_vector_type(16)));
typedef unsigned u32x2 __attribute__((ext_vector_type(2)));
typedef unsigned u32x4 __attribute__((ext_vector_type(4)));

constexpr int DM = 1024, NB = 8, SEQ = 8192, CTXL = 256, NLAYER = 2;
constexpr int TL = NB * SEQ;
constexpr int TC = NB * CTXL;
constexpr int TA = TL + TC;
constexpr int INW = 4096;
constexpr int C_Q = 0, C_K = 512, C_V = 1024, C_SX = 1536, C_SB = 2048, C_SC = 2560, C_FX = 3072, C_PX = 3584;
constexpr int NEXP = 32, TOPK = 4;
constexpr int MAXROWS = TA + NEXP * 256;
constexpr int WBR_K = 2560;
constexpr float EPS = 1e-6f;
constexpr int NTHR = 512;

constexpr size_t al256(size_t x) { return (x + 255) & ~(size_t)255; }
constexpr size_t WS_CTL = 0, CTL_BYTES = 256 * 1024;
constexpr size_t WS_MODS = WS_CTL + CTL_BYTES;
constexpr size_t WS_ROPE = al256(WS_MODS + (size_t)2 * 9 * 6144 * 4);
constexpr size_t WS_TW = al256(WS_ROPE + 2 * 128 * 16 * 4);
constexpr size_t WS_DFT = al256(WS_TW + 128 * 64 * 2 * 4);
constexpr size_t WS_LAM = al256(WS_DFT + (size_t)(2 * 128 * 128 + 3 * 64 * 64) * 2);
constexpr size_t WS_CTXB = al256(WS_LAM + 256);
constexpr size_t WS_WIN = al256(WS_CTXB + (size_t)TC * DM * 4);
constexpr size_t WS_WGATE = al256(WS_WIN + (size_t)2 * INW * DM * 2);
constexpr size_t WS_WBR = al256(WS_WGATE + (size_t)2 * INW * DM * 2);
constexpr size_t WS_WOUT = al256(WS_WBR + (size_t)2 * DM * WBR_K * 2);
constexpr size_t WS_GU = al256(WS_WOUT + (size_t)2 * DM * DM * 2);
constexpr size_t WS_DN = al256(WS_GU + (size_t)NEXP * 2048 * DM * 2);
constexpr size_t WS_H = al256(WS_DN + (size_t)NEXP * DM * DM * 2);
constexpr size_t WS_PROJ = al256(WS_H + (size_t)TA * DM * 2);
constexpr size_t WS_ZM = al256(WS_PROJ + (size_t)TA * INW * 2);
constexpr size_t WS_SELE = al256(WS_ZM + (size_t)TA * DM * 2);
constexpr size_t WS_SELW = al256(WS_SELE + (size_t)TA * 4 * 4);
constexpr size_t WS_RTOK = al256(WS_SELW + (size_t)TA * 4 * 4);
constexpr size_t WS_RW = al256(WS_RTOK + (size_t)4 * MAXROWS * 4);
constexpr size_t WS_END = al256(WS_RW + (size_t)4 * MAXROWS * 4);
constexpr size_t WS_GST = WS_GU;
constexpr size_t WS_MST = WS_GU + (size_t)256 * 64 * 512 * 4;
static_assert(WS_MST + (size_t)256 * 128 * 512 * 4 <= WS_H, "stash fits in the expert region");
static_assert((size_t)MAXROWS * DM * 2 <= (size_t)TA * INW * 2, "ACT fits in PROJ");

constexpr int CW_BAR = 1024;
constexpr int CW_CNT = 8192;

constexpr int LDS_BYTES = 147456;
constexpr int LDS_MISC = 131072 + 12288;

__device__ __forceinline__ unsigned cvt_pk_bf16(float lo, float hi) { unsigned r; asm volatile("v_cvt_pk_bf16_f32 %0, %1, %2" : "=v"(r) : "v"(lo), "v"(hi)); return r; }
__device__ __forceinline__ float bf_lo(unsigned w) { return __uint_as_float(w << 16); }
__device__ __forceinline__ float bf_hi(unsigned w) { return __uint_as_float(w & 0xffff0000u); }
__device__ __forceinline__ float bf2f(bf16_t b) { return __uint_as_float(((unsigned)b) << 16); }
__device__ __forceinline__ bf16_t f2bf(float f) { return (bf16_t)(cvt_pk_bf16(f, 0.f) & 0xffffu); }
__device__ __forceinline__ float wave_sum(float v) {
#pragma unroll
    for (int o = 32; o >= 1; o >>= 1) v += __shfl_xor(v, o);
    return v;
}
__device__ __forceinline__ void ld8bf(const bf16_t* p, float (&v)[8]) {
    const u32x4 w = *(const u32x4*)p;
    v[0] = bf_lo(w.x); v[1] = bf_hi(w.x); v[2] = bf_lo(w.y); v[3] = bf_hi(w.y); v[4] = bf_lo(w.z); v[5] = bf_hi(w.z); v[6] = bf_lo(w.w); v[7] = bf_hi(w.w);
}
__device__ __forceinline__ void st8bf(bf16_t* p, const float (&v)[8]) {
    u32x4 w; w.x = cvt_pk_bf16(v[0], v[1]); w.y = cvt_pk_bf16(v[2], v[3]); w.z = cvt_pk_bf16(v[4], v[5]); w.w = cvt_pk_bf16(v[6], v[7]);
    *(u32x4*)p = w;
}

struct Params {
    const float* x; const float* c; const float* ctx; const float* c_ctx; const float* w_ada; const float* b_ada; const float* g_norm1;
    const float* w_in; const float* da_lambda; const float* g_subln; const float* w_conv; const float* w_pool; const float* pool_scale;
    const float* w_branch; const float* w_mgate; const float* b_mgate; const float* w_out; const float* g_norm2; const float* w_router; const float* b_router;
    const float* w_e_gate; const float* b_e_gate; const float* w_e_up; const float* b_e_up; const float* w_e_down; const float* b_e_down; const float* g_final;
    float* out; unsigned char* ws; int ph_lo, ph_hi;
};

#define XB_TMO      128
#define XB_XCNT(j)  (256  + 64 * (j))
#define XB_XSUB(j)  (1280 + 64 * (j))
#define XB_XGEN(j)  (2304 + 64 * (j))
#define XB_TOP      3328
#define XB_TOPGEN   3392
#define XCD_BAR_WORDS 3456
#define XB_SPIN_CAP (1u << 20)
__device__ __forceinline__ unsigned xb_ld(unsigned* p)              { return __hip_atomic_load(p, __ATOMIC_RELAXED, __HIP_MEMORY_SCOPE_AGENT); }
__device__ __forceinline__ unsigned xb_add(unsigned* p, unsigned v) { return __hip_atomic_fetch_add(p, v, __ATOMIC_RELAXED, __HIP_MEMORY_SCOPE_AGENT); }
__device__ __forceinline__ unsigned xb_xcc_id() { return (unsigned)__builtin_amdgcn_s_getreg((3 << 11) | 20) & 0xFu; }
#define XB_SPIN(cond, bar) do { unsigned _sp = 0; while (cond) { __builtin_amdgcn_s_sleep(1); \
    if ((++_sp & 255u) == 0u) { if (xb_ld(&(bar)[XB_TMO])) break; if (_sp > XB_SPIN_CAP) { atomicAdd(&(bar)[XB_TMO], 1u); break; } } } } while (0)
struct XcdBarrier { unsigned* bar; unsigned x; volatile LAS unsigned* st; };
__device__ __forceinline__ XcdBarrier xcd_barrier_post(unsigned* bar, volatile LAS unsigned* st) {
    XcdBarrier b; b.bar = bar; b.x = xb_xcc_id(); b.st = st;
    if (threadIdx.x == 0) (void)xb_add(&bar[XB_XCNT(b.x)], 1u);
    return b;
}
__device__ __forceinline__ void xcd_barrier_complete(unsigned* bar, unsigned x, unsigned& nloc, unsigned& nx) {
    const unsigned G = gridDim.x * gridDim.y * gridDim.z;
    unsigned sum, cnt, mine, sp = 0u;
    for (;;) {
        sum = 0u; cnt = 0u; mine = 0u;
#pragma unroll
        for (unsigned j = 0; j < 16; ++j) { const unsigned c = xb_ld(&bar[XB_XCNT(j)]); sum += c; cnt += (c > 0u) ? 1u : 0u; mine = (j == x) ? c : mine; }
        if (sum == G) break;
        __builtin_amdgcn_s_sleep(1);
        if ((++sp & 255u) == 0u) { if (xb_ld(&bar[XB_TMO])) break; if (sp > XB_SPIN_CAP) { atomicAdd(&bar[XB_TMO], 1u); break; } }
    }
    nloc = mine > 0u ? mine : 1u; nx = cnt > 0u ? cnt : 1u;
}
__device__ __forceinline__ void xcd_barrier(const XcdBarrier& b) {
    asm volatile("s_waitcnt vmcnt(0)" ::: "memory");
    __syncthreads();
    if (threadIdx.x == 0) {
        unsigned* bar = b.bar;
        __builtin_amdgcn_s_waitcnt(0);
        unsigned nloc = b.st[0], nx = b.st[1];
        if (nloc == 0u) { xcd_barrier_complete(bar, b.x, nloc, nx); b.st[0] = nloc; b.st[1] = nx; }
        const unsigned old = xb_add(&bar[XB_XSUB(b.x)], 1u);
        const unsigned gen = old / nloc;
        if (old + 1u == (gen + 1u) * nloc) {
            __builtin_amdgcn_fence(__ATOMIC_RELEASE, "agent");
            asm volatile("s_waitcnt vmcnt(0)" ::: "memory");
            const unsigned og = xb_add(&bar[XB_TOP], 1u);
            const unsigned tg = og / nx;
            if (og + 1u == (tg + 1u) * nx) xb_add(&bar[XB_TOPGEN], 1u);
            else XB_SPIN(xb_ld(&bar[XB_TOPGEN]) == tg, bar);
            __builtin_amdgcn_fence(__ATOMIC_ACQUIRE, "agent");
            xb_add(&bar[XB_XGEN(b.x)], 1u);
            asm volatile("s_waitcnt vmcnt(0)" ::: "memory");
        } else {
            XB_SPIN(xb_ld(&bar[XB_XGEN(b.x)]) == gen, bar);
            __builtin_amdgcn_fence(__ATOMIC_ACQUIRE, "agent");
            asm volatile("s_waitcnt vmcnt(0)" ::: "memory");
        }
    }
    __syncthreads();
}

struct Frame {
    int tid, lane, wid, wg, nwg;
    LAS unsigned char* lds;
    unsigned char* ws;
    __device__ __forceinline__ unsigned* ctl() const { return (unsigned*)(ws + WS_CTL); }
    __device__ __forceinline__ float* mods() const { return (float*)(ws + WS_MODS); }
    __device__ __forceinline__ float* rope() const { return (float*)(ws + WS_ROPE); }
    __device__ __forceinline__ float* tw() const { return (float*)(ws + WS_TW); }
    __device__ __forceinline__ bf16_t* dft() const { return (bf16_t*)(ws + WS_DFT); }
    __device__ __forceinline__ float* lam() const { return (float*)(ws + WS_LAM); }
    __device__ __forceinline__ float* ctxb() const { return (float*)(ws + WS_CTXB); }
    __device__ __forceinline__ bf16_t* win() const { return (bf16_t*)(ws + WS_WIN); }
    __device__ __forceinline__ bf16_t* wgate() const { return (bf16_t*)(ws + WS_WGATE); }
    __device__ __forceinline__ bf16_t* wbr() const { return (bf16_t*)(ws + WS_WBR); }
    __device__ __forceinline__ bf16_t* wout() const { return (bf16_t*)(ws + WS_WOUT); }
    __device__ __forceinline__ bf16_t* gu() const { return (bf16_t*)(ws + WS_GU); }
    __device__ __forceinline__ bf16_t* dn() const { return (bf16_t*)(ws + WS_DN); }
    __device__ __forceinline__ bf16_t* H() const { return (bf16_t*)(ws + WS_H); }
    __device__ __forceinline__ bf16_t* proj() const { return (bf16_t*)(ws + WS_PROJ); }
    __device__ __forceinline__ bf16_t* zm() const { return (bf16_t*)(ws + WS_ZM); }
    __device__ __forceinline__ bf16_t* act() const { return (bf16_t*)(ws + WS_PROJ); }
    __device__ __forceinline__ int* sele() const { return (int*)(ws + WS_SELE); }
    __device__ __forceinline__ float* selw() const { return (float*)(ws + WS_SELW); }
    __device__ __forceinline__ int* rtok() const { return (int*)(ws + WS_RTOK); }
    __device__ __forceinline__ float* rw() const { return (float*)(ws + WS_RW); }
    __device__ __forceinline__ unsigned* gst() const { return (unsigned*)(ws + WS_GST) + (size_t)wg * 64 * NTHR; }
    __device__ __forceinline__ float* mst() const { return (float*)(ws + WS_MST) + (size_t)wg * 128 * NTHR; }
};

__device__ __forceinline__ int qk_rowmap(int n) {
    if (n >= 1024) return n;
    const int g = n & ~31, d = n & 31;
    const int p = d < 16 ? 8 * (d >> 2) + (d & 3) : 8 * ((d - 16) >> 2) + 4 + (d & 3);
    return g + p;
}
__device__ __forceinline__ int gu_rowmap(int c, int up) { return 32 * (c >> 4) + 8 * ((c & 15) >> 2) + (c & 3) + 4 * up; }

template <int MODE>
__device__ __forceinline__ void cvt_tile(const Frame& F, const float* __restrict__ src, int src_ld, int k0, int n0, bf16_t* __restrict__ dst, int dst_ld, int dst_k0) {
    LAS float* tile = (LAS float*)F.lds;
#pragma unroll
    for (int q = 0; q < 2; ++q) {
        const int idx = F.tid + q * NTHR, r = idx >> 4, c4 = idx & 15;
        const f32x4 v = *(const f32x4*)(src + (size_t)(k0 + r) * src_ld + n0 + c4 * 4);
        tile[r * 65 + c4 * 4 + 0] = v[0]; tile[r * 65 + c4 * 4 + 1] = v[1]; tile[r * 65 + c4 * 4 + 2] = v[2]; tile[r * 65 + c4 * 4 + 3] = v[3];
    }
    __syncthreads();
    {
        const int n = F.tid >> 3, kc = F.tid & 7;
        float v[8];
#pragma unroll
        for (int j = 0; j < 8; ++j) v[j] = tile[(kc * 8 + j) * 65 + n];
        int row = n0 + n;
        if (MODE == 1) row = qk_rowmap(row);
        if (MODE == 2) row = gu_rowmap(row, 0);
        if (MODE == 3) row = gu_rowmap(row, 1);
        st8bf(dst + (size_t)row * dst_ld + dst_k0 + k0 + kc * 8, v);
    }
    __syncthreads();
}

__device__ __forceinline__ void p0_mods(const Frame& F, const Params& P, int item) {
    LAS float* sl = (LAS float*)F.lds;
    for (int i = F.tid; i < 9 * 1024; i += NTHR) {
        const int r = i >> 10, d = i & 1023;
        const float v = (r < 8) ? P.c[r * 1024 + d] : P.c_ctx[d];
        sl[i] = v / (1.f + __expf(-v));
    }
    __syncthreads();
    const int col = item * NTHR + F.tid, l = col / 6144, j = col % 6144;
    float acc[9];
#pragma unroll
    for (int r = 0; r < 9; ++r) acc[r] = 0.f;
    const float* w = P.w_ada + (size_t)l * 1024 * 6144 + j;
    for (int d = 0; d < 1024; ++d) {
        const float wv = w[(size_t)d * 6144];
#pragma unroll
        for (int r = 0; r < 9; ++r) acc[r] += sl[r * 1024 + d] * wv;
    }
#pragma unroll
    for (int r = 0; r < 9; ++r) F.mods()[(size_t)(l * 9 + r) * 6144 + j] = acc[r] + P.b_ada[l * 6144 + j];
    __syncthreads();
}

__device__ __forceinline__ void p0_fold(const Frame& F, const Params& P, int item) {
    const int l = item / 192, rem = item % 192, which = rem / 64, c8 = rem % 64;
    const int cbase = c8 * 8, g = cbase >> 7, cl = cbase & 127;
    LAS float* coef = (LAS float*)F.lds;
    for (int i = F.tid; i < 1024; i += NTHR) {
        const int cp = i >> 3, j = i & 7, c = cl + j;
        float v;
        if (which == 2) v = P.w_pool[((size_t)(l * 4 + g) * 128 + c) * 128 + cp] * P.pool_scale[l * 512 + g * 128 + cp];
        else { float sn, cs; sincospif(2.f * (float)((c * cp) & 127) / 128.f, &sn, &cs); v = (which == 0 ? cs : -sn) * 0.08838834764831845f; }
        coef[i] = v;
    }
    __syncthreads();
    const float* wb = P.w_branch + ((size_t)(l * 4 + (which == 2 ? 3 : 2)) * 512 + g * 128) * 1024;
    const int kofs = (which == 0 ? 1024 : which == 1 ? 1536 : 2048) + cbase;
#pragma unroll
    for (int h = 0; h < 2; ++h) {
        const int n = F.tid + h * NTHR;
        float acc[8];
#pragma unroll
        for (int j = 0; j < 8; ++j) acc[j] = 0.f;
        for (int cp = 0; cp < 128; ++cp) {
            const float w = wb[(size_t)cp * 1024 + n];
#pragma unroll
            for (int j = 0; j < 8; ++j) acc[j] += coef[cp * 8 + j] * w;
        }
        st8bf(F.wbr() + ((size_t)l * 1024 + n) * WBR_K + kofs, acc);
    }
    __syncthreads();
}

__device__ __forceinline__ void p0_tables(const Frame& F, const Params& P, int item) {
    const int idx = item * NTHR + F.tid;
    if (idx < 2048) {
        const int pos = idx >> 4, i = idx & 15;
        const float inv = powf(10000.f, -(float)(2 * i) / 32.f);
        const float ang = (float)pos * inv;
        F.rope()[idx] = cosf(ang); F.rope()[2048 + idx] = sinf(ang);
    }
    if (idx < 8192) {
        const int k1 = idx >> 6, n2 = idx & 63;
        float sn, cs; sincospif(2.f * (float)(k1 * n2) / 8192.f, &sn, &cs);
        F.tw()[idx * 2] = cs; F.tw()[idx * 2 + 1] = sn;
    }
    if (idx < 16384) {
        const int k = idx >> 7, n = idx & 127;
        float sn, cs; sincospif(2.f * (float)((k * n) & 127) / 128.f, &sn, &cs);
        F.dft()[idx] = f2bf(cs); F.dft()[16384 + idx] = f2bf(sn);
    }
    if (idx < 4096) {
        const int k = idx >> 6, n = idx & 63;
        float sn, cs; sincospif(2.f * (float)((k * n) & 63) / 64.f, &sn, &cs);
        F.dft()[32768 + idx] = f2bf(cs); F.dft()[32768 + 4096 + idx] = f2bf(sn); F.dft()[32768 + 8192 + idx] = f2bf(-sn);
    }
    if (idx < 2) {
        const float* lm = P.da_lambda + idx * 256;
        float s1 = 0.f, s2 = 0.f;
        for (int i = 0; i < 64; ++i) { s1 += lm[i] * lm[64 + i]; s2 += lm[128 + i] * lm[192 + i]; }
        const float lam_init = 0.8f - 0.6f * expf(-0.3f * (float)idx);
        F.lam()[idx] = expf(s1) - expf(s2) + lam_init;
    }
}

__device__ __forceinline__ void p0_prologue(const Frame& F, const Params& P) {
    for (int it = F.wg; it < 24 + 384 + 64; it += F.nwg) {
        if (it < 24) p0_mods(F, P, it);
        else if (it < 408) p0_fold(F, P, it - 24);
        else p0_tables(F, P, it - 408);
    }
    for (size_t i = (size_t)F.wg * NTHR + F.tid; i < (size_t)TC * DM / 4; i += (size_t)F.nwg * NTHR) ((f32x4*)F.ctxb())[i] = ((const f32x4*)P.ctx)[i];
    for (int it = F.wg; it < 2 * 2560; it += F.nwg) {
        const int l = it / 2560; int r = it % 2560;
        if (r < 1024) cvt_tile<1>(F, P.w_in + (size_t)l * DM * INW, INW, (r >> 6) * 64, (r & 63) * 64, F.win() + (size_t)l * INW * DM, DM, 0);
        else if (r < 2048) { r -= 1024; cvt_tile<0>(F, P.w_mgate + (size_t)l * DM * INW, INW, (r >> 6) * 64, (r & 63) * 64, F.wgate() + (size_t)l * INW * DM, DM, 0); }
        else if (r < 2304) { r -= 2048; cvt_tile<0>(F, P.w_out + (size_t)l * DM * DM, DM, (r >> 4) * 64, (r & 15) * 64, F.wout() + (size_t)l * DM * DM, DM, 0); }
        else { r -= 2304; const int k = r >> 7; r &= 127;
               cvt_tile<0>(F, P.w_branch + (size_t)(l * 4 + k) * 512 * 1024, 1024, (r >> 4) * 64, (r & 15) * 64, F.wbr() + (size_t)l * 1024 * WBR_K, WBR_K, k * 512); }
    }
}

__device__ __forceinline__ void cvt_experts(const Frame& F, const Params& P, int l) {
    for (int it = F.wg; it < NEXP * 3 * 256; it += F.nwg) {
        const int e = it / 768, r = it % 768, which = r >> 8, t = r & 255, k0 = (t >> 4) * 64, n0 = (t & 15) * 64;
        const size_t eo = ((size_t)l * NEXP + e) * DM * DM;
        if (which == 0) cvt_tile<2>(F, P.w_e_gate + eo, DM, k0, n0, F.gu() + (size_t)e * 2048 * DM, DM, 0);
        else if (which == 1) cvt_tile<3>(F, P.w_e_up + eo, DM, k0, n0, F.gu() + (size_t)e * 2048 * DM, DM, 0);
        else cvt_tile<0>(F, P.w_e_down + eo, DM, k0, n0, F.dn() + (size_t)e * DM * DM, DM, 0);
    }
}

__device__ __forceinline__ const float* xrow_ptr(const float* xs, long long dctx, int row) { return xs + (size_t)row * DM + (row >= TL ? dctx : 0ll); }
__device__ __forceinline__ void phase_norm1(const Frame& F, const Params& P, int l, const float* xs, long long dctx) {
    const float* g = P.g_norm1 + l * DM;
    for (int row = F.wg * 8 + F.wid; row < TA; row += F.nwg * 8) {
        const float* xr = xrow_ptr(xs, dctx, row);
        const int b = row < TL ? (row >> 13) : 8;
        const float* md = F.mods() + (size_t)(l * 9 + b) * 6144;
        f32x4 v[4]; float ss = 0.f;
#pragma unroll
        for (int j = 0; j < 4; ++j) { v[j] = *(const f32x4*)(xr + F.lane * 4 + 256 * j); ss += v[j][0] * v[j][0] + v[j][1] * v[j][1] + v[j][2] * v[j][2] + v[j][3] * v[j][3]; }
        ss = wave_sum(ss);
        const float rstd = rsqrtf(ss * (1.f / 1024.f) + EPS);
#pragma unroll
        for (int j = 0; j < 4; ++j) {
            const int col = F.lane * 4 + 256 * j;
            const f32x4 gg = *(const f32x4*)(g + col), sh = *(const f32x4*)(md + col), sc = *(const f32x4*)(md + 1024 + col);
            float o[4];
#pragma unroll
            for (int i = 0; i < 4; ++i) o[i] = v[j][i] * rstd * gg[i] * (1.f + sc[i]) + sh[i];
            u32x2 w; w.x = cvt_pk_bf16(o[0], o[1]); w.y = cvt_pk_bf16(o[2], o[3]);
            *(u32x2*)(F.H() + (size_t)row * DM + col) = w;
        }
    }
}

__device__ __forceinline__ void phase_final(const Frame& F, const Params& P) {
    for (int row = F.wg * 8 + F.wid; row < TL; row += F.nwg * 8) {
        float* xr = P.out + (size_t)row * DM;
        f32x4 v[4]; float ss = 0.f;
#pragma unroll
        for (int j = 0; j < 4; ++j) { v[j] = *(const f32x4*)(xr + F.lane * 4 + 256 * j); ss += v[j][0] * v[j][0] + v[j][1] * v[j][1] + v[j][2] * v[j][2] + v[j][3] * v[j][3]; }
        ss = wave_sum(ss);
        const float rstd = rsqrtf(ss * (1.f / 1024.f) + EPS);
#pragma unroll
        for (int j = 0; j < 4; ++j) {
            const int col = F.lane * 4 + 256 * j;
            const f32x4 gg = *(const f32x4*)(P.g_final + col);
            f32x4 o;
#pragma unroll
            for (int i = 0; i < 4; ++i) o[i] = v[j][i] * rstd * gg[i];
            *(f32x4*)(xr + col) = o;
        }
    }
}

__device__ __forceinline__ void seq_of(int row, int& s, int& n) { if (row < TL) { s = row & (SEQ - 1); n = SEQ; } else { s = (row - TL) & (CTXL - 1); n = CTXL; } }

__device__ __forceinline__ void phase_conv(const Frame& F, const Params& P, int l, int nrows) {
    const float* wc = P.w_conv + l * 3 * 512;
    for (size_t idx = (size_t)F.wg * NTHR + F.tid; idx < (size_t)nrows * 64; idx += (size_t)F.nwg * NTHR) {
        const int row = (int)(idx >> 6), ch = (int)(idx & 63) * 8;
        int s, n; seq_of(row, s, n);
        bf16_t* base = F.proj() + (size_t)row * INW;
        float xc[8], cc[8], bb[8], up[8], un[8];
        ld8bf(base + C_SX + ch, xc); ld8bf(base + C_SC + ch, cc); ld8bf(base + C_SB + ch, bb);
        if (s > 0) { float a[8], b[8]; ld8bf(base - INW + C_SX + ch, a); ld8bf(base - INW + C_SC + ch, b);
#pragma unroll
            for (int j = 0; j < 8; ++j) up[j] = a[j] * b[j]; }
        else {
#pragma unroll
            for (int j = 0; j < 8; ++j) up[j] = 0.f; }
        if (s < n - 1) { float a[8], b[8]; ld8bf(base + INW + C_SX + ch, a); ld8bf(base + INW + C_SC + ch, b);
#pragma unroll
            for (int j = 0; j < 8; ++j) un[j] = a[j] * b[j]; }
        else {
#pragma unroll
            for (int j = 0; j < 8; ++j) un[j] = 0.f; }
        float y[8];
#pragma unroll
        for (int j = 0; j < 8; ++j) y[j] = bb[j] * (wc[ch + j] * up[j] + wc[512 + ch + j] * (xc[j] * cc[j]) + wc[1024 + ch + j] * un[j]);
        st8bf(base + C_SB + ch, y);
    }
}

__device__ __forceinline__ void phase_pool(const Frame& F, int nrows) {
    for (size_t idx = (size_t)F.wg * NTHR + F.tid; idx < (size_t)nrows * 64; idx += (size_t)F.nwg * NTHR) {
        const int row = (int)(idx >> 6), c8 = (int)(idx & 63), ch = c8 * 8, g = c8 >> 4, half = 1 << g;
        int s, n; seq_of(row, s, n);
        const int lo = max(s - half, 0), hi = min(s + half, n);
        const bf16_t* base = F.proj() + (size_t)row * INW + C_PX + ch;
        float sum[8], xs[8];
#pragma unroll
        for (int j = 0; j < 8; ++j) sum[j] = 0.f;
        for (int t = lo; t < hi; ++t) { float v[8]; ld8bf(base + (ptrdiff_t)(t - s) * INW, v);
#pragma unroll
            for (int j = 0; j < 8; ++j) sum[j] += v[j]; }
        ld8bf(base, xs);
        const float ic = 1.f / (float)(hi - lo);
        float y[8];
#pragma unroll
        for (int j = 0; j < 8; ++j) y[j] = sum[j] * ic - xs[j];
        st8bf(F.proj() + (size_t)row * INW + C_FX + ch, y);
    }
}

__device__ __forceinline__ void phase_ctx_dft(const Frame& F) {
    LAS float* tab = (LAS float*)F.lds;
    if (F.tid < 256) { float sn, cs; sincospif(2.f * (float)F.tid / 256.f, &sn, &cs); tab[F.tid] = cs; tab[256 + F.tid] = sn; }
    __syncthreads();
    for (int it = F.wg; it < NB * CTXL; it += F.nwg) {
        const int b = it >> 8, np = it & 255;
        const bf16_t* src = F.proj() + (size_t)(TL + b * CTXL) * INW + C_FX + F.tid;
        float a = 0.f, bb = 0.f;
        for (int n = 0; n < CTXL; ++n) {
            const float xv = bf2f(src[(size_t)n * INW]);
            const int m = (n * np) & 255;
            a += xv * tab[m]; bb += xv * tab[256 + m];
        }
        bf16_t* dst = F.zm() + (size_t)(TL + b * CTXL + np) * DM;
        dst[F.tid] = f2bf(a * 0.0625f); dst[512 + F.tid] = f2bf(bb * 0.0625f);
    }
    __syncthreads();
}
__device__ __forceinline__ void phase_ctx_dft_copy(const Frame& F) {
    for (size_t idx = (size_t)F.wg * NTHR + F.tid; idx < (size_t)TC * 128; idx += (size_t)F.nwg * NTHR) {
        const int r = (int)(idx >> 7), c = (int)(idx & 127) * 8;
        *(u32x4*)(F.proj() + (size_t)(TL + r) * INW + C_K + c) = *(const u32x4*)(F.zm() + (size_t)(TL + r) * DM + c);
    }
}

namespace gm {
constexpr int BM = 256, BK = 64, HALF = 128, HTB = HALF * BK * 2, STAGE_BYTES = 8 * HTB;
__device__ __forceinline__ int lds_byte(int r, int c) { const int st = (r >> 4) * 2 + (c >> 5), rr = r & 15, cc = c & 31, ob = rr * 64 + cc * 2; return st * 1024 + (ob ^ (((ob >> 9) & 1) << 5)); }
__device__ __forceinline__ void stage_rc(int b, int& R, int& C) { const int st = b / 1024, sb = b % 1024, swz = sb ^ (((sb >> 9) & 1) << 5); R = (st >> 1) * 16 + swz / 64; C = (st & 1) * 32 + (swz % 64) / 2; }
__device__ __forceinline__ int perm32(int rho) { const int n = rho >> 4, i = rho & 15; return 8 * (i >> 2) + 4 * n + (i & 3); }

struct GUnit {
    const char* A;
    const char* B;
    const int* gidx;
    unsigned lda, ldb;
    int nt;
    int pm, pn, sub, e;
};

template <bool PERM, class Epi, class Sched>
__device__ __forceinline__ void gemm_phase(LAS unsigned char* lds, const Sched& S, const Epi& E) {
    int tid = threadIdx.x; asm volatile("" : "+v"(tid));
    const int wid = __builtin_amdgcn_readfirstlane(tid >> 6), lane = tid & 63, wr = wid >> 2, wc = wid & 3, fr = lane & 15, fq = lane >> 4;
    int R0, C0, R1, C1; stage_rc(tid * 16, R0, C0); stage_rc(tid * 16 + 8192, R1, C1);
    const int Rb0 = PERM ? ((R0 & ~31) + perm32(R0 & 31)) : R0, Rb1 = PERM ? ((R1 & ~31) + perm32(R1 & 31)) : R1;
    const unsigned ldsw = (unsigned)wid * 1024u;
    const int aoff = lds_byte(wr * 64 + fr, fq * 8), boff = lds_byte(wc * 32 + fr, fq * 8);
    const size_t kstep = (size_t)(BK * 2);
#define G_SA(b, h) (((b) * 2 + (h)) * gm::HTB)
#define G_SB(b, h) ((4 + (b) * 2 + (h)) * gm::HTB)
#define G_STAGE2(bufoff, gbase, v0, v1) do { \
        __builtin_amdgcn_global_load_lds((const unsigned*)((const char*)(gbase) + (v0)), (LAS unsigned*)(lds + (bufoff) + ldsw), 16, 0, 0); \
        __builtin_amdgcn_global_load_lds((const unsigned*)((const char*)(gbase) + (v1)), (LAS unsigned*)(lds + (bufoff) + ldsw + 8192), 16, 0, 0); } while (0)
#define G_LDA(dst, b, h) do { _Pragma("unroll") for (int m = 0; m < 4; ++m) _Pragma("unroll") for (int k = 0; k < 2; ++k) dst[m][k] = *(const LAS bf16x8*)(lds + G_SA(b, h) + aoff + m * 2048 + k * 1024); } while (0)
#define G_LDB(dst, b, h) do { _Pragma("unroll") for (int n = 0; n < 2; ++n) _Pragma("unroll") for (int k = 0; k < 2; ++k) dst[n][k] = *(const LAS bf16x8*)(lds + G_SB(b, h) + boff + n * 2048 + k * 1024); } while (0)
#define G_MMA(ai, bj, At, Bt) do { __builtin_amdgcn_s_setprio(1); _Pragma("unroll") for (int m = 0; m < 4; ++m) _Pragma("unroll") for (int n = 0; n < 2; ++n) _Pragma("unroll") for (int k = 0; k < 2; ++k) \
        acc[ai][bj][m][n] = __builtin_amdgcn_mfma_f32_16x16x32_bf16(Bt[n][k], At[m][k], acc[ai][bj][m][n], 0, 0, 0); __builtin_amdgcn_s_setprio(0); } while (0)
#define G_WAIT_V(n) asm volatile("s_waitcnt vmcnt(" #n ")" ::: "memory")
#define G_WAIT_L(n) asm volatile("s_waitcnt lgkmcnt(" #n ")" ::: "memory")
#define G_BAR __builtin_amdgcn_s_barrier()
#define G_SCHED __builtin_amdgcn_sched_barrier(0)
#define G_OFFS(u, va00, va01, va10, va11, vb0, vb1, hsB) do { \
        unsigned _lda = (u).lda, _ldb = (u).ldb; if (Sched::VAR_STRIDE) asm volatile("" : "+s"(_lda), "+s"(_ldb));     \
        int r00 = R0, r01 = R1, r10 = 128 + R0, r11 = 128 + R1; \
        if ((u).gidx) { r00 = (u).gidx[R0]; r01 = (u).gidx[R1]; r10 = (u).gidx[128 + R0]; r11 = (u).gidx[128 + R1]; r00 = r00 < 0 ? 0 : r00; r01 = r01 < 0 ? 0 : r01; r10 = r10 < 0 ? 0 : r10; r11 = r11 < 0 ? 0 : r11; } \
        va00 = (unsigned)r00 * _lda + (unsigned)C0 * 2u; va01 = (unsigned)r01 * _lda + (unsigned)C1 * 2u; \
        va10 = (unsigned)r10 * _lda + (unsigned)C0 * 2u; va11 = (unsigned)r11 * _lda + (unsigned)C1 * 2u; \
        vb0 = (unsigned)Rb0 * _ldb + (unsigned)C0 * 2u; vb1 = (unsigned)Rb1 * _ldb + (unsigned)C1 * 2u; hsB = (size_t)128 * _ldb; } while (0)
    GUnit cur, nxt; int ui = 0;
    if (!S.next(0, cur)) return;
    f32x4 acc[2][2][4][2];
#pragma unroll
    for (int a = 0; a < 2; ++a)
#pragma unroll
        for (int b = 0; b < 2; ++b)
#pragma unroll
            for (int m = 0; m < 4; ++m)
#pragma unroll
                for (int n = 0; n < 2; ++n) acc[a][b][m][n] = (f32x4){0.f, 0.f, 0.f, 0.f};
    bf16x8 At[4][2], B0[2][2], B1[2][2];
    unsigned va00, va01, va10, va11, vb0, vb1; size_t hsB;
    unsigned na00, na01, na10, na11, nb0, nb1; size_t nhsB;
    G_OFFS(cur, va00, va01, va10, va11, vb0, vb1, hsB);
    const char* cA = cur.A; const char* cB = cur.B;
    G_STAGE2(G_SB(0, 0), cB, vb0, vb1); G_STAGE2(G_SA(0, 0), cA, va00, va01); G_STAGE2(G_SB(0, 1), cB + hsB, vb0, vb1); G_STAGE2(G_SA(0, 1), cA, va10, va11);
    if (wr == 1) G_BAR;
    G_WAIT_V(4); G_BAR;
    G_STAGE2(G_SB(1, 0), cB + kstep, vb0, vb1); G_STAGE2(G_SA(1, 0), cA + kstep, va00, va01); G_STAGE2(G_SB(1, 1), cB + hsB + kstep, vb0, vb1);
    G_WAIT_V(6); G_BAR;
    for (;;) {
        const bool has_next = S.next(ui + 1, nxt);
        const char* nA = cA; const char* nB = cB;
        if (has_next) { nA = nxt.A; nB = nxt.B; }
        if (Sched::GATHER_A) {
            na00 = va00; na01 = va01; na10 = va10; na11 = va11; nb0 = vb0; nb1 = vb1; nhsB = hsB;
            if (has_next) G_OFFS(nxt, na00, na01, na10, na11, nb0, nb1, nhsB);
        }
        const int nt = cur.nt;
        for (int t = 0; t < nt; t += 2) {
            const bool last = (t == nt - 2);
            const char* a1 = cA + (size_t)(t + 1) * kstep;
            G_LDB(B0, 0, 0); G_SCHED; G_LDA(At, 0, 0); G_STAGE2(G_SA(1, 1), a1, va10, va11);
            const char* a2 = last ? nA : cA + (size_t)(t + 2) * kstep; const char* b2 = last ? nB : cB + (size_t)(t + 2) * kstep;
            if (last) {
                if (Sched::GATHER_A) { va00 = na00; va01 = na01; va10 = na10; va11 = na11; vb0 = nb0; vb1 = nb1; hsB = nhsB; }
                else if (has_next) G_OFFS(nxt, va00, va01, va10, va11, vb0, vb1, hsB);
            }
            const char* a3 = a2 + kstep; const char* b3 = b2 + kstep;
            G_WAIT_L(8); G_BAR; G_WAIT_L(0); G_MMA(0, 0, At, B0); G_BAR; G_SCHED;
            G_LDB(B1, 0, 1); G_STAGE2(G_SB(0, 0), b2, vb0, vb1);
            G_BAR; G_WAIT_L(0); G_MMA(0, 1, At, B1); G_BAR;
            G_LDA(At, 0, 1); G_STAGE2(G_SA(0, 0), a2, va00, va01);
            G_BAR; G_WAIT_L(0); G_MMA(1, 0, At, B0); G_BAR; G_SCHED;
            G_STAGE2(G_SB(0, 1), b2 + hsB, vb0, vb1);
            G_WAIT_V(6); G_BAR; G_MMA(1, 1, At, B1); G_BAR;
            G_LDB(B0, 1, 0); G_SCHED; G_LDA(At, 1, 0); G_STAGE2(G_SA(0, 1), a2, va10, va11);
            G_WAIT_L(8); G_BAR; G_WAIT_L(0); G_MMA(0, 0, At, B0); G_BAR; G_SCHED;
            G_LDB(B1, 1, 1); G_STAGE2(G_SB(1, 0), b3, vb0, vb1);
            G_BAR; G_WAIT_L(0); G_MMA(0, 1, At, B1); G_BAR;
            G_LDA(At, 1, 1); G_STAGE2(G_SA(1, 0), a3, va00, va01);
            G_BAR; G_WAIT_L(0); G_MMA(1, 0, At, B0); G_BAR; G_SCHED;
            G_STAGE2(G_SB(1, 1), b3 + hsB, vb0, vb1);
            G_WAIT_V(6); G_BAR; G_MMA(1, 1, At, B1); G_BAR;
        }
        E(acc, cur, wr, wc, fr, fq);
        if (!has_next) break;
#pragma unroll
        for (int a = 0; a < 2; ++a)
#pragma unroll
            for (int b = 0; b < 2; ++b)
#pragma unroll
                for (int m = 0; m < 4; ++m)
#pragma unroll
                    for (int n = 0; n < 2; ++n) acc[a][b][m][n] = (f32x4){0.f, 0.f, 0.f, 0.f};
        cur = nxt; cA = nA; cB = nB; ++ui;
    }
    G_WAIT_V(0);
    if (wr == 0) G_BAR;
    G_BAR;
}
}

struct SchedProj {
    static constexpr bool VAR_STRIDE = false, GATHER_A = false;
    const char* H; const char* W; int l, G, c;
    __device__ __forceinline__ bool next(int i, gm::GUnit& u) const {
        const int L = i * G + c, nlat = 256 * 16, ntot = nlat + (l == 0 ? 8 * 16 : 8 * 4);
        if (L >= ntot) return false;
        int pm, pn;
        if (L < nlat) { pm = L >> 4; pn = L & 15; }
        else { const int r = L - nlat; if (l == 0) { pm = 256 + (r >> 4); pn = r & 15; } else { pm = 256 + (r >> 2); pn = 2 + (r & 3); } }
        u.A = H + (size_t)pm * 256 * 2048; u.B = W + (size_t)pn * 256 * 2048; u.gidx = nullptr; u.lda = 2048; u.ldb = 2048; u.nt = 16; u.pm = pm; u.pn = pn; u.sub = 0; u.e = 0;
        return true;
    }
};
struct SchedMerge {
    static constexpr bool VAR_STRIDE = true, GATHER_A = false;
    const char* H; const char* WG; const char* P; const char* WB; int ntile, G, c;
    __device__ __forceinline__ bool next(int i, gm::GUnit& u) const {
        const int L = (i >> 3) * G + c, s = i & 7, k = s >> 1;
        if (L >= ntile) return false;
        const int pm = L >> 2, pn = L & 3;
        u.gidx = nullptr; u.pm = pm; u.pn = pn; u.sub = s; u.e = 0;
        if ((s & 1) == 0) { u.A = H + (size_t)pm * 256 * 2048; u.lda = 2048; u.B = WG + (size_t)(k * 1024 + pn * 256) * 2048; u.ldb = 2048; u.nt = 16; }
        else {
            const int colofs = (k == 0) ? C_Q : (k == 1) ? C_SB : (k == 2) ? C_K : C_FX;
            const int kofs = (k == 0) ? 0 : (k == 1) ? 512 : (k == 2) ? 1024 : 2048;
            u.A = P + (size_t)pm * 256 * 8192 + colofs * 2; u.lda = 8192; u.B = WB + (size_t)pn * 256 * (WBR_K * 2) + kofs * 2; u.ldb = WBR_K * 2; u.nt = (k == 2) ? 16 : 8;
        }
        return true;
    }
};
struct SchedOut {
    static constexpr bool VAR_STRIDE = false, GATHER_A = false;
    const char* M; const char* W; int ntile, G, c;
    __device__ __forceinline__ bool next(int i, gm::GUnit& u) const {
        const int L = i * G + c; if (L >= ntile) return false;
        const int pm = L >> 2, pn = L & 3;
        u.A = M + (size_t)pm * 256 * 2048; u.B = W + (size_t)pn * 256 * 2048; u.gidx = nullptr; u.lda = 2048; u.ldb = 2048; u.nt = 16; u.pm = pm; u.pn = pn; u.sub = 0; u.e = 0;
        return true;
    }
};
template <int NCT, bool GATHER>
struct SchedMoe {
    static constexpr bool VAR_STRIDE = false, GATHER_A = GATHER;
    const char* A; const char* W; const int* rtok; const LAS int* tb; int G, c;
    __device__ __forceinline__ bool next(int i, gm::GUnit& u) const {
        const int L = i * G + c, rt = L / NCT, ct = L % NCT;
        if (rt >= tb[32]) return false;
        int e = 0;
        while (tb[e + 1] <= rt) ++e;
        u.pm = rt; u.pn = ct; u.sub = 0; u.e = e; u.lda = 2048; u.ldb = 2048; u.nt = 16;
        if (GATHER) { u.A = A; u.gidx = rtok + (size_t)rt * 256; u.B = W + ((size_t)e * 2048 + ct * 256) * 2048; }
        else { u.A = A + (size_t)rt * 256 * 2048; u.gidx = nullptr; u.B = W + ((size_t)e * 1024 + ct * 256) * 2048; }
        return true;
    }
};

typedef f32x4 AccT[2][2][4][2];
struct EpiProj {
    bf16_t* P; const float* rope;
    __device__ __forceinline__ void operator()(const AccT& acc, const gm::GUnit& u, int wr, int wc, int fr, int fq) const {
        asm volatile("" : "+v"(fr), "+v"(fq));
        const bool dorope = (u.pn < 4) && (u.pm < 256);
#pragma unroll
        for (int ai = 0; ai < 2; ++ai)
#pragma unroll
            for (int m = 0; m < 4; ++m) {
                const int row = u.pm * 256 + ai * 128 + wr * 64 + m * 16 + fr;
                f32x4 cs = (f32x4){1.f, 1.f, 1.f, 1.f}, sn = (f32x4){0.f, 0.f, 0.f, 0.f};
                if (dorope) { const int s = row & (SEQ - 1), pos = (wc & 1) ? (s & 63) : (s >> 6); cs = *(const f32x4*)(rope + pos * 16 + 4 * fq); sn = *(const f32x4*)(rope + 2048 + pos * 16 + 4 * fq); }
                bf16_t* rowp = P + (size_t)row * INW + u.pn * 256 + wc * 32 + 8 * fq;
#pragma unroll
                for (int bj = 0; bj < 2; ++bj) {
                    const f32x4 x0 = acc[ai][bj][m][0], x1 = acc[ai][bj][m][1];
                    const f32x4 o0 = x0 * cs - x1 * sn, o1 = x1 * cs + x0 * sn;
                    u32x4 w; w.x = cvt_pk_bf16(o0[0], o0[1]); w.y = cvt_pk_bf16(o0[2], o0[3]); w.z = cvt_pk_bf16(o1[0], o1[1]); w.w = cvt_pk_bf16(o1[2], o1[3]);
                    *(u32x4*)(rowp + bj * 128) = w;
                }
            }
    }
};
struct EpiMerge {
    unsigned* gst; float* mst; const float* bg; bf16_t* M;
    __device__ __forceinline__ void operator()(const AccT& acc, const gm::GUnit& u, int wr, int wc, int fr, int fq) const {
        asm volatile("" : "+v"(fr), "+v"(fq));
        const int k = u.sub >> 1, wid = wr * 4 + wc;
        const int lane16 = fr * 16 + fq * 256;
        char* gp = (char*)gst + wid * 16384 + lane16;
        char* mp = (char*)mst + wid * 32768 + lane16;
        if ((u.sub & 1) == 0) {
            const float* bp = bg + k * 1024 + u.pn * 256 + wc * 32 + 8 * fq;
#pragma unroll
            for (int bj = 0; bj < 2; ++bj) {
                const f32x4 b0 = *(const f32x4*)(bp + bj * 128), b1 = *(const f32x4*)(bp + bj * 128 + 4);
#pragma unroll
                for (int ai = 0; ai < 2; ++ai)
#pragma unroll
                    for (int m = 0; m < 4; ++m) {
                        const f32x4 v0 = acc[ai][bj][m][0] + b0, v1 = acc[ai][bj][m][1] + b1;
                        float g[8];
#pragma unroll
                        for (int j = 0; j < 4; ++j) { g[j] = 1.f / (1.f + __expf(-v0[j])); g[4 + j] = 1.f / (1.f + __expf(-v1[j])); }
                        const int gi = (ai * 2 + bj) * 4 + m;
                        u32x4 w; w.x = cvt_pk_bf16(g[0], g[1]); w.y = cvt_pk_bf16(g[2], g[3]); w.z = cvt_pk_bf16(g[4], g[5]); w.w = cvt_pk_bf16(g[6], g[7]);
                        *(u32x4*)(gp + gi * 1024) = w;
                        asm volatile("" ::: "memory"); __builtin_amdgcn_sched_barrier(0);
                    }
            }
        } else {
#pragma unroll
            for (int ai = 0; ai < 2; ++ai)
#pragma unroll
                for (int m = 0; m < 4; ++m) {
                    const int row = u.pm * 256 + ai * 128 + wr * 64 + m * 16 + fr;
#pragma unroll
                    for (int bj = 0; bj < 2; ++bj) {
                        const int gi = (ai * 2 + bj) * 4 + m;
                        const u32x4 g = *(const u32x4*)(gp + gi * 1024);
                        const f32x4 p0 = acc[ai][bj][m][0], p1 = acc[ai][bj][m][1];
                        f32x4 s0, s1;
                        s0[0] = bf_lo(g.x) * p0[0]; s0[1] = bf_hi(g.x) * p0[1]; s0[2] = bf_lo(g.y) * p0[2]; s0[3] = bf_hi(g.y) * p0[3];
                        s1[0] = bf_lo(g.z) * p1[0]; s1[1] = bf_hi(g.z) * p1[1]; s1[2] = bf_lo(g.w) * p1[2]; s1[3] = bf_hi(g.w) * p1[3];
                        if (k > 0) { s0 += *(const f32x4*)(mp + gi * 2048); s1 += *(const f32x4*)(mp + gi * 2048 + 1024); }
                        if (k < 3) { *(f32x4*)(mp + gi * 2048) = s0; *(f32x4*)(mp + gi * 2048 + 1024) = s1; }
                        else {
                            u32x4 w; w.x = cvt_pk_bf16(s0[0], s0[1]); w.y = cvt_pk_bf16(s0[2], s0[3]); w.z = cvt_pk_bf16(s1[0], s1[1]); w.w = cvt_pk_bf16(s1[2], s1[3]);
                            *(u32x4*)(M + (size_t)row * DM + u.pn * 256 + bj * 128 + wc * 32 + 8 * fq) = w;
                        }
                    }
                    asm volatile("" ::: "memory"); __builtin_amdgcn_sched_barrier(0);
                }
        }
    }
};
struct EpiOut {
    const float* xin; float* xout; long long din, dout; const float* mods;
    __device__ __forceinline__ void operator()(const AccT& acc, const gm::GUnit& u, int wr, int wc, int fr, int fq) const {
        asm volatile("" : "+v"(fr), "+v"(fq));
        const bool lat = u.pm < 256;
        const int b = lat ? (u.pm >> 5) : 8;
        const float* gp = mods + (size_t)b * 6144 + 2 * 1024 + u.pn * 256 + wc * 32 + 4 * fq;
        f32x4 gv[2][2];
#pragma unroll
        for (int bj = 0; bj < 2; ++bj)
#pragma unroll
            for (int n = 0; n < 2; ++n) gv[bj][n] = *(const f32x4*)(gp + bj * 128 + n * 16);
#pragma unroll
        for (int ai = 0; ai < 2; ++ai)
#pragma unroll
            for (int m = 0; m < 4; ++m) {
                const int row = u.pm * 256 + ai * 128 + wr * 64 + m * 16 + fr;
                const size_t off = (size_t)row * DM + u.pn * 256 + wc * 32 + 4 * fq;
                const float* ip = xin + off + (lat ? 0ll : din); float* op = xout + off + (lat ? 0ll : dout);
#pragma unroll
                for (int bj = 0; bj < 2; ++bj)
#pragma unroll
                    for (int n = 0; n < 2; ++n) { const f32x4 xv = *(const f32x4*)(ip + bj * 128 + n * 16); *(f32x4*)(op + bj * 128 + n * 16) = xv + gv[bj][n] * acc[ai][bj][m][n]; }
            }
    }
};
struct EpiGU {
    bf16_t* act; const float* bgate; const float* bup;
    __device__ __forceinline__ void operator()(const AccT& acc, const gm::GUnit& u, int wr, int wc, int fr, int fq) const {
        asm volatile("" : "+v"(fr), "+v"(fq));
#pragma unroll
        for (int bj = 0; bj < 2; ++bj) {
            const int col = u.pn * 128 + bj * 64 + wc * 16 + 4 * fq;
            const f32x4 bgv = *(const f32x4*)(bgate + u.e * 1024 + col), buv = *(const f32x4*)(bup + u.e * 1024 + col);
#pragma unroll
            for (int ai = 0; ai < 2; ++ai)
#pragma unroll
                for (int m = 0; m < 4; ++m) {
                    const int row = u.pm * 256 + ai * 128 + wr * 64 + m * 16 + fr;
                    const f32x4 a4 = acc[ai][bj][m][0] + bgv, u4 = acc[ai][bj][m][1] + buv;
                    float o[4];
#pragma unroll
                    for (int j = 0; j < 4; ++j) {
                        const float a = fminf(a4[j], 7.f), uu = fminf(fmaxf(u4[j], -7.f), 7.f);
                        o[j] = a / (1.f + __expf(-1.702f * a)) * (uu + 1.f);
                    }
                    u32x2 w; w.x = cvt_pk_bf16(o[0], o[1]); w.y = cvt_pk_bf16(o[2], o[3]);
                    *(u32x2*)(act + (size_t)row * DM + col) = w;
                }
        }
    }
};
struct EpiDown {
    float* xout; long long dout; const float* mods; const float* bd; const int* rtok; const float* rw;
    __device__ __forceinline__ void operator()(const AccT& acc, const gm::GUnit& u, int wr, int wc, int fr, int fq) const {
        asm volatile("" : "+v"(fr), "+v"(fq));
        const int col = u.pn * 256 + wc * 32 + 4 * fq;
        f32x4 bv[2][2];
#pragma unroll
        for (int bj = 0; bj < 2; ++bj)
#pragma unroll
            for (int n = 0; n < 2; ++n) bv[bj][n] = *(const f32x4*)(bd + u.e * 1024 + col + bj * 128 + n * 16);
#pragma unroll
        for (int ai = 0; ai < 2; ++ai)
#pragma unroll
            for (int m = 0; m < 4; ++m) {
                const int row = u.pm * 256 + ai * 128 + wr * 64 + m * 16 + fr;
                const int tok = rtok[row];
                if (tok >= 0) {
                    const float w = rw[row];
                    const bool lat = tok < TL;
                    const int b = lat ? (tok >> 13) : 8;
                    float* xp = xout + (size_t)tok * DM + (lat ? 0ll : dout) + col;
                    const float* gp = mods + (size_t)b * 6144 + 5 * 1024 + col;
#pragma unroll
                    for (int bj = 0; bj < 2; ++bj)
#pragma unroll
                        for (int n = 0; n < 2; ++n) {
                            const f32x4 gv = *(const f32x4*)(gp + bj * 128 + n * 16);
                            const f32x4 xv = *(const f32x4*)(xp + bj * 128 + n * 16);
                            *(f32x4*)(xp + bj * 128 + n * 16) = xv + gv * w * (acc[ai][bj][m][n] + bv[bj][n]);
                        }
                }
            }
    }
};

namespace at {
constexpr int SHM_V = 64 * 128 * 2, SHM_K = 64 * 64 * 2;
constexpr int OFF_V = 0, OFF_K = 2 * SHM_V, OFF_WS = OFF_K + 2 * SHM_K, OFF_STASH = OFF_WS + 8 * 64 * 4;
constexpr float SCALE = 0.125f, THR = 8.f;
#define AT_KSWZ(row, colB) ((row) * 128 + ((colB) ^ ((((row) >> 1) & 7) << 4)))
#define AT_SBAR() __builtin_amdgcn_sched_barrier(0)
__device__ __forceinline__ int crow(int r, int hi) { return (r & 3) + 8 * (r >> 2) + 4 * hi; }

__device__ __forceinline__ void partialSM(f32x16& p0, f32x16& p1, float& m_reg, float& mn, float& alpha) {
    constexpr float C = SCALE * 1.4426950408889634f;
    float pmax = p0[0];
#pragma unroll
    for (int r = 1; r < 16; ++r) pmax = fmaxf(pmax, p0[r]);
#pragma unroll
    for (int r = 0; r < 16; ++r) pmax = fmaxf(pmax, p1[r]);
    { auto rr = __builtin_amdgcn_permlane32_swap(__float_as_uint(pmax), __float_as_uint(pmax), false, false);
      pmax = fmaxf(__uint_as_float(rr[0]), __uint_as_float(rr[1])); }
    if (__builtin_expect(__all(pmax - m_reg <= THR / SCALE), 1)) { mn = m_reg; alpha = 1.f; }
    else { mn = fmaxf(m_reg, pmax); alpha = __builtin_amdgcn_exp2f((m_reg - mn) * C); m_reg = mn; }
    const float mnC = -mn * C;
#pragma unroll
    for (int r = 0; r < 16; ++r) p0[r] = fmaf(p0[r], C, mnC);
#pragma unroll
    for (int r = 0; r < 16; ++r) p1[r] = fmaf(p1[r], C, mnC);
#pragma unroll
    for (int r = 0; r < 16; ++r) p0[r] = __builtin_amdgcn_exp2f(p0[r]);
}
__device__ __forceinline__ void finishSM(f32x16& p0, f32x16& p1, float alpha, float& l_reg, bf16x8& pa0, bf16x8& pa1, bf16x8& pa2, bf16x8& pa3) {
#pragma unroll
    for (int r = 0; r < 16; ++r) p1[r] = __builtin_amdgcn_exp2f(p1[r]);
    float ps = 0;
#pragma unroll
    for (int r = 0; r < 16; ++r) ps += p0[r];
#pragma unroll
    for (int r = 0; r < 16; ++r) ps += p1[r];
    { auto rr = __builtin_amdgcn_permlane32_swap(__float_as_uint(ps), __float_as_uint(ps), false, false);
      ps = __uint_as_float(rr[0]) + __uint_as_float(rr[1]); }
    l_reg = l_reg * alpha + ps;
#define AT_PK4(P, BASE, OUT) do { unsigned a0 = cvt_pk_bf16(P[BASE + 0], P[BASE + 1]), a1 = cvt_pk_bf16(P[BASE + 2], P[BASE + 3]);   \
    unsigned b0 = cvt_pk_bf16(P[BASE + 4], P[BASE + 5]), b1 = cvt_pk_bf16(P[BASE + 6], P[BASE + 7]);                              \
    auto r0 = __builtin_amdgcn_permlane32_swap(a0, b0, false, false); auto r1 = __builtin_amdgcn_permlane32_swap(a1, b1, false, false); \
    u32x4 w = {r0[0], r1[0], r0[1], r1[1]}; OUT = *reinterpret_cast<bf16x8*>(&w); } while (0)
    AT_PK4(p0, 0, pa0); AT_PK4(p0, 8, pa1); AT_PK4(p1, 0, pa2); AT_PK4(p1, 8, pa3);
#undef AT_PK4
}
__device__ __forceinline__ void qkt(f32x16& p0, f32x16& p1, const LAS char* Ks, const bf16x8* qr, int r32, int hi) {
    p0 = f32x16{}; p1 = f32x16{};
#pragma unroll
    for (int d0 = 0; d0 < 4; ++d0) { const int cb = (d0 * 16 + hi * 8) * 2;
        const bf16x8 b0 = *(const LAS bf16x8*)(Ks + AT_KSWZ(r32, cb));
        const bf16x8 b1 = *(const LAS bf16x8*)(Ks + AT_KSWZ(32 + r32, cb));
        p0 = __builtin_amdgcn_mfma_f32_32x32x16_bf16(b0, qr[d0], p0, 0, 0, 0);
        p1 = __builtin_amdgcn_mfma_f32_32x32x16_bf16(b1, qr[d0], p1, 0, 0, 0); }
}
__device__ __forceinline__ int v_st(int k, int c) { const int kk = (k & ~0xC) | ((k & 4) << 1) | ((k & 8) >> 1); return ((kk >> 3) * 4 + (c >> 5)) * 512 + ((kk & 7) * 32 + (c & 31)) * 2; }
__device__ __forceinline__ int v_rd_base(int lane) { return ((lane & 3) << 3) | (((lane >> 2) & 3) << 6) | (((lane >> 4) & 1) << 5) | (((lane >> 5) & 1) << 8); }
constexpr int v_rd_off(int d0, int ks, int half) { return d0 * 512 + ks * 4096 + half * 2048; }
template <int OFF> __device__ __forceinline__ s16x4 tr_read(int vb) {
    s16x4 r; asm volatile("ds_read_b64_tr_b16 %0, %1 offset:%2" : "=&v"(r) : "v"(vb), "i"(OFF) : "memory"); return r;
}
#define AT_PKV(L, H) (bf16x8){L[0], L[1], L[2], L[3], H[0], H[1], H[2], H[3]}
template <int D0> __device__ __forceinline__ void pv_one(f32x16& od, int vb, bf16x8 pa0, bf16x8 pa1, bf16x8 pa2, bf16x8 pa3) {
    const s16x4 l0 = tr_read<v_rd_off(D0, 0, 0)>(vb), h0 = tr_read<v_rd_off(D0, 0, 1)>(vb), l1 = tr_read<v_rd_off(D0, 1, 0)>(vb), h1 = tr_read<v_rd_off(D0, 1, 1)>(vb);
    const s16x4 l2 = tr_read<v_rd_off(D0, 2, 0)>(vb), h2 = tr_read<v_rd_off(D0, 2, 1)>(vb), l3 = tr_read<v_rd_off(D0, 3, 0)>(vb), h3 = tr_read<v_rd_off(D0, 3, 1)>(vb);
    asm volatile("s_waitcnt lgkmcnt(0)" ::: "memory"); AT_SBAR();
    od = __builtin_amdgcn_mfma_f32_32x32x16_bf16(pa0, AT_PKV(l0, h0), od, 0, 0, 0);
    od = __builtin_amdgcn_mfma_f32_32x32x16_bf16(pa1, AT_PKV(l1, h1), od, 0, 0, 0);
    od = __builtin_amdgcn_mfma_f32_32x32x16_bf16(pa2, AT_PKV(l2, h2), od, 0, 0, 0);
    od = __builtin_amdgcn_mfma_f32_32x32x16_bf16(pa3, AT_PKV(l3, h3), od, 0, 0, 0);
}
__device__ __forceinline__ void pv_d0(f32x16* o, int vb, bf16x8 pa0, bf16x8 pa1, bf16x8 pa2, bf16x8 pa3) {
    pv_one<0>(o[0], vb, pa0, pa1, pa2, pa3); pv_one<1>(o[1], vb, pa0, pa1, pa2, pa3); pv_one<2>(o[2], vb, pa0, pa1, pa2, pa3); pv_one<3>(o[3], vb, pa0, pa1, pa2, pa3);
}

__device__ __forceinline__ void attn_pass(const bf16_t* __restrict__ proj, LAS char* lds, int qrow0, int ctxrow0, int latrow0, int NT, int h, int comp, f32x16 (&o)[4]) {
    int tid = threadIdx.x; asm volatile("" : "+v"(tid));
    const int wid = tid >> 6, lane = tid & 63, r32 = lane & 31, hi = lane >> 5;
    LAS char* V_lds = lds + OFF_V; LAS char* K_lds = lds + OFF_K;
    LAS float* ws = (LAS float*)(lds + OFF_WS) + wid * 64; LAS float* li_l = ws; LAS float* al_l = ws + 32;
    float m_reg = -1e30f, l_reg = 0.f;
#pragma unroll
    for (int d = 0; d < 4; ++d) o[d] = f32x16{};
    bf16x8 qr[4];
    { const bf16_t* Qw = proj + (size_t)(qrow0 + wid * 32 + r32) * INW + C_Q + h * 128 + comp * 64 + hi * 8;
#pragma unroll
      for (int d0 = 0; d0 < 4; ++d0) qr[d0] = *(const bf16x8*)(Qw + d0 * 16); }
    const int sr = tid >> 4, sc = (tid & 15) * 8, vst0 = v_st(sr, sc), vst1 = v_st(32 + sr, sc);
    const int kr = tid >> 3, kc = (tid & 7) * 8, kst = AT_KSWZ(kr, kc * 2);
    const int vb0 = (int)(uintptr_t)V_lds + v_rd_base(lane);
    const char* pb = (const char*)proj;
    const unsigned voV0 = (unsigned)((sr * INW + C_V + h * 128 + sc) * 2), voV1 = voV0 + 32u * INW * 2u, voK = (unsigned)((kr * INW + C_K + h * 128 + comp * 64 + kc) * 2);
    bf16x8 vsA0, vsA1, ksA, vsB0, vsB1, ksB;
#define AT_ROW(j) ((j) < 4 ? ctxrow0 + (j) * 64 : latrow0 + ((j) - 4) * 64)
#define AT_SLOAD(S, j) do { const char* _p = pb + (size_t)__builtin_amdgcn_readfirstlane(AT_ROW(j)) * (INW * 2); vs##S##0 = *(const bf16x8*)(_p + voV0); vs##S##1 = *(const bf16x8*)(_p + voV1); \
        ks##S = *(const bf16x8*)(_p + voK); } while (0)
#define AT_SWRITE(b, S) do { *(LAS bf16x8*)(V_lds + (b) * SHM_V + vst0) = vs##S##0; *(LAS bf16x8*)(V_lds + (b) * SHM_V + vst1) = vs##S##1; \
        *(LAS bf16x8*)(K_lds + (b) * SHM_K + kst) = ks##S; } while (0)
#define AT_SWAIT() asm volatile("s_waitcnt vmcnt(3)" ::: "memory")
#define AT_RESC(a) do { if (__any((a) < 1.f)) { if (hi == 0) al_l[r32] = (a); asm volatile("s_waitcnt lgkmcnt(0)" ::: "memory"); \
        _Pragma("unroll") for (int d = 0; d < 4; ++d) _Pragma("unroll") for (int r = 0; r < 16; ++r) o[d][r] *= al_l[crow(r, hi)]; } } while (0)
    f32x16 pA0, pA1, pB0, pB1; float mnA, mnB, alA, alB; bf16x8 pa0, pa1, pa2, pa3;
    AT_SLOAD(A, 0); asm volatile("s_waitcnt vmcnt(0)" ::: "memory"); AT_SWRITE(0, A); __syncthreads();
    qkt(pA0, pA1, K_lds, qr, r32, hi); partialSM(pA0, pA1, m_reg, mnA, alA);
    AT_SLOAD(B, 1); if (2 < NT) AT_SLOAD(A, 2);
    AT_SWAIT(); AT_SWRITE(1, B); __syncthreads();
    for (int j = 1; j + 1 < NT; j += 2) {
        AT_SBAR(); qkt(pB0, pB1, K_lds + SHM_K, qr, r32, hi);
        finishSM(pA0, pA1, alA, l_reg, pa0, pa1, pa2, pa3); AT_SBAR();
        AT_SLOAD(B, j + 2); AT_SBAR();
        pv_d0(o, vb0, pa0, pa1, pa2, pa3); partialSM(pB0, pB1, m_reg, mnB, alB);
        __syncthreads(); AT_SWAIT(); AT_SWRITE(0, A);
        AT_RESC(alB); __syncthreads();
        AT_SBAR(); qkt(pA0, pA1, K_lds, qr, r32, hi);
        finishSM(pB0, pB1, alB, l_reg, pa0, pa1, pa2, pa3); AT_SBAR();
        if (j + 3 < NT) AT_SLOAD(A, j + 3); AT_SBAR();
        pv_d0(o, vb0 + SHM_V, pa0, pa1, pa2, pa3); partialSM(pA0, pA1, m_reg, mnA, alA);
        __syncthreads(); AT_SWAIT(); AT_SWRITE(1, B);
        AT_RESC(alA); __syncthreads();
    }
    AT_SBAR(); qkt(pB0, pB1, K_lds + SHM_K, qr, r32, hi);
    finishSM(pA0, pA1, alA, l_reg, pa0, pa1, pa2, pa3); AT_SBAR();
    pv_d0(o, vb0, pa0, pa1, pa2, pa3); partialSM(pB0, pB1, m_reg, mnB, alB);
    __syncthreads(); AT_RESC(alB);
    finishSM(pB0, pB1, alB, l_reg, pa0, pa1, pa2, pa3); AT_SBAR();
    pv_d0(o, vb0 + SHM_V, pa0, pa1, pa2, pa3);
    if (hi == 0) li_l[r32] = l_reg;
    asm volatile("s_waitcnt lgkmcnt(0)" ::: "memory");
#pragma unroll
    for (int r = 0; r < 16; ++r) { const float rl = __builtin_amdgcn_rcpf(li_l[crow(r, hi)]);
#pragma unroll
        for (int d = 0; d < 4; ++d) o[d][r] *= rl; }
    __syncthreads();
#undef AT_ROW
#undef AT_SLOAD
#undef AT_SWRITE
#undef AT_SWAIT
#undef AT_RESC
}

__device__ __forceinline__ void attn_unit(bf16_t* __restrict__ proj, LAS char* lds, int qrow0, int b, int h, int NT, float lam, float post, const float* __restrict__ gsub) {
    int tid = threadIdx.x; asm volatile("" : "+v"(tid));
    const int wid = tid >> 6, lane = tid & 63, r32 = lane & 31, hi = lane >> 5;
    const int ctxrow0 = TL + b * CTXL, latrow0 = b * SEQ;
    LAS unsigned* stash = (LAS unsigned*)(lds + OFF_STASH);
    f32x16 o[4];
#pragma unroll 1
    for (int comp = 0; comp < 2; ++comp) {
        attn_pass(proj, lds, qrow0, ctxrow0, latrow0, NT, h, comp, o);
        if (comp == 0) {
#pragma unroll
            for (int d = 0; d < 4; ++d)
#pragma unroll
                for (int r = 0; r < 16; r += 2) stash[(d * 8 + (r >> 1)) * NTHR + tid] = cvt_pk_bf16(o[d][r], o[d][r + 1]);
        }
    }
    float ss[16];
#pragma unroll
    for (int r = 0; r < 16; ++r) ss[r] = 0.f;
#pragma unroll
    for (int d = 0; d < 4; ++d)
#pragma unroll
        for (int r = 0; r < 16; r += 2) {
            const unsigned w = stash[(d * 8 + (r >> 1)) * NTHR + tid];
            const float a0 = bf_lo(w) - lam * o[d][r], a1 = bf_hi(w) - lam * o[d][r + 1];
            o[d][r] = a0; o[d][r + 1] = a1; ss[r] += a0 * a0; ss[r + 1] += a1 * a1;
        }
#pragma unroll
    for (int r = 0; r < 16; ++r) {
        float v = ss[r];
        v += __shfl_xor(v, 1); v += __shfl_xor(v, 2); v += __shfl_xor(v, 4); v += __shfl_xor(v, 8); v += __shfl_xor(v, 16);
        ss[r] = rsqrtf(v * (1.f / 128.f) + EPS) * post;
    }
    bf16_t* Ow = proj + (size_t)(qrow0 + wid * 32) * INW + C_Q + h * 128;
#pragma unroll
    for (int d = 0; d < 4; ++d) { const float g = gsub[d * 32 + r32];
#pragma unroll
        for (int r = 0; r < 16; ++r) Ow[(size_t)crow(r, hi) * INW + d * 32 + r32] = f2bf(o[d][r] * ss[r] * g); }
}
}

__device__ __forceinline__ void phase_attn(const Frame& F, const Params& P, int l) {
    const float lam = F.lam()[l], lam_init = 0.8f - 0.6f * expf(-0.3f * (float)l), post = 1.f - lam_init;
    const float* gsub = P.g_subln + l * 128;
    const int nlat = NB * 4 * 32, nun = nlat + (l == 0 ? NB * 4 : 0);
    for (int i = 0;; ++i) {
        int u = i * F.nwg + F.wg;
        if (F.nwg == 256 && i < 4) u = ((i * 8 + (F.wg & 7)) << 5) + (F.wg >> 3);
        if (u >= nun) break;
        int qrow0, b, h, NT;
        if (u < nlat) { b = u >> 7; h = (u >> 5) & 3; qrow0 = b * SEQ + (u & 31) * 256; NT = 132; }
        else { const int v = u - nlat; b = v >> 2; h = v & 3; qrow0 = TL + b * CTXL; NT = 4; }
        at::attn_unit(F.proj(), (LAS char*)F.lds, qrow0, b, h, NT, lam, post, gsub);
    }
}

namespace ff {
using at::tr_read; using at::v_rd_off; using at::v_st; using at::v_rd_base; using at::crow;
template <int D0> __device__ __forceinline__ void pv_two(f32x16& od1, f32x16& od2, int vb, const bf16x8 (&a1)[4], const bf16x8 (&a2)[4]) {
    const s16x4 l0 = tr_read<v_rd_off(D0, 0, 0)>(vb), h0 = tr_read<v_rd_off(D0, 0, 1)>(vb), l1 = tr_read<v_rd_off(D0, 1, 0)>(vb), h1 = tr_read<v_rd_off(D0, 1, 1)>(vb);
    const s16x4 l2 = tr_read<v_rd_off(D0, 2, 0)>(vb), h2 = tr_read<v_rd_off(D0, 2, 1)>(vb), l3 = tr_read<v_rd_off(D0, 3, 0)>(vb), h3 = tr_read<v_rd_off(D0, 3, 1)>(vb);
    asm volatile("s_waitcnt lgkmcnt(0)" ::: "memory"); __builtin_amdgcn_sched_barrier(0);
    const bf16x8 b0 = AT_PKV(l0, h0), b1 = AT_PKV(l1, h1), b2 = AT_PKV(l2, h2), b3 = AT_PKV(l3, h3);
    od1 = __builtin_amdgcn_mfma_f32_32x32x16_bf16(a1[0], b0, od1, 0, 0, 0); od2 = __builtin_amdgcn_mfma_f32_32x32x16_bf16(a2[0], b0, od2, 0, 0, 0);
    od1 = __builtin_amdgcn_mfma_f32_32x32x16_bf16(a1[1], b1, od1, 0, 0, 0); od2 = __builtin_amdgcn_mfma_f32_32x32x16_bf16(a2[1], b1, od2, 0, 0, 0);
    od1 = __builtin_amdgcn_mfma_f32_32x32x16_bf16(a1[2], b2, od1, 0, 0, 0); od2 = __builtin_amdgcn_mfma_f32_32x32x16_bf16(a2[2], b2, od2, 0, 0, 0);
    od1 = __builtin_amdgcn_mfma_f32_32x32x16_bf16(a1[3], b3, od1, 0, 0, 0); od2 = __builtin_amdgcn_mfma_f32_32x32x16_bf16(a2[3], b3, od2, 0, 0, 0);
}
}

__device__ __forceinline__ void phase_fft_a(const Frame& F) {
    const int tid = F.tid, wid = F.wid, lane = F.lane, r32 = lane & 31, hi = lane >> 5;
    LAS char* Vt = (LAS char*)F.lds;
    const int sr = tid >> 4, sc = (tid & 15) * 8;
    const int rb = wid & 3, chh = wid >> 2;
    const bf16_t* dc = F.dft(); const bf16_t* ds = F.dft() + 16384;
    for (int u = F.wg; u < NB * 64 * 4; u += F.nwg) {
        const int b = u >> 8, n2 = (u >> 2) & 63, cb = u & 3;
#pragma unroll
        for (int t = 0; t < 2; ++t)
#pragma unroll
            for (int hf = 0; hf < 2; ++hf) {
                const int key = hf * 32 + sr, n1 = t * 64 + key;
                const bf16x8 v = *(const bf16x8*)(F.proj() + (size_t)(b * SEQ + 64 * n1 + n2) * INW + C_FX + cb * 128 + sc);
                *(LAS bf16x8*)(Vt + t * 16384 + ff::v_st(key, sc)) = v;
            }
        __syncthreads();
        f32x16 zc[2] = {f32x16{}, f32x16{}}, zs[2] = {f32x16{}, f32x16{}};
#pragma unroll
        for (int t = 0; t < 2; ++t) {
            bf16x8 ac[4], as[4];
#pragma unroll
            for (int ks = 0; ks < 4; ++ks) { const int o = (32 * rb + r32) * 128 + t * 64 + ks * 16 + hi * 8; ac[ks] = *(const bf16x8*)(dc + o); as[ks] = *(const bf16x8*)(ds + o); }
            const int vb = (int)(uintptr_t)Vt + t * 16384 + ff::v_rd_base(lane) + chh * 1024;
            ff::pv_two<0>(zc[0], zs[0], vb, ac, as);
            ff::pv_two<1>(zc[1], zs[1], vb, ac, as);
        }
#pragma unroll
        for (int r = 0; r < 16; ++r) {
            const int k1 = 32 * rb + ff::crow(r, hi);
            const f32x2 t2 = *(const f32x2*)(F.tw() + (size_t)(k1 * 64 + n2) * 2);
            bf16_t* zp = F.zm() + (size_t)((b * 128 + k1) * 64 + n2) * DM + cb * 128 + 64 * chh + r32;
#pragma unroll
            for (int dd = 0; dd < 2; ++dd) {
                const float c = zc[dd][r], s = zs[dd][r];
                zp[dd * 32] = f2bf(c * t2.x - s * t2.y); zp[512 + dd * 32] = f2bf(c * t2.y + s * t2.x);
            }
        }
        __syncthreads();
    }
}

__device__ __forceinline__ void phase_fft_b(const Frame& F) {
    const int tid = F.tid, wid = F.wid, lane = F.lane, r32 = lane & 31, hi = lane >> 5;
    LAS char* Vt = (LAS char*)F.lds;
    const int sr = tid >> 4, sc = (tid & 15) * 8;
    const int rb = wid & 1, cq = wid >> 1;
    const bf16_t* dc = F.dft() + 32768; const bf16_t* ds = dc + 4096; const bf16_t* dn = dc + 8192;
    bf16x8 ac[4], as[4], an[4];
#pragma unroll
    for (int ks = 0; ks < 4; ++ks) { const int o = (32 * rb + r32) * 64 + ks * 16 + hi * 8; ac[ks] = *(const bf16x8*)(dc + o); as[ks] = *(const bf16x8*)(ds + o); an[ks] = *(const bf16x8*)(dn + o); }
    for (int u = F.wg; u < NB * 128 * 4; u += F.nwg) {
        const int b = u >> 9, k1 = (u >> 2) & 127, cb = u & 3;
#pragma unroll
        for (int t = 0; t < 2; ++t)
#pragma unroll
            for (int hf = 0; hf < 2; ++hf) {
                const int key = hf * 32 + sr;
                const bf16x8 v = *(const bf16x8*)(F.zm() + (size_t)((b * 128 + k1) * 64 + key) * DM + t * 512 + cb * 128 + sc);
                *(LAS bf16x8*)(Vt + t * 16384 + ff::v_st(key, sc)) = v;
            }
        __syncthreads();
        f32x16 ar = f32x16{}, bi = f32x16{};
        const int vbP = (int)(uintptr_t)Vt + ff::v_rd_base(lane) + cq * 512;
        ff::pv_two<0>(ar, bi, vbP, ac, as);
        ff::pv_two<0>(ar, bi, vbP + 16384, an, ac);
#pragma unroll
        for (int r = 0; r < 16; ++r) {
            const int k2 = 32 * rb + ff::crow(r, hi), np = k1 + 128 * k2;
            bf16_t* op = F.proj() + (size_t)(b * SEQ + np) * INW + cb * 128 + 32 * cq + r32;
            op[C_K] = f2bf(ar[r] * 0.011048543456039806f); op[C_V] = f2bf(bi[r] * 0.011048543456039806f);
        }
        __syncthreads();
    }
}

__device__ __forceinline__ void phase_norm2_route(const Frame& F, const Params& P, int l, int nrows, long long dctx) {
    LAS float* wl = (LAS float*)F.lds;
    LAS int* hist = (LAS int*)(F.lds + 16 * 64 * 33 * 4);
    const float* wr = P.w_router + (size_t)l * DM * NEXP;
    for (int i = F.tid; i < DM * NEXP; i += NTHR) {
        const int col = i >> 5, e = i & 31, ln = (col & 255) >> 2, slot = (col >> 8) * 4 + (col & 3);
        wl[(slot * 64 + ln) * 33 + e] = wr[i];
    }
    if (F.tid < 128) hist[F.tid] = 0;
    __syncthreads();
    const float* g = P.g_norm2 + l * DM;
    const float* br = P.b_router + l * NEXP;
    for (int row = F.wg * 8 + F.wid; row < nrows; row += F.nwg * 8) {
        const float* xr = xrow_ptr(P.out, dctx, row);
        const int b = row < TL ? (row >> 13) : 8;
        const float* md = F.mods() + (size_t)(l * 9 + b) * 6144;
        f32x4 v[4]; float ss = 0.f;
#pragma unroll
        for (int j = 0; j < 4; ++j) { v[j] = *(const f32x4*)(xr + F.lane * 4 + 256 * j); ss += v[j][0] * v[j][0] + v[j][1] * v[j][1] + v[j][2] * v[j][2] + v[j][3] * v[j][3]; }
        ss = wave_sum(ss);
        const float rstd = rsqrtf(ss * (1.f / 1024.f) + EPS);
        float lg[32];
#pragma unroll
        for (int e = 0; e < 32; ++e) lg[e] = 0.f;
#pragma unroll
        for (int j = 0; j < 4; ++j) {
            const int col = F.lane * 4 + 256 * j;
            const f32x4 gg = *(const f32x4*)(g + col), sh = *(const f32x4*)(md + 3 * 1024 + col), sc = *(const f32x4*)(md + 4 * 1024 + col);
            float o[4];
#pragma unroll
            for (int i = 0; i < 4; ++i) o[i] = v[j][i] * rstd * gg[i] * (1.f + sc[i]) + sh[i];
            u32x2 w; w.x = cvt_pk_bf16(o[0], o[1]); w.y = cvt_pk_bf16(o[2], o[3]);
            *(u32x2*)(F.H() + (size_t)row * DM + col) = w;
#pragma unroll
            for (int i = 0; i < 4; ++i) {
                const LAS float* wp = wl + ((j * 4 + i) * 64 + F.lane) * 33;
#pragma unroll
                for (int e = 0; e < 32; ++e) lg[e] += o[i] * wp[e];
                asm volatile("" ::: "memory");
            }
        }
#pragma unroll
        for (int e = 0; e < 32; ++e) lg[e] = wave_sum(lg[e]) + br[e];
        int se[4]; float sv[4];
#pragma unroll
        for (int k = 0; k < 4; ++k) {
            float best = -3.0e38f; int bi = 0;
#pragma unroll
            for (int e = 0; e < 32; ++e) { const bool take = lg[e] > best; best = take ? lg[e] : best; bi = take ? e : bi; }
            se[k] = bi; sv[k] = best;
#pragma unroll
            for (int e = 0; e < 32; ++e) lg[e] = (e == bi) ? -3.0e38f : lg[e];
        }
        float w4[4], den = 0.f;
#pragma unroll
        for (int k = 0; k < 4; ++k) { w4[k] = __expf(sv[k] - sv[0]); den += w4[k]; }
        const float inv = 1.f / den;
#pragma unroll
        for (int k = 0; k < 4; ++k)
            if (F.lane == k) {
                F.sele()[(size_t)row * 4 + k] = se[k]; F.selw()[(size_t)row * 4 + k] = w4[k] * inv;
                __hip_atomic_fetch_add(&hist[k * 32 + se[k]], 1, __ATOMIC_RELAXED, __HIP_MEMORY_SCOPE_WORKGROUP);
            }
    }
    __syncthreads();
    if (F.tid < 128 && hist[F.tid] != 0) atomicAdd(F.ctl() + CW_CNT + l * 256 + F.tid, (unsigned)hist[F.tid]);
    __syncthreads();
}

__device__ __forceinline__ LAS int* moe_tb(const Frame& F) { return (LAS int*)(F.lds + LDS_MISC + 64); }
__device__ __forceinline__ void moe_build_tb(const Frame& F, int l) {
    LAS int* tb = moe_tb(F);
    if (F.tid < 4) {
        int acc = 0; tb[F.tid * 33] = 0;
        for (int e = 0; e < 32; ++e) { const unsigned c = __hip_atomic_load(F.ctl() + CW_CNT + l * 256 + F.tid * 32 + e, __ATOMIC_RELAXED, __HIP_MEMORY_SCOPE_AGENT); acc += (int)((c + 255u) >> 8); tb[F.tid * 33 + e + 1] = acc; }
    }
    __syncthreads();
}
__device__ __forceinline__ void phase_positions(const Frame& F, int l, int nrows) {
    LAS int* hist = (LAS int*)F.lds; LAS int* start = hist + 128; LAS int* rank = hist + 256;
    LAS int* tb = moe_tb(F);
    if (F.tid < 128) { hist[F.tid] = 0; rank[F.tid] = 0; }
    moe_build_tb(F, l);
    const int per = (nrows + F.nwg - 1) / F.nwg, t0 = F.wg * per, t1 = min(nrows, t0 + per);
    for (int i = t0 * 4 + F.tid; i < t1 * 4; i += NTHR) __hip_atomic_fetch_add(&hist[(i & 3) * 32 + F.sele()[i]], 1, __ATOMIC_RELAXED, __HIP_MEMORY_SCOPE_WORKGROUP);
    __syncthreads();
    if (F.tid < 128) start[F.tid] = hist[F.tid] ? (int)atomicAdd(F.ctl() + CW_CNT + l * 256 + 128 + F.tid, (unsigned)hist[F.tid]) : 0;
    __syncthreads();
    for (int i = t0 * 4 + F.tid; i < t1 * 4; i += NTHR) {
        const int k = i & 3, e = F.sele()[i], r = __hip_atomic_fetch_add(&rank[k * 32 + e], 1, __ATOMIC_RELAXED, __HIP_MEMORY_SCOPE_WORKGROUP);
        const int pos = tb[k * 33 + e] * 256 + start[k * 32 + e] + r;
        F.rtok()[(size_t)k * MAXROWS + pos] = i >> 2; F.rw()[(size_t)k * MAXROWS + pos] = F.selw()[i];
    }
    for (int q = F.wg; q < 128; q += F.nwg) {
        const int k = q >> 5, e = q & 31;
        const int cnt = (int)__hip_atomic_load(F.ctl() + CW_CNT + l * 256 + q, __ATOMIC_RELAXED, __HIP_MEMORY_SCOPE_AGENT);
        const int base = tb[k * 33 + e] * 256, end = tb[k * 33 + e + 1] * 256;
        for (int p = base + cnt + F.tid; p < end; p += NTHR) { F.rtok()[(size_t)k * MAXROWS + p] = -1; F.rw()[(size_t)k * MAXROWS + p] = 0.f; }
    }
    __syncthreads();
}

constexpr int NPHL = 16;
constexpr int NPHASE = 1 + 2 * NPHL + 1;

__device__ __forceinline__ void launder(Frame& F) { int t = threadIdx.x; asm volatile("" : "+v"(t)); F.tid = t; F.lane = t & 63; F.wid = __builtin_amdgcn_readfirstlane(t >> 6); }
__global__ void __launch_bounds__(NTHR, 2) fwd_kernel(Params prm) {
    extern __shared__ __attribute__((aligned(16))) unsigned char lds_raw[];
    Frame F;
    const Params& P = prm;
    F.tid = threadIdx.x; F.lane = F.tid & 63; F.wid = __builtin_amdgcn_readfirstlane(F.tid >> 6); F.wg = blockIdx.x; F.nwg = gridDim.x;
    F.lds = (LAS unsigned char*)lds_raw;
    F.ws = prm.ws;

    volatile LAS unsigned* misc = (volatile LAS unsigned*)(F.lds + LDS_MISC);
    if (F.tid < 16) misc[F.tid] = 0u;
    __syncthreads();
    const int lo = prm.ph_lo, hi = prm.ph_hi;
    XcdBarrier bar; bar.bar = F.ctl() + CW_BAR; bar.x = 0; bar.st = misc;
    if (hi - lo > 1) bar = xcd_barrier_post(F.ctl() + CW_BAR, misc);
#ifndef PH_MASK
#define PH_MASK 0xFFF
#endif
#define EN(g) (((PH_MASK) >> (g)) & 1)
#define IN(k) (lo <= (k) && (k) < hi)
#define SEAM(k) do { if (IN((k) + 1)) xcd_barrier(bar); } while (0)

    if (EN(0) && IN(0)) { launder(F); p0_prologue(F, P); SEAM(0); }

    for (int l = 0; l < NLAYER; ++l) {
        const int PB = 1 + l * NPHL;
        const int nrows = (l == 0) ? TA : TL;
        const float* modl = F.mods() + (size_t)l * 9 * 6144;
        const float* xs = (l == 0) ? prm.x : prm.out;
        const long long dxs = (long long)(F.ctxb() - xs) - (long long)TL * DM;
        const long long dout = (long long)(F.ctxb() - prm.out) - (long long)TL * DM;
        const long long dcin = (l == 0) ? (long long)(prm.ctx - xs) - (long long)TL * DM : dxs;
        if (EN(1) && IN(PB + 0)) { launder(F); phase_norm1(F, P, l, xs, dxs); SEAM(PB + 0); }
        if (EN(2) && IN(PB + 1)) {
            SchedProj S{(const char*)F.H(), (const char*)(F.win() + (size_t)l * INW * DM), l, F.nwg, F.wg};
            EpiProj E{F.proj(), F.rope()};
            gm::gemm_phase<true>(F.lds, S, E);
            SEAM(PB + 1);
        }
        if (EN(3) && IN(PB + 2)) {
#ifndef SUB3
#define SUB3 15
#endif
            launder(F); if (SUB3 & 1) phase_conv(F, P, l, nrows); launder(F);
            if (SUB3 & 2) phase_fft_a(F);
            launder(F); if ((SUB3 & 4) && l == 0) phase_ctx_dft(F); launder(F);
            if (SUB3 & 8) phase_attn(F, P, l);
            SEAM(PB + 2);
        }
        if (EN(4) && IN(PB + 3)) {
            launder(F); phase_fft_b(F);
            launder(F); phase_pool(F, nrows);
            launder(F); if (l == 0) phase_ctx_dft_copy(F);
            SEAM(PB + 3);
        }
        if (EN(5) && IN(PB + 4)) {
            SchedMerge S{(const char*)F.H(), (const char*)(F.wgate() + (size_t)l * INW * DM), (const char*)F.proj(), (const char*)(F.wbr() + (size_t)l * DM * WBR_K), (l == 0 ? 264 : 256) * 4, F.nwg, F.wg};
            EpiMerge E{F.gst(), F.mst(), prm.b_mgate + l * INW, F.zm()};
            gm::gemm_phase<true>(F.lds, S, E);
            SEAM(PB + 4);
        }
        if (EN(6) && IN(PB + 5)) {
            SchedOut S{(const char*)F.zm(), (const char*)(F.wout() + (size_t)l * DM * DM), (l == 0 ? 264 : 256) * 4, F.nwg, F.wg};
            EpiOut E{xs, prm.out, dcin, dout, modl};
            gm::gemm_phase<false>(F.lds, S, E);
            SEAM(PB + 5);
        }
        if (EN(7) && IN(PB + 6)) {
            launder(F); cvt_experts(F, P, l);
            launder(F); phase_norm2_route(F, P, l, nrows, dout);
            SEAM(PB + 6);
        }
        if (EN(8) && IN(PB + 7)) { launder(F); phase_positions(F, l, nrows); SEAM(PB + 7); }
        for (int k = 0; k < TOPK; ++k) {
            if (EN(9) && IN(PB + 8 + 2 * k)) {
                launder(F); moe_build_tb(F, l);
                SchedMoe<8, true> S{(const char*)F.H(), (const char*)F.gu(), F.rtok() + (size_t)k * MAXROWS, moe_tb(F) + k * 33, F.nwg, F.wg};
                EpiGU E{F.act(), prm.b_e_gate + (size_t)l * NEXP * DM, prm.b_e_up + (size_t)l * NEXP * DM};
                gm::gemm_phase<true>(F.lds, S, E);
                SEAM(PB + 8 + 2 * k);
            }
            if (EN(10) && IN(PB + 9 + 2 * k)) {
                launder(F); moe_build_tb(F, l);
                SchedMoe<4, false> S{(const char*)F.act(), (const char*)F.dn(), nullptr, moe_tb(F) + k * 33, F.nwg, F.wg};
                EpiDown E{prm.out, dout, modl, prm.b_e_down + (size_t)l * NEXP * DM, F.rtok() + (size_t)k * MAXROWS, F.rw() + (size_t)k * MAXROWS};
                gm::gemm_phase<false>(F.lds, S, E);
                SEAM(PB + 9 + 2 * k);
            }
        }
    }
    if (EN(11) && IN(NPHASE - 1)) { launder(F); phase_final(F, P); }
#undef IN
#undef SEAM
}

#ifndef N_LAUNCH_MODE
#define N_LAUNCH_MODE 0
#endif
extern "C" void kernel_launch(void* const* d_in, const int* in_sizes, int n_in, void* d_out, int out_size, void* d_ws, size_t ws_size, hipStream_t stream) {
    static int grid = 0;
    if (grid == 0) {
        if (n_in != 27 || out_size != TL * DM || ws_size < WS_END) { fprintf(stderr, "kernel_launch: unexpected shapes (n_in %d out %d ws %zu need %zu)\n", n_in, out_size, ws_size, (size_t)WS_END); grid = -1; return; }
        int dev = 0, cus = 0, per_cu = 0;
        if (hipGetDevice(&dev) != hipSuccess || hipDeviceGetAttribute(&cus, hipDeviceAttributeMultiprocessorCount, dev) != hipSuccess) { grid = -1; return; }
        if (hipFuncSetAttribute((const void*)fwd_kernel, hipFuncAttributeMaxDynamicSharedMemorySize, LDS_BYTES) != hipSuccess) { fprintf(stderr, "kernel_launch: hipFuncSetAttribute failed\n"); grid = -1; return; }
        if (hipOccupancyMaxActiveBlocksPerMultiprocessor(&per_cu, (const void*)fwd_kernel, NTHR, LDS_BYTES) != hipSuccess || per_cu < 1) { fprintf(stderr, "kernel_launch: occupancy query says %d\n", per_cu); }
        (void)hipGetLastError();
        grid = cus;
    }
    if (grid < 0) return;
    (void)hipMemsetAsync((char*)d_ws + WS_CTL, 0, CTL_BYTES, stream);
    Params p{};
    const float** pf = (const float**)&p;
    for (int i = 0; i < 27; ++i) pf[i] = (const float*)d_in[i];
    p.out = (float*)d_out; p.ws = (unsigned char*)d_ws;
#if N_LAUNCH_MODE == 0
    p.ph_lo = 0; p.ph_hi = NPHASE;
    hipLaunchKernelGGL(fwd_kernel, dim3(grid), dim3(NTHR), LDS_BYTES, stream, p);
#else
    for (int ph = 0; ph < NPHASE; ++ph) { p.ph_lo = ph; p.ph_hi = ph + 1; hipLaunchKernelGGL(fwd_kernel, dim3(grid), dim3(NTHR), LDS_BYTES, stream, p); }
#endif
    const hipError_t le = hipPeekAtLastError();
    if (le != hipSuccess) fprintf(stderr, "kernel_launch: launch failed: %s\n", hipGetErrorName(le));
}
```

```cpp
#include <hip/hip_runtime.h>
#include <stdint.h>
#include <stdio.h>

#define LAS __attribute__((address_space(3)))
typedef unsigned short bf16_t;
typedef short bf16x8 __attribute__((ext_vector_type(8)));
typedef short s16x4 __attribute__((ext_vector_type(4)));
typedef float f32x2 __attribute__((ext_vector_type(2)));
typedef float f32x4 __attribute__((ext_vector_type(4)));
typedef float f32x16 __attribute__((ext_vector_type(16)));
typedef unsigned u32x2 __attribute__((ext_vector_type(2)));
typedef unsigned u32x4 __attribute__((ext_vector_type(4)));

constexpr int DM = 1024, NB = 8, SEQ = 8192, CTXL = 256, NLAYER = 2;
constexpr int TL = NB * SEQ;
constexpr int TC = NB * CTXL;
constexpr int TA = TL + TC;
constexpr int INW = 4096;
constexpr int C_Q = 0, C_K = 512, C_V = 1024, C_SX = 1536, C_SB = 2048, C_SC = 2560, C_FX = 3072, C_PX = 3584;
constexpr int NEXP = 32, TOPK = 4;
constexpr int MAXROWS = 4 * TA + NEXP * 256;
constexpr int WBR_K = 2560;
constexpr float EPS = 1e-6f;
constexpr int NTHR = 512;

constexpr size_t al256(size_t x) { return (x + 255) & ~(size_t)255; }
constexpr size_t WS_CTL = 0, CTL_BYTES = 256 * 1024;
constexpr size_t WS_MODS = WS_CTL + CTL_BYTES;
constexpr size_t WS_ROPE = al256(WS_MODS + (size_t)2 * 9 * 6144 * 4);
constexpr size_t WS_TW = al256(WS_ROPE + 2 * 128 * 16 * 4);
constexpr size_t WS_DFT = al256(WS_TW + 128 * 64 * 2 * 4);
constexpr size_t WS_DFT256 = al256(WS_DFT + (size_t)(2 * 128 * 128 + 3 * 64 * 64) * 2);
constexpr size_t WS_LAM = al256(WS_DFT256 + (size_t)2 * 256 * 256 * 2);
constexpr size_t WS_CTXB = al256(WS_LAM + 256);
constexpr size_t WS_WIN = al256(WS_CTXB + (size_t)TC * DM * 4);
constexpr size_t WS_WGATE = al256(WS_WIN + (size_t)2 * INW * DM * 2);
constexpr size_t WS_WBR = al256(WS_WGATE + (size_t)2 * INW * DM * 2);
constexpr size_t WS_WOUT = al256(WS_WBR + (size_t)2 * DM * WBR_K * 2);
constexpr size_t WS_GU = al256(WS_WOUT + (size_t)2 * DM * DM * 2);
constexpr size_t WS_DN = al256(WS_GU + (size_t)NEXP * 2048 * DM * 2);
constexpr size_t WS_ACT2 = al256(WS_DN + (size_t)NEXP * 1024 * DM * 2);
constexpr size_t WS_G8 = WS_GU;
constexpr size_t WS_H = al256(WS_GU + (size_t)TA * INW);
static_assert(WS_ACT2 + (size_t)64 * 256 * 1024 * 2 <= WS_H, "remainder act tiles must fit in the slack of the gate-byte region");
constexpr size_t WS_PROJ = al256(WS_H + (size_t)TA * DM * 2);
constexpr size_t WS_ZM = al256(WS_PROJ + (size_t)TA * INW * 2);
constexpr size_t WS_SELE = al256(WS_ZM + (size_t)TA * DM * 2);
constexpr size_t WS_SELW = al256(WS_SELE + (size_t)TA * 4 * 4);
constexpr size_t WS_RTOK = al256(WS_SELW + (size_t)TA * 4 * 4);
constexpr size_t WS_RW = al256(WS_RTOK + (size_t)MAXROWS * 4);
constexpr size_t WS_CNTW = al256(WS_RW + (size_t)MAXROWS * 4);
constexpr size_t WS_END = al256(WS_CNTW + (size_t)1024 * 32 * 4);
constexpr size_t WS_MST = WS_H;
static_assert((size_t)TA * INW >= (size_t)NEXP * 3 * DM * DM * 2, "experts fit under the gate bytes");
static_assert((size_t)256 * 128 * 512 * 4 <= (size_t)TA * DM * 2, "stash fits in H");
constexpr size_t WS_Y = WS_PROJ;
constexpr size_t WS_ACTS = WS_ZM;
static_assert((size_t)256 * 256 * DM * 2 <= (size_t)TA * DM * 2, "act tiles fit in ZM");

constexpr int CW_BAR = 1024;
constexpr int CW_GUDONE = 6144;
constexpr int CW_CTXM = 6336;
constexpr int CW_ROUTED = 6464;
constexpr int CW_CNT = 8192;

constexpr int LDS_BYTES = 147456;
constexpr int LDS_MISC = 131072 + 12288;

__device__ __forceinline__ unsigned cvt_pk_bf16(float lo, float hi) { unsigned r; asm volatile("v_cvt_pk_bf16_f32 %0, %1, %2" : "=v"(r) : "v"(lo), "v"(hi)); return r; }
__device__ __forceinline__ float bf_lo(unsigned w) { return __uint_as_float(w << 16); }
__device__ __forceinline__ float bf_hi(unsigned w) { return __uint_as_float(w & 0xffff0000u); }
__device__ __forceinline__ float bf2f(bf16_t b) { return __uint_as_float(((unsigned)b) << 16); }
__device__ __forceinline__ bf16_t f2bf(float f) { return (bf16_t)(cvt_pk_bf16(f, 0.f) & 0xffffu); }
template <int CTRL> __device__ __forceinline__ float dpp_f(float v) { return __int_as_float(__builtin_amdgcn_update_dpp(0, __float_as_int(v), CTRL, 0xF, 0xF, true)); }
template <int CTRL> __device__ __forceinline__ int dpp_i(int v) { return __builtin_amdgcn_update_dpp(0, v, CTRL, 0xF, 0xF, true); }
constexpr int DPP_X1 = 0xB1, DPP_X2 = 0x4E, DPP_HMIR = 0x141, DPP_MIR = 0x140;
__device__ __forceinline__ float row16_sum(float v) { v += dpp_f<DPP_X1>(v); v += dpp_f<DPP_X2>(v); v += dpp_f<DPP_HMIR>(v); v += dpp_f<DPP_MIR>(v); return v; }
__device__ __forceinline__ float half32_sum(float v) {
    v = row16_sum(v);
    const auto r = __builtin_amdgcn_permlane16_swap(__float_as_uint(v), __float_as_uint(v), false, false);
    return __uint_as_float(r[0]) + __uint_as_float(r[1]);
}
__device__ __forceinline__ float wave_sum(float v) {
    v = half32_sum(v);
    const auto r = __builtin_amdgcn_permlane32_swap(__float_as_uint(v), __float_as_uint(v), false, false);
    return __uint_as_float(r[0]) + __uint_as_float(r[1]);
}
__device__ __forceinline__ void ld8bf(const bf16_t* p, float (&v)[8]) {
    const u32x4 w = *(const u32x4*)p;
    v[0] = bf_lo(w.x); v[1] = bf_hi(w.x); v[2] = bf_lo(w.y); v[3] = bf_hi(w.y); v[4] = bf_lo(w.z); v[5] = bf_hi(w.z); v[6] = bf_lo(w.w); v[7] = bf_hi(w.w);
}
__device__ __forceinline__ void st8bf(bf16_t* p, const float (&v)[8]) {
    u32x4 w; w.x = cvt_pk_bf16(v[0], v[1]); w.y = cvt_pk_bf16(v[2], v[3]); w.z = cvt_pk_bf16(v[4], v[5]); w.w = cvt_pk_bf16(v[6], v[7]);
    *(u32x4*)p = w;
}

struct Params {
    const float* x; const float* c; const float* ctx; const float* c_ctx; const float* w_ada; const float* b_ada; const float* g_norm1;
    const float* w_in; const float* da_lambda; const float* g_subln; const float* w_conv; const float* w_pool; const float* pool_scale;
    const float* w_branch; const float* w_mgate; const float* b_mgate; const float* w_out; const float* g_norm2; const float* w_router; const float* b_router;
    const float* w_e_gate; const float* b_e_gate; const float* w_e_up; const float* b_e_up; const float* w_e_down; const float* b_e_down; const float* g_final;
    float* out; unsigned char* ws; int ph_lo, ph_hi;
};

#define XB_TMO      128
#define XB_XCNT(j)  (256  + 64 * (j))
#define XB_XSUB(j)  (1280 + 64 * (j))
#define XB_XGEN(j)  (2304 + 64 * (j))
#define XB_TOP      3328
#define XB_TOPGEN   3392
#define XCD_BAR_WORDS 3456
#define XB_SPIN_CAP (1u << 20)
__device__ __forceinline__ unsigned xb_ld(unsigned* p)              { return __hip_atomic_load(p, __ATOMIC_RELAXED, __HIP_MEMORY_SCOPE_AGENT); }
__device__ __forceinline__ unsigned xb_add(unsigned* p, unsigned v) { return __hip_atomic_fetch_add(p, v, __ATOMIC_RELAXED, __HIP_MEMORY_SCOPE_AGENT); }
__device__ __forceinline__ unsigned xb_xcc_id() { return (unsigned)__builtin_amdgcn_s_getreg((3 << 11) | 20) & 0xFu; }
#define XB_SPIN(cond, bar) do { unsigned _sp = 0; while (cond) { __builtin_amdgcn_s_sleep(1); \
    if ((++_sp & 255u) == 0u) { if (xb_ld(&(bar)[XB_TMO])) break; if (_sp > XB_SPIN_CAP) { atomicAdd(&(bar)[XB_TMO], 1u); break; } } } } while (0)
struct XcdBarrier { unsigned* bar; unsigned x; volatile LAS unsigned* st; };
__device__ __forceinline__ XcdBarrier xcd_barrier_post(unsigned* bar, volatile LAS unsigned* st) {
    XcdBarrier b; b.bar = bar; b.x = xb_xcc_id(); b.st = st;
    if (threadIdx.x == 0) (void)xb_add(&bar[XB_XCNT(b.x)], 1u);
    return b;
}
__device__ __forceinline__ void xcd_barrier_complete(unsigned* bar, unsigned x, unsigned& nloc, unsigned& nx) {
    const unsigned G = gridDim.x * gridDim.y * gridDim.z;
    unsigned sum, cnt, mine, sp = 0u;
    for (;;) {
        sum = 0u; cnt = 0u; mine = 0u;
#pragma unroll
        for (unsigned j = 0; j < 16; ++j) { const unsigned c = xb_ld(&bar[XB_XCNT(j)]); sum += c; cnt += (c > 0u) ? 1u : 0u; mine = (j == x) ? c : mine; }
        if (sum == G) break;
        __builtin_amdgcn_s_sleep(1);
        if ((++sp & 255u) == 0u) { if (xb_ld(&bar[XB_TMO])) break; if (sp > XB_SPIN_CAP) { atomicAdd(&bar[XB_TMO], 1u); break; } }
    }
    nloc = mine > 0u ? mine : 1u; nx = cnt > 0u ? cnt : 1u;
}
__device__ __forceinline__ void xcd_barrier(const XcdBarrier& b) {
    asm volatile("s_waitcnt vmcnt(0)" ::: "memory");
    __syncthreads();
    if (threadIdx.x == 0) {
        unsigned long long barw = (unsigned long long)b.bar;
        asm volatile("" : "+s"(barw));
        unsigned* bar = (unsigned*)(__attribute__((address_space(1))) unsigned*)barw;
        __builtin_amdgcn_s_waitcnt(0);
        unsigned nloc = b.st[0], nx = b.st[1];
        if (nloc == 0u) { xcd_barrier_complete(bar, b.x, nloc, nx); b.st[0] = nloc; b.st[1] = nx; }
        const unsigned old = xb_add(&bar[XB_XSUB(b.x)], 1u);
        const unsigned gen = old / nloc;
        if (old + 1u == (gen + 1u) * nloc) {
            __builtin_amdgcn_fence(__ATOMIC_RELEASE, "agent");
            asm volatile("s_waitcnt vmcnt(0)" ::: "memory");
            const unsigned og = xb_add(&bar[XB_TOP], 1u);
            const unsigned tg = og / nx;
            if (og + 1u == (tg + 1u) * nx) xb_add(&bar[XB_TOPGEN], 1u);
            else XB_SPIN(xb_ld(&bar[XB_TOPGEN]) == tg, bar);
            __builtin_amdgcn_fence(__ATOMIC_ACQUIRE, "agent");
            xb_add(&bar[XB_XGEN(b.x)], 1u);
            asm volatile("s_waitcnt vmcnt(0)" ::: "memory");
        } else {
            XB_SPIN(xb_ld(&bar[XB_XGEN(b.x)]) == gen, bar);
            __builtin_amdgcn_fence(__ATOMIC_ACQUIRE, "agent");
            asm volatile("s_waitcnt vmcnt(0)" ::: "memory");
        }
    }
    __syncthreads();
}

struct Frame {
    int tid, lane, wid, wg, nwg;
    LAS unsigned char* lds;
    unsigned char* ws;
    __device__ __forceinline__ unsigned* ctl() const { return (unsigned*)(ws + WS_CTL); }
    __device__ __forceinline__ float* mods() const { return (float*)(ws + WS_MODS); }
    __device__ __forceinline__ float* rope() const { return (float*)(ws + WS_ROPE); }
    __device__ __forceinline__ float* tw() const { return (float*)(ws + WS_TW); }
    __device__ __forceinline__ bf16_t* dft() const { return (bf16_t*)(ws + WS_DFT); }
    __device__ __forceinline__ float* lam() const { return (float*)(ws + WS_LAM); }
    __device__ __forceinline__ float* ctxb() const { return (float*)(ws + WS_CTXB); }
    __device__ __forceinline__ bf16_t* win() const { return (bf16_t*)(ws + WS_WIN); }
    __device__ __forceinline__ bf16_t* wgate() const { return (bf16_t*)(ws + WS_WGATE); }
    __device__ __forceinline__ bf16_t* wbr() const { return (bf16_t*)(ws + WS_WBR); }
    __device__ __forceinline__ bf16_t* wout() const { return (bf16_t*)(ws + WS_WOUT); }
    __device__ __forceinline__ bf16_t* gu() const { return (bf16_t*)(ws + WS_GU); }
    __device__ __forceinline__ bf16_t* dn() const { return (bf16_t*)(ws + WS_DN); }
    __device__ __forceinline__ bf16_t* H() const { return (bf16_t*)(ws + WS_H); }
    __device__ __forceinline__ bf16_t* proj() const { return (bf16_t*)(ws + WS_PROJ); }
    __device__ __forceinline__ bf16_t* zm() const { return (bf16_t*)(ws + WS_ZM); }
    __device__ __forceinline__ bf16_t* act() const { return (bf16_t*)(ws + WS_PROJ); }
    __device__ __forceinline__ int* sele() const { return (int*)(ws + WS_SELE); }
    __device__ __forceinline__ float* selw() const { return (float*)(ws + WS_SELW); }
    __device__ __forceinline__ int* rtok() const { return (int*)(ws + WS_RTOK); }
    __device__ __forceinline__ float* rw() const { return (float*)(ws + WS_RW); }
    __device__ __forceinline__ bf16_t* dft256() const { return (bf16_t*)(ws + WS_DFT256); }
    __device__ __forceinline__ int* cntw() const { return (int*)(ws + WS_CNTW); }
    __device__ __forceinline__ bf16_t* Y() const { return (bf16_t*)(ws + WS_Y); }
    __device__ __forceinline__ bf16_t* acts() const { return (bf16_t*)(ws + WS_ACTS); }
    __device__ __forceinline__ bf16_t* acts2() const { return (bf16_t*)(ws + WS_ACT2); }
    __device__ __forceinline__ unsigned char* g8() const { return ws + WS_G8; }
    __device__ __forceinline__ float* mst() const { return (float*)(ws + WS_MST) + (size_t)wg * 128 * NTHR; }
};

__device__ __forceinline__ int qk_rowmap(int n) {
    if (n >= 1024) return n;
    const int g = n & ~31, d = n & 31;
    const int p = d < 16 ? 8 * (d >> 2) + (d & 3) : 8 * ((d - 16) >> 2) + 4 + (d & 3);
    return g + p;
}
__device__ __forceinline__ int gu_rowmap(int c, int up) { return 32 * (c >> 4) + 8 * ((c & 15) >> 2) + (c & 3) + 4 * up; }

template <int MODE>
__device__ __forceinline__ void cvt_tile(const Frame& F, const float* __restrict__ src, int src_ld, int k0, int n0, bf16_t* __restrict__ dst, int dst_ld, int dst_k0) {
    LAS float* tile = (LAS float*)F.lds;
#pragma unroll
    for (int q = 0; q < 2; ++q) {
        const int idx = F.tid + q * NTHR, r = idx >> 4, c4 = idx & 15;
        const f32x4 v = *(const f32x4*)(src + (size_t)(k0 + r) * src_ld + n0 + c4 * 4);
        tile[r * 65 + c4 * 4 + 0] = v[0]; tile[r * 65 + c4 * 4 + 1] = v[1]; tile[r * 65 + c4 * 4 + 2] = v[2]; tile[r * 65 + c4 * 4 + 3] = v[3];
    }
    __syncthreads();
    {
        const int n = F.tid >> 3, kc = F.tid & 7;
        float v[8];
#pragma unroll
        for (int j = 0; j < 8; ++j) v[j] = tile[(kc * 8 + j) * 65 + n];
        int row = n0 + n;
        if (MODE == 1) row = qk_rowmap(row);
        if (MODE == 2) row = gu_rowmap(row, 0);
        if (MODE == 3) row = gu_rowmap(row, 1);
        st8bf(dst + (size_t)row * dst_ld + dst_k0 + k0 + kc * 8, v);
    }
    __syncthreads();
}

__device__ __forceinline__ void p0_mods(const Frame& F, const Params& P, int item) {
    LAS float* sl = (LAS float*)F.lds;
    LAS float* red = sl + 9 * 1024;
    for (int i = F.tid; i < 9 * 1024; i += NTHR) {
        const int r = i >> 10, d = i & 1023;
        const float v = (r < 8) ? P.c[r * 1024 + d] : P.c_ctx[d];
        sl[i] = v / (1.f + __expf(-v));
    }
    __syncthreads();
    const int col0 = item * 128, l = col0 / 6144, j0 = col0 % 6144;
    const int cq = F.tid & 31, ds = F.tid >> 5;
    f32x4 acc[9];
#pragma unroll
    for (int r = 0; r < 9; ++r) acc[r] = (f32x4){0.f, 0.f, 0.f, 0.f};
    const float* w = P.w_ada + (size_t)l * 1024 * 6144 + j0 + cq * 4;
#pragma unroll 16
    for (int i = 0; i < 64; ++i) {
        const int d = ds * 64 + i;
        const f32x4 wv = *(const f32x4*)(w + (size_t)d * 6144);
#pragma unroll
        for (int r = 0; r < 9; ++r) acc[r] += wv * sl[r * 1024 + d];
    }
#pragma unroll
    for (int r = 0; r < 9; ++r) {
#pragma unroll
        for (int q = 0; q < 4; ++q) red[(ds * 9 + r) * 128 + cq * 4 + q] = acc[r][q];
    }
    __syncthreads();
    for (int i = F.tid; i < 9 * 128; i += NTHR) {
        const int r = i >> 7, c = i & 127;
        float s = 0.f;
#pragma unroll
        for (int k = 0; k < 16; ++k) s += red[(k * 9 + r) * 128 + c];
        F.mods()[(size_t)(l * 9 + r) * 6144 + j0 + c] = s + P.b_ada[l * 6144 + j0 + c];
    }
    __syncthreads();
}

__device__ __forceinline__ void p0_fold(const Frame& F, const Params& P, int item) {
    const int l = item / 192, rem = item % 192, which = rem / 64, c8 = rem % 64;
    const int cbase = c8 * 8, g = cbase >> 7, cl = cbase & 127;
    LAS float* coef = (LAS float*)F.lds;
    for (int i = F.tid; i < 1024; i += NTHR) {
        const int cp = i >> 3, j = i & 7, c = cl + j;
        float v;
        if (which == 2) v = P.w_pool[((size_t)(l * 4 + g) * 128 + c) * 128 + cp] * P.pool_scale[l * 512 + g * 128 + cp];
        else { float sn, cs; sincospif(2.f * (float)((c * cp) & 127) / 128.f, &sn, &cs); v = (which == 0 ? cs : -sn) * 0.08838834764831845f; }
        coef[i] = v;
    }
    __syncthreads();
    const float* wb = P.w_branch + ((size_t)(l * 4 + (which == 2 ? 3 : 2)) * 512 + g * 128) * 1024;
    const int kofs = (which == 0 ? 1024 : which == 1 ? 1536 : 2048) + cbase;
    {
        float acc0[8], acc1[8];
#pragma unroll
        for (int j = 0; j < 8; ++j) { acc0[j] = 0.f; acc1[j] = 0.f; }
#pragma unroll 1
        for (int cp0 = 0; cp0 < 128; cp0 += 16) {
            float w0[16], w1[16];
#pragma unroll
            for (int q = 0; q < 16; ++q) { w0[q] = wb[(size_t)(cp0 + q) * 1024 + F.tid]; w1[q] = wb[(size_t)(cp0 + q) * 1024 + F.tid + NTHR]; }
#pragma unroll
            for (int q = 0; q < 16; ++q)
#pragma unroll
                for (int j = 0; j < 8; ++j) { const float cf = coef[(cp0 + q) * 8 + j]; acc0[j] += cf * w0[q]; acc1[j] += cf * w1[q]; }
        }
        st8bf(F.wbr() + ((size_t)l * 1024 + F.tid) * WBR_K + kofs, acc0);
        st8bf(F.wbr() + ((size_t)l * 1024 + F.tid + NTHR) * WBR_K + kofs, acc1);
    }
    __syncthreads();
}

__device__ __forceinline__ void p0_tables(const Frame& F, const Params& P, int item) {
    const int idx = item * NTHR + F.tid;
    if (idx < 2048) {
        const int pos = idx >> 4, i = idx & 15;
        const float inv = powf(10000.f, -(float)(2 * i) / 32.f);
        const float ang = (float)pos * inv;
        F.rope()[idx] = cosf(ang); F.rope()[2048 + idx] = sinf(ang);
    }
    if (idx < 8192) {
        const int k1 = idx >> 6, n2 = idx & 63;
        float sn, cs; sincospif(2.f * (float)(k1 * n2) / 8192.f, &sn, &cs);
        F.tw()[idx * 2] = cs; F.tw()[idx * 2 + 1] = sn;
    }
    if (idx < 16384) {
        const int k = idx >> 7, n = idx & 127;
        float sn, cs; sincospif(2.f * (float)((k * n) & 127) / 128.f, &sn, &cs);
        F.dft()[idx] = f2bf(cs); F.dft()[16384 + idx] = f2bf(sn);
    }
    if (idx < 4096) {
        const int k = idx >> 6, n = idx & 63;
        float sn, cs; sincospif(2.f * (float)((k * n) & 63) / 64.f, &sn, &cs);
        F.dft()[32768 + idx] = f2bf(cs); F.dft()[32768 + 4096 + idx] = f2bf(sn); F.dft()[32768 + 8192 + idx] = f2bf(-sn);
    }
    if (idx < 2) {
        const float* lm = P.da_lambda + idx * 256;
        float s1 = 0.f, s2 = 0.f;
        for (int i = 0; i < 64; ++i) { s1 += lm[i] * lm[64 + i]; s2 += lm[128 + i] * lm[192 + i]; }
        const float lam_init = 0.8f - 0.6f * expf(-0.3f * (float)idx);
        F.lam()[idx] = expf(s1) - expf(s2) + lam_init;
    }
}

__device__ __forceinline__ void p0_prologue(const Frame& F, const Params& P) {
    for (int it = F.wg; it < 96 + 384 + 64; it += F.nwg) {
        if (it < 96) p0_mods(F, P, it);
        else if (it < 480) { const int f = it - 96; p0_fold(F, P, (f & 7) * 48 + (f >> 3)); }
        else p0_tables(F, P, it - 480);
    }
    for (int idx = F.wg * NTHR + F.tid; idx < 65536; idx += F.nwg * NTHR) {
        const int k = idx >> 8, n = idx & 255;
        float sn, cs; sincospif(2.f * (float)((k * n) & 255) / 256.f, &sn, &cs);
        F.dft256()[idx] = f2bf(cs); F.dft256()[65536 + idx] = f2bf(sn);
    }
    for (size_t i = (size_t)F.wg * NTHR + F.tid; i < (size_t)TC * DM / 4; i += (size_t)F.nwg * NTHR) ((f32x4*)F.ctxb())[i] = ((const f32x4*)P.ctx)[i];
    {
        constexpr int NWS = 2 * 640, TP = 257;
#define WS_DESC(it, src, sld, k0, n0) do { const int _l = (it) / 640; int _r = (it) % 640; \
            if (_r < 256) { src = P.w_in + (size_t)_l * DM * INW; sld = INW; k0 = (_r >> 4) * 64; n0 = (_r & 15) * 256; } \
            else if (_r < 512) { _r -= 256; src = P.w_mgate + (size_t)_l * DM * INW; sld = INW; k0 = (_r >> 4) * 64; n0 = (_r & 15) * 256; } \
            else if (_r < 576) { _r -= 512; src = P.w_out + (size_t)_l * DM * DM; sld = DM; k0 = (_r >> 2) * 64; n0 = (_r & 3) * 256; } \
            else { _r -= 576; const int _k = _r >> 5; _r &= 31; src = P.w_branch + (size_t)(_l * 4 + _k) * 512 * 1024; sld = 1024; k0 = (_r >> 2) * 64; n0 = (_r & 3) * 256; } } while (0)
#define WS_LOAD(it) do { const float* _s; int _sld, _k0, _n0; WS_DESC(it, _s, _sld, _k0, _n0); \
            _Pragma("unroll") for (int _q = 0; _q < 8; ++_q) { const int _i = F.tid + _q * NTHR; wv[_q] = *(const f32x4*)(_s + (size_t)(_k0 + (_i >> 6)) * _sld + _n0 + (_i & 63) * 4); } } while (0)
        LAS float* tile = (LAS float*)F.lds;
        f32x4 wv[8];
        int it = F.wg, par = 0;
        if (it < NWS) WS_LOAD(it);
        for (; it < NWS; it += F.nwg, par ^= 1) {
            LAS float* tl = tile + par * (64 * TP);
#pragma unroll
            for (int q = 0; q < 8; ++q) { const int i = F.tid + q * NTHR, r = i >> 6, c = (i & 63) * 4; tl[r * TP + c] = wv[q][0]; tl[r * TP + c + 1] = wv[q][1]; tl[r * TP + c + 2] = wv[q][2]; tl[r * TP + c + 3] = wv[q][3]; }
            __syncthreads();
            if (it + F.nwg < NWS) WS_LOAD(it + F.nwg);
            const int l = it / 640; int r = it % 640;
            bf16_t* dst; int dld, k0, n0, kofs = 0; bool qk = false;
            if (r < 256) { dst = F.win() + (size_t)l * INW * DM; dld = DM; k0 = (r >> 4) * 64; n0 = (r & 15) * 256; qk = true; }
            else if (r < 512) { r -= 256; dst = F.wgate() + (size_t)l * INW * DM; dld = DM; k0 = (r >> 4) * 64; n0 = (r & 15) * 256; }
            else if (r < 576) { r -= 512; dst = F.wout() + (size_t)l * DM * DM; dld = DM; k0 = (r >> 2) * 64; n0 = (r & 3) * 256; }
            else { r -= 576; const int k = r >> 5; r &= 31; dst = F.wbr() + (size_t)l * 1024 * WBR_K; dld = WBR_K; k0 = (r >> 2) * 64; n0 = (r & 3) * 256; kofs = k * 512; }
#pragma unroll
            for (int q = 0; q < 4; ++q) {
                const int p = F.tid + q * NTHR, n = p >> 3, kc = p & 7;
                float o[8];
#pragma unroll
                for (int j = 0; j < 8; ++j) o[j] = tl[(kc * 8 + j) * TP + n];
                const int row = qk ? qk_rowmap(n0 + n) : (n0 + n);
                st8bf(dst + (size_t)row * dld + kofs + k0 + kc * 8, o);
            }
        }
        __syncthreads();
#undef WS_DESC
#undef WS_LOAD
    }
}

__device__ __forceinline__ void cvt_experts(const Frame& F, const Params& P, int l) {
    constexpr int NS = NEXP * 3 * 64, TP = 257;
    LAS float* tile = (LAS float*)F.lds;
    f32x4 v[8];
#define CE_SRC(s, base, k0, n0) do { const int _e = (s) / 192, _r = (s) % 192, _w = _r >> 6, _t = _r & 63; k0 = (_t >> 2) * 64; n0 = (_t & 3) * 256; \
        base = (_w == 0 ? P.w_e_gate : _w == 1 ? P.w_e_up : P.w_e_down) + ((size_t)l * NEXP + _e) * DM * DM; } while (0)
#define CE_LOAD(s) do { const float* _b; int _k0, _n0; CE_SRC(s, _b, _k0, _n0); \
        _Pragma("unroll") for (int _q = 0; _q < 8; ++_q) { const int _i = F.tid + _q * NTHR; v[_q] = *(const f32x4*)(_b + (size_t)(_k0 + (_i >> 6)) * DM + _n0 + (_i & 63) * 4); } } while (0)
    int s = F.wg, par = 0;
    if (s < NS) CE_LOAD(s);
    for (; s < NS; s += F.nwg, par ^= 1) {
        LAS float* tl = tile + par * (64 * TP);
#pragma unroll
        for (int q = 0; q < 8; ++q) { const int i = F.tid + q * NTHR, r = i >> 6, c = (i & 63) * 4; tl[r * TP + c] = v[q][0]; tl[r * TP + c + 1] = v[q][1]; tl[r * TP + c + 2] = v[q][2]; tl[r * TP + c + 3] = v[q][3]; }
        __syncthreads();
        if (s + F.nwg < NS) CE_LOAD(s + F.nwg);
        const int e = s / 192, r = s % 192, w = r >> 6, t = r & 63, k0 = (t >> 2) * 64, n0 = (t & 3) * 256;
        bf16_t* dst = (w == 2) ? F.dn() + (size_t)e * DM * DM : F.gu() + (size_t)e * 2048 * DM;
#pragma unroll
        for (int q = 0; q < 4; ++q) {
            const int p = F.tid + q * NTHR, n = p >> 3, kc = p & 7;
            float o[8];
#pragma unroll
            for (int j = 0; j < 8; ++j) o[j] = tl[(kc * 8 + j) * TP + n];
            const int row = (w == 2) ? (n0 + n) : gu_rowmap(n0 + n, w);
            st8bf(dst + (size_t)row * DM + k0 + kc * 8, o);
        }
    }
#undef CE_SRC
#undef CE_LOAD
    __syncthreads();
}

__device__ __forceinline__ const float* xrow_ptr(const float* xs, long long dctx, int row) { return xs + (size_t)row * DM + (row >= TL ? dctx : 0ll); }
__device__ __forceinline__ void phase_norm1(const Frame& F, const Params& P, int l, const float* xs, long long dctx, bool combine, float* xw, long long dctxw) {
    const float* g = P.g_norm1 + l * DM;
    for (int row = F.wg * 8 + F.wid; row < TA; row += F.nwg * 8) {
        const float* xr = xrow_ptr(xs, dctx, row);
        const int b = row < TL ? (row >> 13) : 8;
        const float* md = F.mods() + (size_t)(l * 9 + b) * 6144;
        f32x4 v[4]; float ss = 0.f;
#pragma unroll
        for (int j = 0; j < 4; ++j) v[j] = *(const f32x4*)(xr + F.lane * 4 + 256 * j);
        if (combine) {
            const float* g5 = F.mods() + (size_t)((l - 1) * 9 + b) * 6144 + 5 * 1024;
            const bf16_t* yr = F.Y() + (size_t)row * 4 * DM;
            float* xo = xw + (size_t)row * DM + (row >= TL ? dctxw : 0ll);
#pragma unroll
            for (int j = 0; j < 4; ++j) {
                const int col = F.lane * 4 + 256 * j;
                f32x4 s = (f32x4){0.f, 0.f, 0.f, 0.f};
#pragma unroll
                for (int k = 0; k < 4; ++k) { const u32x2 w = __builtin_nontemporal_load((const u32x2*)(yr + (size_t)k * DM + col));     s[0] += bf_lo(w.x); s[1] += bf_hi(w.x); s[2] += bf_lo(w.y); s[3] += bf_hi(w.y); }
                v[j] += *(const f32x4*)(g5 + col) * s;
                *(f32x4*)(xo + col) = v[j];
            }
        }
#pragma unroll
        for (int j = 0; j < 4; ++j) ss += v[j][0] * v[j][0] + v[j][1] * v[j][1] + v[j][2] * v[j][2] + v[j][3] * v[j][3];
        ss = wave_sum(ss);
        const float rstd = rsqrtf(ss * (1.f / 1024.f) + EPS);
#pragma unroll
        for (int j = 0; j < 4; ++j) {
            const int col = F.lane * 4 + 256 * j;
            const f32x4 gg = *(const f32x4*)(g + col), sh = *(const f32x4*)(md + col), sc = *(const f32x4*)(md + 1024 + col);
            float o[4];
#pragma unroll
            for (int i = 0; i < 4; ++i) o[i] = v[j][i] * rstd * gg[i] * (1.f + sc[i]) + sh[i];
            u32x2 w; w.x = cvt_pk_bf16(o[0], o[1]); w.y = cvt_pk_bf16(o[2], o[3]);
            *(u32x2*)(F.H() + (size_t)row * DM + col) = w;
        }
    }
}

__device__ __forceinline__ void phase_final(const Frame& F, const Params& P) {
    for (int row = F.wg * 8 + F.wid; row < TL; row += F.nwg * 8) {
        float* xr = P.out + (size_t)row * DM;
        const float* g5 = F.mods() + (size_t)((NLAYER - 1) * 9 + (row >> 13)) * 6144 + 5 * 1024;
        const bf16_t* yr = F.Y() + (size_t)row * 4 * DM;
        f32x4 v[4]; float ss = 0.f;
#pragma unroll
        for (int j = 0; j < 4; ++j) {
            const int col = F.lane * 4 + 256 * j;
            v[j] = *(const f32x4*)(xr + col);
            f32x4 s = (f32x4){0.f, 0.f, 0.f, 0.f};
#pragma unroll
            for (int k = 0; k < 4; ++k) { const u32x2 w = __builtin_nontemporal_load((const u32x2*)(yr + (size_t)k * DM + col));     s[0] += bf_lo(w.x); s[1] += bf_hi(w.x); s[2] += bf_lo(w.y); s[3] += bf_hi(w.y); }
            v[j] += *(const f32x4*)(g5 + col) * s;
            ss += v[j][0] * v[j][0] + v[j][1] * v[j][1] + v[j][2] * v[j][2] + v[j][3] * v[j][3];
        }
        ss = wave_sum(ss);
        const float rstd = rsqrtf(ss * (1.f / 1024.f) + EPS);
#pragma unroll
        for (int j = 0; j < 4; ++j) {
            const int col = F.lane * 4 + 256 * j;
            const f32x4 gg = *(const f32x4*)(P.g_final + col);
            f32x4 o;
#pragma unroll
            for (int i = 0; i < 4; ++i) o[i] = v[j][i] * rstd * gg[i];
            __builtin_nontemporal_store(o, (f32x4*)(xr + col));
        }
    }
}

__device__ __forceinline__ void seq_of(int row, int& s, int& n) { if (row < TL) { s = row & (SEQ - 1); n = SEQ; } else { s = (row - TL) & (CTXL - 1); n = CTXL; } }

__device__ __forceinline__ void phase_conv(const Frame& F, const Params& P, int l, int nrows) {
    const float* wc = P.w_conv + l * 3 * 512;
    for (size_t idx = (size_t)F.wg * NTHR + F.tid; idx < (size_t)(nrows / 4) * 64; idx += (size_t)F.nwg * NTHR) {
        const int row0 = (int)(idx >> 6) * 4, ch = (int)(idx & 63) * 8;
        int s0, n; seq_of(row0, s0, n);
        const char* pb = (const char*)F.proj();
        const unsigned off0 = (unsigned)(row0 * INW + ch) * 2u;
        u32x4 rx[6], rc[6], rb[4];
#pragma unroll
        for (int i = 0; i < 6; ++i) {
            const int s = s0 - 1 + i; const bool ok = s >= 0 && s < n; const unsigned o = off0 + (ok ? (unsigned)((i - 1) * INW * 2) : 0u);
            rx[i] = *(const u32x4*)(pb + (size_t)(o + C_SX * 2)); rc[i] = *(const u32x4*)(pb + (size_t)(o + C_SC * 2));
        }
#pragma unroll
        for (int i = 0; i < 4; ++i) rb[i] = *(const u32x4*)(pb + (size_t)(off0 + (unsigned)(i * INW * 2 + C_SB * 2)));
        bf16_t* base = F.proj() + (size_t)row0 * INW;
        float w0[8], w1[8], w2[8];
#pragma unroll
        for (int j = 0; j < 8; ++j) { w0[j] = wc[ch + j]; w1[j] = wc[512 + ch + j]; w2[j] = wc[1024 + ch + j]; }
        float u[6][8];
#pragma unroll
        for (int i = 0; i < 6; ++i) {
            const int s = s0 - 1 + i; const float z = (s >= 0 && s < n) ? 1.f : 0.f;
            u[i][0] = bf_lo(rx[i].x) * bf_lo(rc[i].x) * z; u[i][1] = bf_hi(rx[i].x) * bf_hi(rc[i].x) * z; u[i][2] = bf_lo(rx[i].y) * bf_lo(rc[i].y) * z; u[i][3] = bf_hi(rx[i].y) * bf_hi(rc[i].y) * z;
            u[i][4] = bf_lo(rx[i].z) * bf_lo(rc[i].z) * z; u[i][5] = bf_hi(rx[i].z) * bf_hi(rc[i].z) * z; u[i][6] = bf_lo(rx[i].w) * bf_lo(rc[i].w) * z; u[i][7] = bf_hi(rx[i].w) * bf_hi(rc[i].w) * z;
        }
#pragma unroll
        for (int i = 0; i < 4; ++i) {
            float bb[8], y[8];
            bb[0] = bf_lo(rb[i].x); bb[1] = bf_hi(rb[i].x); bb[2] = bf_lo(rb[i].y); bb[3] = bf_hi(rb[i].y); bb[4] = bf_lo(rb[i].z); bb[5] = bf_hi(rb[i].z); bb[6] = bf_lo(rb[i].w); bb[7] = bf_hi(rb[i].w);
#pragma unroll
            for (int j = 0; j < 8; ++j) y[j] = bb[j] * (w0[j] * u[i][j] + w1[j] * u[i + 1][j] + w2[j] * u[i + 2][j]);
            st8bf(base + (ptrdiff_t)i * INW + C_SB + ch, y);
        }
    }
}

template <int HW>
__device__ __forceinline__ void pool_group(const Frame& F, int nrows, int g, size_t idx) {
    constexpr int NR = 8 + 2 * HW - 1;
    {
        const int row0 = (int)(idx >> 4) * 8, ch = g * 128 + (int)(idx & 15) * 8;
        int s0, n; seq_of(row0, s0, n);
        const char* pb = (const char*)F.proj();
        const unsigned off0 = (unsigned)(row0 * INW + C_PX + ch) * 2u;
        u32x4 rx[NR];
#pragma unroll
        for (int i = 0; i < NR; ++i) {
            const int s = s0 - HW + i; const bool ok = s >= 0 && s < n;
            rx[i] = *(const u32x4*)(pb + (size_t)(off0 + (ok ? (unsigned)((i - HW) * INW * 2) : 0u)));
            if (!ok) rx[i] = (u32x4){0u, 0u, 0u, 0u};
        }
        float w[8];
#pragma unroll
        for (int j = 0; j < 8; ++j) w[j] = 0.f;
#pragma unroll
        for (int i = 0; i < 2 * HW; ++i) { w[0] += bf_lo(rx[i].x); w[1] += bf_hi(rx[i].x); w[2] += bf_lo(rx[i].y); w[3] += bf_hi(rx[i].y); w[4] += bf_lo(rx[i].z); w[5] += bf_hi(rx[i].z); w[6] += bf_lo(rx[i].w); w[7] += bf_hi(rx[i].w); }
#pragma unroll
        for (int t = 0; t < 8; ++t) {
            const int s = s0 + t, lo = max(s - HW, 0), hi = min(s + HW, n);
            const float ic = 1.f / (float)(hi - lo);
            u32x4 xc = rx[t + HW];
            asm volatile("" : "+v"(xc));
            float y[8];
            y[0] = w[0] * ic - bf_lo(xc.x); y[1] = w[1] * ic - bf_hi(xc.x); y[2] = w[2] * ic - bf_lo(xc.y); y[3] = w[3] * ic - bf_hi(xc.y);
            y[4] = w[4] * ic - bf_lo(xc.z); y[5] = w[5] * ic - bf_hi(xc.z); y[6] = w[6] * ic - bf_lo(xc.w); y[7] = w[7] * ic - bf_hi(xc.w);
            st8bf(F.proj() + (size_t)(row0 + t) * INW + C_FX + ch, y);
            if (t < 7) {
                u32x4 a = rx[t + 2 * HW], d = rx[t];
                asm volatile("" : "+v"(a), "+v"(d));
                w[0] += bf_lo(a.x) - bf_lo(d.x); w[1] += bf_hi(a.x) - bf_hi(d.x); w[2] += bf_lo(a.y) - bf_lo(d.y); w[3] += bf_hi(a.y) - bf_hi(d.y);
                w[4] += bf_lo(a.z) - bf_lo(d.z); w[5] += bf_hi(a.z) - bf_hi(d.z); w[6] += bf_lo(a.w) - bf_lo(d.w); w[7] += bf_hi(a.w) - bf_hi(d.w);
            }
        }
    }
}
__device__ __forceinline__ void phase_pool(const Frame& F, int nrows) {
    const size_t nit = (size_t)(nrows / 8) * 16 / 64;
    int it = 0;
    for (size_t base = (size_t)F.wg * 2 + (F.wid >> 2); base < nit; base += (size_t)F.nwg * 2, ++it) {
        const int g = __builtin_amdgcn_readfirstlane((F.wid + it) & 3);
        const size_t idx = base * 64 + F.lane;
        if (g == 0) pool_group<1>(F, nrows, 0, idx); else if (g == 1) pool_group<2>(F, nrows, 1, idx); else if (g == 2) pool_group<4>(F, nrows, 2, idx); else pool_group<8>(F, nrows, 3, idx);
    }
}

__device__ __forceinline__ void phase_ctx_dft_copy(const Frame& F) {
    for (size_t idx = (size_t)F.wg * NTHR + F.tid; idx < (size_t)TC * 128; idx += (size_t)F.nwg * NTHR) {
        const int r = (int)(idx >> 7), c = (int)(idx & 127) * 8;
        *(u32x4*)(F.proj() + (size_t)(TL + r) * INW + C_K + c) = *(const u32x4*)(F.zm() + (size_t)(TL + r) * DM + c);
    }
}

namespace gm {
constexpr int BM = 256, BK = 64, HALF = 128, HTB = HALF * BK * 2, STAGE_BYTES = 8 * HTB;
__device__ __forceinline__ int lds_byte(int r, int c) { const int st = (r >> 4) * 2 + (c >> 5), rr = r & 15, cc = c & 31, ob = rr * 64 + cc * 2; return st * 1024 + (ob ^ (((ob >> 9) & 1) << 5)); }
__device__ __forceinline__ void stage_rc(int b, int& R, int& C) { const int st = b / 1024, sb = b % 1024, swz = sb ^ (((sb >> 9) & 1) << 5); R = (st >> 1) * 16 + swz / 64; C = (st & 1) * 32 + (swz % 64) / 2; }
__device__ __forceinline__ int perm32(int rho) { const int n = rho >> 4, i = rho & 15; return 8 * (i >> 2) + 4 * n + (i & 3); }

struct GUnit {
    const char* A;
    const char* B;
    const int* gidx;
    unsigned lda, ldb;
    int nt;
    int pm, pn, sub, e;
    unsigned aux;
};

template <bool PERM, class Epi, class Sched>
__device__ __forceinline__ void gemm_phase(LAS unsigned char* lds, const Sched& S, const Epi& E) {
    int tid = threadIdx.x; asm volatile("" : "+v"(tid));
    const int wid = __builtin_amdgcn_readfirstlane(tid >> 6), lane = tid & 63, wr = wid >> 2, wc = wid & 3, fr = lane & 15, fq = lane >> 4;
    const unsigned ldsw = (unsigned)wid * 1024u;
    const int aoff = lds_byte(wr * 64 + fr, fq * 8), boff = lds_byte(wc * 32 + fr, fq * 8);
    const size_t kstep = (size_t)(BK * 2);
#define G_SA(b, h) (((b) * 2 + (h)) * gm::HTB)
#define G_SB(b, h) ((4 + (b) * 2 + (h)) * gm::HTB)
#define G_STAGE2(bufoff, gbase, v0, v1) do { \
        __builtin_amdgcn_global_load_lds((const unsigned*)((const char*)(gbase) + (v0)), (LAS unsigned*)(lds + (bufoff) + ldsw), 16, 0, 0); \
        __builtin_amdgcn_global_load_lds((const unsigned*)((const char*)(gbase) + (v1)), (LAS unsigned*)(lds + (bufoff) + ldsw + 8192), 16, 0, 0); } while (0)
#define G_LDA(dst, b, h) do { _Pragma("unroll") for (int m = 0; m < 4; ++m) _Pragma("unroll") for (int k = 0; k < 2; ++k) dst[m][k] = *(const LAS bf16x8*)(lds + G_SA(b, h) + aoff + m * 2048 + k * 1024); } while (0)
#define G_LDB(dst, b, h) do { _Pragma("unroll") for (int n = 0; n < 2; ++n) _Pragma("unroll") for (int k = 0; k < 2; ++k) dst[n][k] = *(const LAS bf16x8*)(lds + G_SB(b, h) + boff + n * 2048 + k * 1024); } while (0)
#define G_MMA(ai, bj, At, Bt) do { __builtin_amdgcn_s_setprio(1); _Pragma("unroll") for (int m = 0; m < 4; ++m) _Pragma("unroll") for (int n = 0; n < 2; ++n) _Pragma("unroll") for (int k = 0; k < 2; ++k) \
        acc[ai][bj][m][n] = __builtin_amdgcn_mfma_f32_16x16x32_bf16(Bt[n][k], At[m][k], acc[ai][bj][m][n], 0, 0, 0); __builtin_amdgcn_s_setprio(0); } while (0)
#define G_WAIT_V(n) asm volatile("s_waitcnt vmcnt(" #n ")" ::: "memory")
#define G_WAIT_L(n) asm volatile("s_waitcnt lgkmcnt(" #n ")" ::: "memory")
#define G_BAR __builtin_amdgcn_s_barrier()
#define G_SCHED __builtin_amdgcn_sched_barrier(0)
#define G_OFFS(u, va00, va01, va10, va11, vb0, vb1, hsB) do { \
        int _t = threadIdx.x; asm volatile("" : "+v"(_t));     \
        int R0, C0, R1, C1; gm::stage_rc(_t * 16, R0, C0); gm::stage_rc(_t * 16 + 8192, R1, C1); \
        const int Rb0 = PERM ? ((R0 & ~31) + gm::perm32(R0 & 31)) : R0, Rb1 = PERM ? ((R1 & ~31) + gm::perm32(R1 & 31)) : R1; \
        unsigned _lda = (u).lda, _ldb = (u).ldb; if (Sched::VAR_STRIDE) asm volatile("" : "+s"(_lda), "+s"(_ldb));     \
        int r00 = R0, r01 = R1, r10 = 128 + R0, r11 = 128 + R1; \
        if ((u).gidx) { r00 = (u).gidx[R0]; r01 = (u).gidx[R1]; r10 = (u).gidx[128 + R0]; r11 = (u).gidx[128 + R1]; r00 = r00 < 0 ? 0 : (r00 >> 2); r01 = r01 < 0 ? 0 : (r01 >> 2); r10 = r10 < 0 ? 0 : (r10 >> 2); r11 = r11 < 0 ? 0 : (r11 >> 2); }     \
        va00 = (unsigned)r00 * _lda + (unsigned)C0 * 2u; va01 = (unsigned)r01 * _lda + (unsigned)C1 * 2u; \
        va10 = (unsigned)r10 * _lda + (unsigned)C0 * 2u; va11 = (unsigned)r11 * _lda + (unsigned)C1 * 2u; \
        vb0 = (unsigned)Rb0 * _ldb + (unsigned)C0 * 2u; vb1 = (unsigned)Rb1 * _ldb + (unsigned)C1 * 2u; hsB = (size_t)128 * _ldb; } while (0)
    GUnit cur, nxt; int ui = 0;
    if (!S.next(0, cur)) return;
#ifndef GEMM_SKEW_TICKS
#define GEMM_SKEW_TICKS 0
#endif
    if (GEMM_SKEW_TICKS > 0 && Sched::SKEW) {
        const unsigned long long t0 = __builtin_amdgcn_s_memrealtime(), w = (unsigned long long)(blockIdx.x & 7u) * (GEMM_SKEW_TICKS);
        while (__builtin_amdgcn_s_memrealtime() - t0 < w) __builtin_amdgcn_s_sleep(8);
    }
    f32x4 acc[2][2][4][2];
#pragma unroll
    for (int a = 0; a < 2; ++a)
#pragma unroll
        for (int b = 0; b < 2; ++b)
#pragma unroll
            for (int m = 0; m < 4; ++m)
#pragma unroll
                for (int n = 0; n < 2; ++n) acc[a][b][m][n] = (f32x4){0.f, 0.f, 0.f, 0.f};
    bf16x8 At[4][2], B0[2][2], B1[2][2];
    unsigned va00, va01, va10, va11, vb0, vb1; size_t hsB;
    unsigned na00, na01, na10, na11, nb0, nb1; size_t nhsB;
    G_OFFS(cur, va00, va01, va10, va11, vb0, vb1, hsB);
    const char* cA = cur.A; const char* cB = cur.B;
    G_STAGE2(G_SB(0, 0), cB, vb0, vb1); G_STAGE2(G_SA(0, 0), cA, va00, va01); G_STAGE2(G_SB(0, 1), cB + hsB, vb0, vb1); G_STAGE2(G_SA(0, 1), cA, va10, va11);
    if (wr == 1) G_BAR;
    G_WAIT_V(4); G_BAR;
    G_STAGE2(G_SB(1, 0), cB + kstep, vb0, vb1); G_STAGE2(G_SA(1, 0), cA + kstep, va00, va01); G_STAGE2(G_SB(1, 1), cB + hsB + kstep, vb0, vb1);
    G_WAIT_V(6); G_BAR;
    for (;;) {
        const bool has_next = S.next(ui + 1, nxt);
        const char* nA = cA; const char* nB = cB;
        if (has_next) { nA = nxt.A; nB = nxt.B; }
        if (Sched::GATHER_A) {
            na00 = va00; na01 = va01; na10 = va10; na11 = va11; nb0 = vb0; nb1 = vb1; nhsB = hsB;
            if (has_next) {
                if (nxt.gidx != nullptr && nxt.gidx == cur.gidx) {
                    unsigned t0, t1, t2, t3; gm::GUnit ub = nxt; ub.gidx = nullptr; G_OFFS(ub, t0, t1, t2, t3, nb0, nb1, nhsB); (void)t0; (void)t1; (void)t2; (void)t3;
                } else G_OFFS(nxt, na00, na01, na10, na11, nb0, nb1, nhsB);
            }
        }
        const int nt = cur.nt;
        for (int t = 0; t < nt; t += 2) {
            const bool last = (t == nt - 2);
            const char* a1 = cA + (size_t)(t + 1) * kstep;
            G_LDB(B0, 0, 0); G_SCHED; G_LDA(At, 0, 0); G_STAGE2(G_SA(1, 1), a1, va10, va11);
            const char* a2 = last ? nA : cA + (size_t)(t + 2) * kstep; const char* b2 = last ? nB : cB + (size_t)(t + 2) * kstep;
            if (last) {
                if (Sched::GATHER_A) { va00 = na00; va01 = na01; va10 = na10; va11 = na11; vb0 = nb0; vb1 = nb1; hsB = nhsB; }
                else if (has_next) G_OFFS(nxt, va00, va01, va10, va11, vb0, vb1, hsB);
            }
            const char* a3 = a2 + kstep; const char* b3 = b2 + kstep;
            G_WAIT_L(8); G_BAR; G_WAIT_L(0); G_MMA(0, 0, At, B0); G_BAR; G_SCHED;
            G_LDB(B1, 0, 1); G_STAGE2(G_SB(0, 0), b2, vb0, vb1);
            G_BAR; G_WAIT_L(0); G_MMA(0, 1, At, B1); G_BAR;
            G_LDA(At, 0, 1); G_STAGE2(G_SA(0, 0), a2, va00, va01);
            G_BAR; G_WAIT_L(0); G_MMA(1, 0, At, B0); G_BAR; G_SCHED;
            G_STAGE2(G_SB(0, 1), b2 + hsB, vb0, vb1);
            G_WAIT_V(6); G_BAR; G_MMA(1, 1, At, B1); G_BAR;
            G_LDB(B0, 1, 0); G_SCHED; G_LDA(At, 1, 0); G_STAGE2(G_SA(0, 1), a2, va10, va11);
            G_WAIT_L(8); G_BAR; G_WAIT_L(0); G_MMA(0, 0, At, B0); G_BAR; G_SCHED;
            G_LDB(B1, 1, 1); G_STAGE2(G_SB(1, 0), b3, vb0, vb1);
            G_BAR; G_WAIT_L(0); G_MMA(0, 1, At, B1); G_BAR;
            G_LDA(At, 1, 1); G_STAGE2(G_SA(1, 0), a3, va00, va01);
            G_BAR; G_WAIT_L(0); G_MMA(1, 0, At, B0); G_BAR; G_SCHED;
            G_STAGE2(G_SB(1, 1), b3 + hsB, vb0, vb1);
            G_WAIT_V(6); G_BAR; G_MMA(1, 1, At, B1); G_BAR;
        }
        E(acc, cur, wr, wc, (int)(threadIdx.x & 15u), (int)((threadIdx.x >> 4) & 3u));
        if (!has_next) break;
        if constexpr (!Epi::MAYKEEP) {
#pragma unroll
            for (int a = 0; a < 2; ++a)
#pragma unroll
                for (int b = 0; b < 2; ++b)
#pragma unroll
                    for (int m = 0; m < 4; ++m)
#pragma unroll
                        for (int n = 0; n < 2; ++n) acc[a][b][m][n] = (f32x4){0.f, 0.f, 0.f, 0.f};
        }
        cur = nxt; cA = nA; cB = nB; ++ui;
    }
    G_WAIT_V(0);
    if (wr == 0) G_BAR;
    G_BAR;
}
}

__device__ __forceinline__ void grouped_order(int Ls, int nM, int nN, int& pm, int& pn) {
    const int n = nM * nN, q = n >> 3, r = n & 7, xcd = Ls & 7, off = Ls >> 3;
    const int wgid = (xcd < r ? xcd * (q + 1) : r * (q + 1) + (xcd - r) * q) + off;
    const int nig = 8 * nN, gid = wgid / nig, fm = gid * 8, gsz = (nM - fm) < 8 ? (nM - fm) : 8, w = wgid - gid * nig;
    pm = fm + (w % gsz); pn = w / gsz;
}
struct SchedProj {
    static constexpr bool VAR_STRIDE = false, GATHER_A = false, SKEW = true;
    const char* H; const char* W; const char* WG; int l, G, c;
    __device__ __forceinline__ bool next(int i, gm::GUnit& u) const {
        const int L = i * G + c, nlat = 256 * 16, nproj = nlat + (l == 0 ? 8 * 16 : 8 * 4), ngate = (l == 0 ? 264 : 256) * 16;
        if (L >= nproj + ngate) return false;
        int pm, pn, sub = 0;
        if (L < nlat) grouped_order(L, 256, 16, pm, pn);
        else if (L < nproj) { const int r = L - nlat; if (l == 0) { pm = 256 + (r >> 4); pn = r & 15; } else { pm = 256 + (r >> 2); pn = 2 + (r & 3); } }
        else { grouped_order(L - nproj, l == 0 ? 264 : 256, 16, pm, pn); sub = 1; }
        u.A = H + (size_t)pm * 256 * 2048; u.B = (sub ? WG : W) + (size_t)pn * 256 * 2048; u.gidx = nullptr; u.lda = 2048; u.ldb = 2048; u.nt = 16; u.pm = pm; u.pn = pn; u.sub = sub; u.e = 0; u.aux = 0;
        return true;
    }
};
struct SchedMerge {
    static constexpr bool VAR_STRIDE = true, GATHER_A = false, SKEW = false;
    const char* P; const char* WB; int ntile, G, c; bool ctxmode;
    __device__ __forceinline__ bool next(int i, gm::GUnit& u) const {
        const int k = i & 3;
        int pm, pn;
        if (ctxmode) { if (c >= 32 || i >= 4) return false; pm = 256 + (c >> 2); pn = c & 3; }
        else { const int L = (i >> 2) * G + c; if (L >= ntile) return false; grouped_order(L, ntile >> 2, 4, pm, pn); }
        u.gidx = nullptr; u.pm = pm; u.pn = pn; u.sub = k; u.e = 0; u.aux = 0;
        const int colofs = (k == 0) ? C_Q : (k == 1) ? C_SB : (k == 2) ? C_K : C_FX;
        const int kofs = (k == 0) ? 0 : (k == 1) ? 512 : (k == 2) ? 1024 : 2048;
        u.A = P + (size_t)pm * 256 * 8192 + colofs * 2; u.lda = 8192; u.B = WB + (size_t)pn * 256 * (WBR_K * 2) + kofs * 2; u.ldb = WBR_K * 2; u.nt = (k == 2) ? 16 : 8;
        return true;
    }
};
struct SchedOut {
    static constexpr bool VAR_STRIDE = false, GATHER_A = false, SKEW = false;
    const char* M; const char* W; int ntile, G, c, mode;
    __device__ __forceinline__ bool next(int i, gm::GUnit& u) const {
        int pm, pn;
        if (mode == 0) { const int L = i * G + c; if (L >= ntile) return false; grouped_order(L, ntile >> 2, 4, pm, pn); }
        else if (mode == 1) {
            const int w = c >> 3; int off;
            if (w < 4) { if (i >= 2) return false; off = w * 2 + i; }
            else if (i < 4) off = 8 + (w - 4) + 28 * i;
            else if (i == 4 && w < 12) off = 120 + (w - 4);
            else return false;
            grouped_order(off * 8 + (c & 7), 256, 4, pm, pn);
        } else {
            const int r = c - 96; if (i != 0 || r < 0 || r >= 32) return false;
            pm = 256 + (r >> 2); pn = r & 3;
        }
        u.A = M + (size_t)pm * 256 * 2048; u.B = W + (size_t)pn * 256 * 2048; u.gidx = nullptr; u.lda = 2048; u.ldb = 2048; u.nt = 16; u.pm = pm; u.pn = pn; u.sub = 0; u.e = 0;
        return true;
    }
};
__device__ __forceinline__ int moe_expert_of(const LAS int* tb, int rt) { int e = 0; while (tb[e + 1] <= rt) ++e; return e; }
struct SchedMoeFused {
    static constexpr bool VAR_STRIDE = false, GATHER_A = true, SKEW = true;
    const char* H; const char* GU; const char* DN; const char* act; const int* rtok; const LAS int* tb; int nfull, G, c; unsigned aux;
    __device__ __forceinline__ bool next(int i, gm::GUnit& u) const {
        const int ti = i / 12, s = i % 12, rt = ti * G + c;
        if (rt >= nfull) return false;
        const int e = moe_expert_of(tb, rt);
        u.pm = rt; u.sub = s; u.e = e; u.lda = 2048; u.ldb = 2048; u.nt = 16; u.aux = aux;
        if (s < 8) { u.pn = s; u.A = H; u.gidx = rtok + (size_t)rt * 256; u.B = GU + ((size_t)e * 2048 + s * 256) * 2048; }
        else { u.pn = s - 8; u.A = act + aux; u.gidx = nullptr; u.B = DN + ((size_t)e * 1024 + (s - 8) * 256) * 2048; }
        return true;
    }
};
template <bool GUPASS>
struct SchedMoeSplit {
    static constexpr bool VAR_STRIDE = false, GATHER_A = GUPASS, SKEW = false;
    const char* A; const char* W; const int* rtok; const LAS int* tb; int nfull, G, c;
    __device__ __forceinline__ bool next(int i, gm::GUnit& u) const {
        constexpr int NCT = GUPASS ? 8 : 4;
        const int L = i * G + c, rt = nfull + L / NCT, ct = L % NCT;
        if (rt >= tb[32]) return false;
        const int e = moe_expert_of(tb, rt);
        u.pm = rt; u.pn = ct; u.e = e; u.lda = 2048; u.ldb = 2048; u.nt = 16; u.aux = (unsigned)(rt - nfull) * (256u * 2048u);
        if (GUPASS) { u.sub = ct; u.A = A; u.gidx = rtok + (size_t)rt * 256; u.B = W + ((size_t)e * 2048 + ct * 256) * 2048; }
        else { u.sub = 8 + ct; u.A = A + u.aux; u.gidx = nullptr; u.B = W + ((size_t)e * 1024 + ct * 256) * 2048; }
        return true;
    }
};

typedef f32x4 AccT[2][2][4][2];
struct EpiProj {
    static constexpr bool MAYKEEP = false;
    bf16_t* P; const float* rope; unsigned char* G8; const float* bg;
    __device__ __forceinline__ void operator()(const AccT& acc, const gm::GUnit& u, int wr, int wc, int fr, int fq) const {
        asm volatile("" : "+v"(fr), "+v"(fq));
        if (u.sub == 1) {
            const float* bp = bg + u.pn * 256 + wc * 32 + 8 * fq;
            f32x4 bb[2][2];
#pragma unroll
            for (int bj = 0; bj < 2; ++bj) { bb[bj][0] = *(const f32x4*)(bp + bj * 128); bb[bj][1] = *(const f32x4*)(bp + bj * 128 + 4); }
            __builtin_amdgcn_sched_barrier(0);
#pragma unroll
            for (int bj = 0; bj < 2; ++bj) {
                const f32x4 b0 = bb[bj][0], b1 = bb[bj][1];
#pragma unroll
                for (int ai = 0; ai < 2; ++ai)
#pragma unroll
                    for (int m = 0; m < 4; ++m) {
                        const int row = u.pm * 256 + ai * 128 + wr * 64 + m * 16 + fr;
                        f32x4 v0 = (acc[ai][bj][m][0] + b0) * -1.4426950408889634f, v1 = (acc[ai][bj][m][1] + b1) * -1.4426950408889634f;
#pragma unroll
                        for (int j = 0; j < 4; ++j) { v0[j] = __builtin_amdgcn_exp2f(v0[j]); v1[j] = __builtin_amdgcn_exp2f(v1[j]); }
                        v0 = v0 + 1.f; v1 = v1 + 1.f;
#pragma unroll
                        for (int j = 0; j < 4; ++j) { v0[j] = __builtin_amdgcn_rcpf(v0[j]); v1[j] = __builtin_amdgcn_rcpf(v1[j]); }
                        v0 = v0 * 255.f + 0.5f; v1 = v1 * 255.f + 0.5f;
                        unsigned q[8];
#pragma unroll
                        for (int j = 0; j < 4; ++j) { q[j] = max((unsigned)v0[j], 1u); q[4 + j] = max((unsigned)v1[j], 1u); }
                        u32x2 w; w.x = q[0] | (q[1] << 8) | (q[2] << 16) | (q[3] << 24); w.y = q[4] | (q[5] << 8) | (q[6] << 16) | (q[7] << 24);
                        *(u32x2*)(G8 + (size_t)row * INW + u.pn * 256 + bj * 128 + wc * 32 + 8 * fq) = w;
                    }
            }
            return;
        }
        const bool dorope = (u.pn < 4) && (u.pm < 256);
f32x4 cs[2][4], sn[2][4];
#pragma unroll
        for (int ai = 0; ai < 2; ++ai)
#pragma unroll
            for (int m = 0; m < 4; ++m) { cs[ai][m] = (f32x4){1.f, 1.f, 1.f, 1.f}; sn[ai][m] = (f32x4){0.f, 0.f, 0.f, 0.f}; }
        if (dorope) {
#pragma unroll
            for (int ai = 0; ai < 2; ++ai)
#pragma unroll
                for (int m = 0; m < 4; ++m) {
                    const int row = u.pm * 256 + ai * 128 + wr * 64 + m * 16 + fr, s = row & (SEQ - 1), pos = (wc & 1) ? (s & 63) : (s >> 6);
                    cs[ai][m] = *(const f32x4*)(rope + pos * 16 + 4 * fq); sn[ai][m] = *(const f32x4*)(rope + 2048 + pos * 16 + 4 * fq);
                }
        }
        __builtin_amdgcn_sched_barrier(0);
#pragma unroll
        for (int ai = 0; ai < 2; ++ai)
#pragma unroll
            for (int m = 0; m < 4; ++m) {
                const int row = u.pm * 256 + ai * 128 + wr * 64 + m * 16 + fr;
                bf16_t* rowp = P + (size_t)row * INW + u.pn * 256 + wc * 32 + 8 * fq;
#pragma unroll
                for (int bj = 0; bj < 2; ++bj) {
                    const f32x4 x0 = acc[ai][bj][m][0], x1 = acc[ai][bj][m][1];
                    const f32x4 o0 = x0 * cs[ai][m] - x1 * sn[ai][m], o1 = x1 * cs[ai][m] + x0 * sn[ai][m];
                    u32x4 w; w.x = cvt_pk_bf16(o0[0], o0[1]); w.y = cvt_pk_bf16(o0[2], o0[3]); w.z = cvt_pk_bf16(o1[0], o1[1]); w.w = cvt_pk_bf16(o1[2], o1[3]);
                    *(u32x4*)(rowp + bj * 128) = w;
                }
            }
    }
};
struct EpiMerge {
    static constexpr bool MAYKEEP = true;
    const unsigned char* G8; bf16_t* M;
    __device__ __forceinline__ void operator()(AccT& acc, const gm::GUnit& u, int wr, int wc, int fr, int fq) const {
        asm volatile("" : "+v"(fr), "+v"(fq));
        const int k = u.sub;
        const unsigned char* gbase = G8 + (size_t)(u.pm * 256 + wr * 64 + fr) * INW + k * 1024 + u.pn * 256 + wc * 32 + 8 * fq;
#pragma unroll
        for (int q = 0; q < 4; ++q) {
            const int ai = q >> 1, m0 = (q & 1) * 2;
            u32x2 ga[2][2], gb[2][2];
#pragma unroll
            for (int mi = 0; mi < 2; ++mi)
#pragma unroll
                for (int bj = 0; bj < 2; ++bj) {
                    const unsigned char* gp = gbase + (size_t)(ai * 128 + (m0 + mi) * 16) * INW + bj * 128;
                    ga[mi][bj] = *(const u32x2*)gp;
                    gb[mi][bj] = (k < 3) ? *(const u32x2*)(gp + 1024) : (u32x2){0xffffffffu, 0xffffffffu};
                }
            __builtin_amdgcn_sched_barrier(0);
#pragma unroll
            for (int mi = 0; mi < 2; ++mi) {
                const int m = m0 + mi, row = u.pm * 256 + ai * 128 + wr * 64 + m * 16 + fr;
#pragma unroll
                for (int bj = 0; bj < 2; ++bj) {
                    const u32x2 a = ga[mi][bj], b = gb[mi][bj];
                    f32x4 r0, r1;
                    r0[0] = (float)(a.x & 255u) * __builtin_amdgcn_rcpf((float)(b.x & 255u)); r0[1] = (float)((a.x >> 8) & 255u) * __builtin_amdgcn_rcpf((float)((b.x >> 8) & 255u));
                    r0[2] = (float)((a.x >> 16) & 255u) * __builtin_amdgcn_rcpf((float)((b.x >> 16) & 255u)); r0[3] = (float)(a.x >> 24) * __builtin_amdgcn_rcpf((float)(b.x >> 24));
                    r1[0] = (float)(a.y & 255u) * __builtin_amdgcn_rcpf((float)(b.y & 255u)); r1[1] = (float)((a.y >> 8) & 255u) * __builtin_amdgcn_rcpf((float)((b.y >> 8) & 255u));
                    r1[2] = (float)((a.y >> 16) & 255u) * __builtin_amdgcn_rcpf((float)((b.y >> 16) & 255u)); r1[3] = (float)(a.y >> 24) * __builtin_amdgcn_rcpf((float)(b.y >> 24));
                    const f32x4 s0 = acc[ai][bj][m][0] * r0, s1 = acc[ai][bj][m][1] * r1;
                    if (k == 3) {
                        u32x4 w; w.x = cvt_pk_bf16(s0[0], s0[1]); w.y = cvt_pk_bf16(s0[2], s0[3]); w.z = cvt_pk_bf16(s1[0], s1[1]); w.w = cvt_pk_bf16(s1[2], s1[3]);
                        *(u32x4*)(M + (size_t)row * DM + u.pn * 256 + bj * 128 + wc * 32 + 8 * fq) = w;
                    }
                    const float kz = (k == 3) ? 0.f : 1.f;
                    acc[ai][bj][m][0] = s0 * kz; acc[ai][bj][m][1] = s1 * kz;
                }
            }
            __builtin_amdgcn_sched_barrier(0);
        }
    }
};
struct EpiOut {
    static constexpr bool MAYKEEP = false;
    const float* xin; float* xout; long long din, dout; const float* mods;
    __device__ __forceinline__ void operator()(const AccT& acc, const gm::GUnit& u, int wr, int wc, int fr, int fq) const {
        asm volatile("" : "+v"(fr), "+v"(fq));
        const bool lat = u.pm < 256;
        const int b = lat ? (u.pm >> 5) : 8;
        const float* gp = mods + (size_t)b * 6144 + 2 * 1024 + u.pn * 256 + wc * 32 + 4 * fq;
        f32x4 gv[2][2];
#pragma unroll
        for (int bj = 0; bj < 2; ++bj)
#pragma unroll
            for (int n = 0; n < 2; ++n) gv[bj][n] = *(const f32x4*)(gp + bj * 128 + n * 16);
#pragma unroll
        for (int q = 0; q < 4; ++q) {
            const int ai = q >> 1, m0 = (q & 1) * 2;
            f32x4 xv[2][2][2];
#pragma unroll
            for (int mi = 0; mi < 2; ++mi) {
                const int row = u.pm * 256 + ai * 128 + wr * 64 + (m0 + mi) * 16 + fr;
                const float* ip = xin + (size_t)row * DM + u.pn * 256 + wc * 32 + 4 * fq + (lat ? 0ll : din);
#pragma unroll
                for (int bj = 0; bj < 2; ++bj)
#pragma unroll
                    for (int n = 0; n < 2; ++n) xv[mi][bj][n] = *(const f32x4*)(ip + bj * 128 + n * 16);
            }
            __builtin_amdgcn_sched_barrier(0);
#pragma unroll
            for (int mi = 0; mi < 2; ++mi) {
                const int m = m0 + mi, row = u.pm * 256 + ai * 128 + wr * 64 + m * 16 + fr;
                float* op = xout + (size_t)row * DM + u.pn * 256 + wc * 32 + 4 * fq + (lat ? 0ll : dout);
#pragma unroll
                for (int bj = 0; bj < 2; ++bj)
#pragma unroll
                    for (int n = 0; n < 2; ++n) *(f32x4*)(op + bj * 128 + n * 16) = xv[mi][bj][n] + gv[bj][n] * acc[ai][bj][m][n];
            }
            __builtin_amdgcn_sched_barrier(0);
        }
    }
};
struct EpiMoe {
    static constexpr bool MAYKEEP = false;
    char* act; const float* bgate; const float* bup; const float* bd; const int* rtok; const float* rw; bf16_t* Y; bool fused;
    __device__ __forceinline__ void operator()(const AccT& acc, const gm::GUnit& u, int wr, int wc, int fr, int fq) const {
        asm volatile("" : "+v"(fr), "+v"(fq));
        if (u.sub < 8) {
            bf16_t* at = (bf16_t*)(act + u.aux);
            f32x4 bgs[2], bus[2];
#pragma unroll
            for (int bj = 0; bj < 2; ++bj) { const int col = u.pn * 128 + bj * 64 + wc * 16 + 4 * fq; bgs[bj] = *(const f32x4*)(bgate + u.e * 1024 + col); bus[bj] = *(const f32x4*)(bup + u.e * 1024 + col); }
            __builtin_amdgcn_sched_barrier(0);
#pragma unroll
            for (int bj = 0; bj < 2; ++bj) {
                const int col = u.pn * 128 + bj * 64 + wc * 16 + 4 * fq;
                const f32x4 bgv = bgs[bj], buv = bus[bj];
#pragma unroll
                for (int ai = 0; ai < 2; ++ai)
#pragma unroll
                    for (int m = 0; m < 4; ++m) {
                        const int row = ai * 128 + wr * 64 + m * 16 + fr;
                        f32x4 a4 = acc[ai][bj][m][0] + bgv, u4 = acc[ai][bj][m][1] + buv;
#pragma unroll
                        for (int j = 0; j < 4; ++j) { a4[j] = fminf(a4[j], 7.f); u4[j] = fminf(fmaxf(u4[j], -7.f), 7.f); }
                        f32x4 e4 = a4 * (-1.702f * 1.4426950408889634f);
#pragma unroll
                        for (int j = 0; j < 4; ++j) e4[j] = __builtin_amdgcn_exp2f(e4[j]);
                        e4 = e4 + 1.f;
#pragma unroll
                        for (int j = 0; j < 4; ++j) e4[j] = __builtin_amdgcn_rcpf(e4[j]);
                        const f32x4 g4 = a4 * e4, o = g4 * u4 + g4;
                        u32x2 w; w.x = cvt_pk_bf16(o[0], o[1]); w.y = cvt_pk_bf16(o[2], o[3]);
                        *(u32x2*)(at + (size_t)row * DM + col) = w;
                    }
            }
        } else {
            const int col = u.pn * 256 + wc * 32 + 8 * fq;
            f32x4 bv[2][2];
#pragma unroll
            for (int bj = 0; bj < 2; ++bj) { bv[bj][0] = *(const f32x4*)(bd + u.e * 1024 + col + bj * 128); bv[bj][1] = *(const f32x4*)(bd + u.e * 1024 + col + bj * 128 + 4); }
            int slots[8]; float ws8[8];
#pragma unroll
            for (int i = 0; i < 8; ++i) { const int row = u.pm * 256 + (i >> 2) * 128 + wr * 64 + (i & 3) * 16 + fr; slots[i] = rtok[row]; ws8[i] = rw[row]; }
            __builtin_amdgcn_sched_barrier(0);
#pragma unroll
            for (int ai = 0; ai < 2; ++ai)
#pragma unroll
                for (int m = 0; m < 4; ++m) {
                    const int slot = slots[ai * 4 + m];
                    if (slot >= 0) {
                        const float w = ws8[ai * 4 + m];
                        bf16_t* yp = Y + (size_t)slot * DM + col;
#pragma unroll
                        for (int bj = 0; bj < 2; ++bj) {
                            const f32x4 y0 = (acc[ai][bj][m][0] + bv[bj][0]) * w, y1 = (acc[ai][bj][m][1] + bv[bj][1]) * w;
                            u32x4 q; q.x = cvt_pk_bf16(y0[0], y0[1]); q.y = cvt_pk_bf16(y0[2], y0[3]); q.z = cvt_pk_bf16(y1[0], y1[1]); q.w = cvt_pk_bf16(y1[2], y1[3]);
                            *(u32x4*)(yp + bj * 128) = q;
                        }
                    }
                }
            if (fused && u.sub == 11) asm volatile("buffer_inv sc0\n\ts_waitcnt vmcnt(0)" ::: "memory");
        }
    }
};

struct EpiDry {
    static constexpr bool MAYKEEP = false;
    bf16_t* P;
    __device__ __forceinline__ void operator()(const AccT& acc, const gm::GUnit& u, int wr, int wc, int fr, int fq) const {
        float s = 0.f;
#pragma unroll
        for (int ai = 0; ai < 2; ++ai)
#pragma unroll
            for (int bj = 0; bj < 2; ++bj)
#pragma unroll
                for (int m = 0; m < 4; ++m)
#pragma unroll
                    for (int n = 0; n < 2; ++n) s += acc[ai][bj][m][n][0] + acc[ai][bj][m][n][1] + acc[ai][bj][m][n][2] + acc[ai][bj][m][n][3];
        if (s == 123456.789f) P[(size_t)u.pm * 256 * INW + fr] = 0;
    }
};

#ifndef DRY_NT
#define DRY_NT 16
#endif
struct SchedProjDry {
    static constexpr bool VAR_STRIDE = false, GATHER_A = false, SKEW = false;
    SchedProj S;
    __device__ __forceinline__ bool next(int i, gm::GUnit& u) const { const bool ok = S.next(i, u); u.nt = DRY_NT;
#ifdef DRY_SAME
        u.A = S.H; u.B = S.W;
#endif
        return ok; }
};

namespace at {
constexpr int SHM_V = 64 * 128 * 2, SHM_K = 64 * 64 * 2;
constexpr int SLOT = SHM_V + SHM_K;
constexpr int OFF_V = 0, OFF_K = 2 * SHM_V, OFF_WS = 3 * SLOT, OFF_STASH = OFF_WS + 8 * 64 * 4, OFF_FLAG = OFF_STASH + 65536;
constexpr float SCALE = 0.125f, THR = 8.f;
#define AT_KSWZ(row, colB) ((row) * 128 + ((colB) ^ ((((row) >> 1) & 7) << 4)))
#define AT_SBAR() __builtin_amdgcn_sched_barrier(0)
__device__ __forceinline__ int crow(int r, int hi) { return (r & 3) + 8 * (r >> 2) + 4 * hi; }

constexpr float THRL = THR * 1.4426950408889634f;
template <bool FIRST>
__device__ __forceinline__ void partialSM(f32x16& p0, f32x16& p1, float& m_reg, float& alpha) {
    float pmax = p0[0];
#pragma unroll
    for (int r = 1; r < 16; ++r) pmax = fmaxf(pmax, p0[r]);
#pragma unroll
    for (int r = 0; r < 16; ++r) pmax = fmaxf(pmax, p1[r]);
    { auto rr = __builtin_amdgcn_permlane32_swap(__float_as_uint(pmax), __float_as_uint(pmax), false, false);
      pmax = fmaxf(__uint_as_float(rr[0]), __uint_as_float(rr[1])); }
    if (!FIRST && __builtin_expect(__all(pmax <= THRL), 1)) { alpha = 1.f; }
    else {
        const float d = FIRST ? pmax : fmaxf(pmax, 0.f);
        alpha = FIRST ? 1.f : __builtin_amdgcn_exp2f(-d); m_reg += d;
#pragma unroll
        for (int r = 0; r < 16; ++r) { p0[r] -= d; p1[r] -= d; }
    }
#pragma unroll
    for (int r = 0; r < 16; ++r) p0[r] = __builtin_amdgcn_exp2f(p0[r]);
}
__device__ __forceinline__ void finishSM(f32x16& p0, f32x16& p1, float alpha, float& l_reg, bf16x8& pa0, bf16x8& pa1, bf16x8& pa2, bf16x8& pa3) {
#pragma unroll
    for (int r = 0; r < 16; ++r) p1[r] = __builtin_amdgcn_exp2f(p1[r]);
    float ps = 0;
#pragma unroll
    for (int r = 0; r < 16; ++r) ps += p0[r];
#pragma unroll
    for (int r = 0; r < 16; ++r) ps += p1[r];
    { auto rr = __builtin_amdgcn_permlane32_swap(__float_as_uint(ps), __float_as_uint(ps), false, false);
      ps = __uint_as_float(rr[0]) + __uint_as_float(rr[1]); }
    l_reg = l_reg * alpha + ps;
#define AT_PK4(P, BASE, OUT) do { unsigned a0 = cvt_pk_bf16(P[BASE + 0], P[BASE + 1]), a1 = cvt_pk_bf16(P[BASE + 2], P[BASE + 3]);   \
    unsigned b0 = cvt_pk_bf16(P[BASE + 4], P[BASE + 5]), b1 = cvt_pk_bf16(P[BASE + 6], P[BASE + 7]);                              \
    auto r0 = __builtin_amdgcn_permlane32_swap(a0, b0, false, false); auto r1 = __builtin_amdgcn_permlane32_swap(a1, b1, false, false); \
    u32x4 w = {r0[0], r1[0], r0[1], r1[1]}; OUT = *reinterpret_cast<bf16x8*>(&w); } while (0)
    AT_PK4(p0, 0, pa0); AT_PK4(p0, 8, pa1); AT_PK4(p1, 0, pa2); AT_PK4(p1, 8, pa3);
#undef AT_PK4
}
#ifndef AT_TOVF
#define AT_TOVF 1099511627776.f
#endif
constexpr float TOVF = AT_TOVF;
__device__ __forceinline__ void expSM(f32x16& p) {
#pragma unroll
    for (int r = 0; r < 16; ++r) p[r] = __builtin_amdgcn_exp2f(p[r]);
}
__device__ __forceinline__ void finishFast(f32x16& p0, f32x16& p1, bool& ovf, float& l_reg, bf16x8& pa0, bf16x8& pa1, bf16x8& pa2, bf16x8& pa3) {
    expSM(p1);
    typedef float f32x2_t __attribute__((ext_vector_type(2)));
    f32x2_t sa = {p0[0], p0[1]}, sb = {p0[8], p0[9]}, sc = {p1[0], p1[1]}, sd = {p1[8], p1[9]};
#pragma unroll
    for (int r = 2; r < 8; r += 2) { sa += f32x2_t{p0[r], p0[r + 1]}; sb += f32x2_t{p0[8 + r], p0[9 + r]}; sc += f32x2_t{p1[r], p1[r + 1]}; sd += f32x2_t{p1[8 + r], p1[9 + r]}; }
    const f32x2_t ps2 = (sa + sb) + (sc + sd);
    float ps = ps2.x + ps2.y;
    { auto rr = __builtin_amdgcn_permlane32_swap(__float_as_uint(ps), __float_as_uint(ps), false, false);
      ps = __uint_as_float(rr[0]) + __uint_as_float(rr[1]); }
    l_reg += ps;
#define AT_PK4(P, BASE, OUT) do { u32x4 w = {cvt_pk_bf16(P[BASE + 0], P[BASE + 1]), cvt_pk_bf16(P[BASE + 2], P[BASE + 3]), cvt_pk_bf16(P[BASE + 4], P[BASE + 5]), cvt_pk_bf16(P[BASE + 6], P[BASE + 7])}; \
    OUT = *reinterpret_cast<bf16x8*>(&w); } while (0)
    AT_PK4(p0, 0, pa0); AT_PK4(p0, 8, pa1); AT_PK4(p1, 0, pa2); AT_PK4(p1, 8, pa3);
#undef AT_PK4
}
__device__ __forceinline__ void qkt(f32x16& p0, f32x16& p1, const LAS char* Ks, const bf16x8* qr, int r32, int hi, float init) {
#pragma unroll
    for (int r = 0; r < 16; ++r) { p0[r] = init; p1[r] = init; }
#pragma unroll
    for (int d0 = 0; d0 < 4; ++d0) { const int cb = (d0 * 16 + hi * 8) * 2;
        const bf16x8 b0 = *(const LAS bf16x8*)(Ks + AT_KSWZ(r32, cb));
        const bf16x8 b1 = *(const LAS bf16x8*)(Ks + AT_KSWZ(32 + r32, cb));
        p0 = __builtin_amdgcn_mfma_f32_32x32x16_bf16(b0, qr[d0], p0, 0, 0, 0);
        p1 = __builtin_amdgcn_mfma_f32_32x32x16_bf16(b1, qr[d0], p1, 0, 0, 0); }
}
template <int OFF> __device__ __forceinline__ bf16x8 k_read(int ka) {
    bf16x8 r; asm volatile("ds_read_b128 %0, %1 offset:%2" : "=&v"(r) : "v"(ka), "i"(OFF) : "memory"); return r;
}
template <int BOFF>
__device__ __forceinline__ void qkt_pre(f32x16& p0, f32x16& p1, const int (&ka)[4], const bf16x8* qr, float init) {
    bf16x8 a0 = k_read<BOFF>(ka[0]), b0 = k_read<BOFF + 4096>(ka[0]), a1 = k_read<BOFF>(ka[1]), b1 = k_read<BOFF + 4096>(ka[1]);
    bf16x8 a2 = k_read<BOFF>(ka[2]), b2 = k_read<BOFF + 4096>(ka[2]), a3 = k_read<BOFF>(ka[3]), b3 = k_read<BOFF + 4096>(ka[3]);
#pragma unroll
    for (int r = 0; r < 16; ++r) { p0[r] = init; p1[r] = init; }
    asm volatile("s_waitcnt lgkmcnt(6)" : "+v"(a0), "+v"(b0) :: "memory");
    p0 = __builtin_amdgcn_mfma_f32_32x32x16_bf16(a0, qr[0], p0, 0, 0, 0); p1 = __builtin_amdgcn_mfma_f32_32x32x16_bf16(b0, qr[0], p1, 0, 0, 0);
    asm volatile("s_waitcnt lgkmcnt(4)" : "+v"(a1), "+v"(b1) :: "memory");
    p0 = __builtin_amdgcn_mfma_f32_32x32x16_bf16(a1, qr[1], p0, 0, 0, 0); p1 = __builtin_amdgcn_mfma_f32_32x32x16_bf16(b1, qr[1], p1, 0, 0, 0);
    asm volatile("s_waitcnt lgkmcnt(2)" : "+v"(a2), "+v"(b2) :: "memory");
    p0 = __builtin_amdgcn_mfma_f32_32x32x16_bf16(a2, qr[2], p0, 0, 0, 0); p1 = __builtin_amdgcn_mfma_f32_32x32x16_bf16(b2, qr[2], p1, 0, 0, 0);
    asm volatile("s_waitcnt lgkmcnt(0)" : "+v"(a3), "+v"(b3) :: "memory");
    p0 = __builtin_amdgcn_mfma_f32_32x32x16_bf16(a3, qr[3], p0, 0, 0, 0); p1 = __builtin_amdgcn_mfma_f32_32x32x16_bf16(b3, qr[3], p1, 0, 0, 0);
}
__device__ __forceinline__ int v_st(int k, int c) { const int kk = (k & ~0xC) | ((k & 4) << 1) | ((k & 8) >> 1); return ((kk >> 3) * 4 + (c >> 5)) * 512 + ((kk & 7) * 32 + (c & 31)) * 2; }
__device__ __forceinline__ int v_rd_base(int lane) { return ((lane & 3) << 3) | (((lane >> 2) & 3) << 6) | (((lane >> 4) & 1) << 5) | (((lane >> 5) & 1) << 8); }
constexpr int v_rd_off(int d0, int ks, int half) { return d0 * 512 + ks * 4096 + half * 2048; }
template <int OFF> __device__ __forceinline__ s16x4 tr_read(int vb) {
    s16x4 r; asm volatile("ds_read_b64_tr_b16 %0, %1 offset:%2" : "=&v"(r) : "v"(vb), "i"(OFF) : "memory"); return r;
}
#define AT_PKV(L, H) (bf16x8){L[0], L[1], L[2], L[3], H[0], H[1], H[2], H[3]}
template <int D0> __device__ __forceinline__ void pv_one(f32x16& od, int vb, bf16x8 pa0, bf16x8 pa1, bf16x8 pa2, bf16x8 pa3) {
    const s16x4 l0 = tr_read<v_rd_off(D0, 0, 0)>(vb), h0 = tr_read<v_rd_off(D0, 0, 1)>(vb), l1 = tr_read<v_rd_off(D0, 1, 0)>(vb), h1 = tr_read<v_rd_off(D0, 1, 1)>(vb);
    const s16x4 l2 = tr_read<v_rd_off(D0, 2, 0)>(vb), h2 = tr_read<v_rd_off(D0, 2, 1)>(vb), l3 = tr_read<v_rd_off(D0, 3, 0)>(vb), h3 = tr_read<v_rd_off(D0, 3, 1)>(vb);
    asm volatile("s_waitcnt lgkmcnt(0)" ::: "memory"); AT_SBAR();
    od = __builtin_amdgcn_mfma_f32_32x32x16_bf16(pa0, AT_PKV(l0, h0), od, 0, 0, 0);
    od = __builtin_amdgcn_mfma_f32_32x32x16_bf16(pa1, AT_PKV(l1, h1), od, 0, 0, 0);
    od = __builtin_amdgcn_mfma_f32_32x32x16_bf16(pa2, AT_PKV(l2, h2), od, 0, 0, 0);
    od = __builtin_amdgcn_mfma_f32_32x32x16_bf16(pa3, AT_PKV(l3, h3), od, 0, 0, 0);
}
#ifndef AT_PVPIPE
#define AT_PVPIPE 2
#endif
#define AT_TR8(D0, X) s16x4 X##l0 = tr_read<v_rd_off(D0, 0, 0)>(vb), X##h0 = tr_read<v_rd_off(D0, 0, 1)>(vb), X##l1 = tr_read<v_rd_off(D0, 1, 0)>(vb), X##h1 = tr_read<v_rd_off(D0, 1, 1)>(vb), \
    X##l2 = tr_read<v_rd_off(D0, 2, 0)>(vb), X##h2 = tr_read<v_rd_off(D0, 2, 1)>(vb), X##l3 = tr_read<v_rd_off(D0, 3, 0)>(vb), X##h3 = tr_read<v_rd_off(D0, 3, 1)>(vb)
#define AT_MF4(OD, X) do { OD = __builtin_amdgcn_mfma_f32_32x32x16_bf16(pa0, AT_PKV(X##l0, X##h0), OD, 0, 0, 0); OD = __builtin_amdgcn_mfma_f32_32x32x16_bf16(pa1, AT_PKV(X##l1, X##h1), OD, 0, 0, 0); \
    OD = __builtin_amdgcn_mfma_f32_32x32x16_bf16(pa2, AT_PKV(X##l2, X##h2), OD, 0, 0, 0); OD = __builtin_amdgcn_mfma_f32_32x32x16_bf16(pa3, AT_PKV(X##l3, X##h3), OD, 0, 0, 0); } while (0)
__device__ __forceinline__ void pv_d0(f32x16* o, int vb, bf16x8 pa0, bf16x8 pa1, bf16x8 pa2, bf16x8 pa3) {
#if AT_PVPIPE == 2
#define AT_W8(N, X) asm volatile("s_waitcnt lgkmcnt(" #N ")" : "+v"(X##l0), "+v"(X##h0), "+v"(X##l1), "+v"(X##h1), "+v"(X##l2), "+v"(X##h2), "+v"(X##l3), "+v"(X##h3) :: "memory")
    AT_TR8(0, a); AT_TR8(1, b);
    AT_W8(8, a); AT_TR8(2, c); AT_MF4(o[0], a);
    AT_W8(8, b); AT_TR8(3, d); AT_MF4(o[1], b);
    AT_W8(8, c); AT_MF4(o[2], c);
    AT_W8(0, d); AT_MF4(o[3], d);
#undef AT_W8
#elif AT_PVPIPE == 1
    AT_TR8(0, a);
    asm volatile("s_waitcnt lgkmcnt(0)" ::: "memory"); AT_SBAR(); AT_TR8(1, b); AT_SBAR(); AT_MF4(o[0], a);
    asm volatile("s_waitcnt lgkmcnt(0)" ::: "memory"); AT_SBAR(); AT_TR8(2, c); AT_SBAR(); AT_MF4(o[1], b);
    asm volatile("s_waitcnt lgkmcnt(0)" ::: "memory"); AT_SBAR(); AT_TR8(3, d); AT_SBAR(); AT_MF4(o[2], c);
    asm volatile("s_waitcnt lgkmcnt(0)" ::: "memory"); AT_SBAR(); AT_MF4(o[3], d);
#else
    pv_one<0>(o[0], vb, pa0, pa1, pa2, pa3); pv_one<1>(o[1], vb, pa0, pa1, pa2, pa3); pv_one<2>(o[2], vb, pa0, pa1, pa2, pa3); pv_one<3>(o[3], vb, pa0, pa1, pa2, pa3);
#endif
}

template <bool ROBUST>
__device__ __forceinline__ bool attn_pass(const bf16_t* __restrict__ proj, LAS char* lds, int qrow0, int ctxrow0, int latrow0, int NT, int h, int comp, f32x16 (&o)[4]) {
    int tid = threadIdx.x; asm volatile("" : "+v"(tid));
    const int wid = tid >> 6, lane = tid & 63, r32 = lane & 31, hi = lane >> 5;
    LAS char* V_lds = lds + OFF_V; LAS char* K_lds = lds + OFF_K;
    LAS float* ws = (LAS float*)(lds + OFF_WS) + wid * 64; LAS float* li_l = ws; LAS float* al_l = ws + 32;
    float m_reg = 0.f, l_reg = 0.f;
#pragma unroll
    for (int d = 0; d < 4; ++d) o[d] = f32x16{};
    bf16x8 qr[4];
    { const bf16_t* Qw = proj + (size_t)(qrow0 + wid * 32 + r32) * INW + C_Q + h * 128 + comp * 64 + hi * 8;
#pragma unroll
      for (int d0 = 0; d0 < 4; ++d0) {
          const u32x4 w = *(const u32x4*)(Qw + d0 * 16); constexpr float C = SCALE * 1.4426950408889634f; u32x4 s;
          s.x = cvt_pk_bf16(bf_lo(w.x) * C, bf_hi(w.x) * C); s.y = cvt_pk_bf16(bf_lo(w.y) * C, bf_hi(w.y) * C); s.z = cvt_pk_bf16(bf_lo(w.z) * C, bf_hi(w.z) * C); s.w = cvt_pk_bf16(bf_lo(w.w) * C, bf_hi(w.w) * C);
          qr[d0] = *reinterpret_cast<bf16x8*>(&s); } }
    const int sr = tid >> 4, sc = (tid & 15) * 8, vst0 = v_st(sr, sc), vst1 = v_st(32 + sr, sc);
    const int kr = tid >> 3, kc = (tid & 7) * 8, kst = AT_KSWZ(kr, kc * 2);
    const int vb0 = (int)(uintptr_t)V_lds + v_rd_base(lane);
    const char* pb = (const char*)proj;
    const unsigned voV0 = (unsigned)((sr * INW + C_V + h * 128 + sc) * 2), voV1 = voV0 + 32u * INW * 2u, voK = (unsigned)((kr * INW + C_K + h * 128 + comp * 64 + kc) * 2);
    bf16x8 vsA0, vsA1, ksA, vsB0, vsB1, ksB;
#define AT_ROW(j) ((j) < 4 ? ctxrow0 + (j) * 64 : latrow0 + ((j) - 4) * 64)
#define AT_SLOAD(S, j) do { const char* _p = pb + (size_t)__builtin_amdgcn_readfirstlane(AT_ROW(j)) * (INW * 2); vs##S##0 = *(const bf16x8*)(_p + voV0); vs##S##1 = *(const bf16x8*)(_p + voV1); \
        ks##S = *(const bf16x8*)(_p + voK); } while (0)
#define AT_SWRITE(b, S) do { *(LAS bf16x8*)(V_lds + (b) * SHM_V + vst0) = vs##S##0; *(LAS bf16x8*)(V_lds + (b) * SHM_V + vst1) = vs##S##1; \
        *(LAS bf16x8*)(K_lds + (b) * SHM_K + kst) = ks##S; } while (0)
#define AT_SWAIT() asm volatile("s_waitcnt vmcnt(3)" ::: "memory")
#define AT_RESC(a) do { if (__any((a) < 1.f)) { if (hi == 0) al_l[r32] = (a); asm volatile("s_waitcnt lgkmcnt(0)" ::: "memory"); \
        _Pragma("unroll") for (int d = 0; d < 4; ++d) _Pragma("unroll") for (int r = 0; r < 16; ++r) o[d][r] *= al_l[crow(r, hi)]; } } while (0)
    bool any_ovf = false;
    if constexpr (ROBUST) {
    f32x16 pA0, pA1, pB0, pB1; float alA, alB; bf16x8 pa0, pa1, pa2, pa3;
    AT_SLOAD(A, 0); asm volatile("s_waitcnt vmcnt(0)" ::: "memory"); AT_SWRITE(0, A); __syncthreads();
    qkt(pA0, pA1, K_lds, qr, r32, hi, 0.f); partialSM<true>(pA0, pA1, m_reg, alA);
    AT_SLOAD(B, 1); if (2 < NT) AT_SLOAD(A, 2);
    AT_SWAIT(); AT_SWRITE(1, B); __syncthreads();
    for (int j = 1; j + 1 < NT; j += 2) {
        AT_SBAR(); qkt(pB0, pB1, K_lds + SHM_K, qr, r32, hi, -m_reg);
        finishSM(pA0, pA1, alA, l_reg, pa0, pa1, pa2, pa3); AT_SBAR();
        AT_SLOAD(B, j + 2); AT_SBAR();
        pv_d0(o, vb0, pa0, pa1, pa2, pa3); partialSM<false>(pB0, pB1, m_reg, alB);
        __syncthreads(); AT_SWAIT(); AT_SWRITE(0, A);
        AT_RESC(alB); __syncthreads();
        AT_SBAR(); qkt(pA0, pA1, K_lds, qr, r32, hi, -m_reg);
        finishSM(pB0, pB1, alB, l_reg, pa0, pa1, pa2, pa3); AT_SBAR();
        if (j + 3 < NT) AT_SLOAD(A, j + 3); AT_SBAR();
        pv_d0(o, vb0 + SHM_V, pa0, pa1, pa2, pa3); partialSM<false>(pA0, pA1, m_reg, alA);
        __syncthreads(); AT_SWAIT(); AT_SWRITE(1, B);
        AT_RESC(alA); __syncthreads();
    }
    AT_SBAR(); qkt(pB0, pB1, K_lds + SHM_K, qr, r32, hi, -m_reg);
    finishSM(pA0, pA1, alA, l_reg, pa0, pa1, pa2, pa3); AT_SBAR();
    pv_d0(o, vb0, pa0, pa1, pa2, pa3); partialSM<false>(pB0, pB1, m_reg, alB);
    __syncthreads(); AT_RESC(alB);
    finishSM(pB0, pB1, alB, l_reg, pa0, pa1, pa2, pa3); AT_SBAR();
    pv_d0(o, vb0 + SHM_V, pa0, pa1, pa2, pa3);
    } else {
    f32x16 pA0, pA1, pB0, pB1; bf16x8 pa0, pa1, pa2, pa3; bool ovf = false; float alA;
    int ka[4];
#pragma unroll
    for (int d0 = 0; d0 < 4; ++d0) ka[d0] = (int)(uintptr_t)(lds + SHM_V) + AT_KSWZ(r32, (d0 * 16 + hi * 8) * 2);
    const int widu = __builtin_amdgcn_readfirstlane(wid), l5 = lane >> 5, lp = lane & 31;
    const int kv = wid * 8 + (lp >> 2);
    const unsigned dV0 = (unsigned)((kv * INW + C_V + h * 128 + l5 * 32 + (lp & 3) * 8) * 2), dV1 = dV0 + 128u;
    const int krow = wid * 8 + (lane >> 3);
    const unsigned dK = (unsigned)((krow * INW + C_K + h * 128 + comp * 64) * 2 + (((lane & 7) ^ ((krow >> 1) & 7)) << 4));
#define AT_DMA_K(j, so) do { const char* _p = pb + (size_t)__builtin_amdgcn_readfirstlane(AT_ROW(j)) * (INW * 2); \
        __builtin_amdgcn_global_load_lds((const unsigned*)(_p + dK), (LAS unsigned*)(lds + (so) + SHM_V + widu * 1024), 16, 0, 0); } while (0)
#define AT_DMA_V(j, so) do { const char* _p = pb + (size_t)__builtin_amdgcn_readfirstlane(AT_ROW(j)) * (INW * 2); \
        __builtin_amdgcn_global_load_lds((const unsigned*)(_p + dV0), (LAS unsigned*)(lds + (so) + widu * 2048), 16, 0, 0); \
        __builtin_amdgcn_global_load_lds((const unsigned*)(_p + dV1), (LAS unsigned*)(lds + (so) + widu * 2048 + 1024), 16, 0, 0); } while (0)
    s16x4 dl0, dh0, dl1, dh1, dl2, dh2, dl3, dh3;
    int sV = 0, sK = SLOT, sN = 2 * SLOT;
#define AT_TR8S(D0, X) do { X##l0 = tr_read<v_rd_off(D0, 0, 0)>(vb); X##h0 = tr_read<v_rd_off(D0, 0, 1)>(vb); X##l1 = tr_read<v_rd_off(D0, 1, 0)>(vb); X##h1 = tr_read<v_rd_off(D0, 1, 1)>(vb); \
        X##l2 = tr_read<v_rd_off(D0, 2, 0)>(vb); X##h2 = tr_read<v_rd_off(D0, 2, 1)>(vb); X##l3 = tr_read<v_rd_off(D0, 3, 0)>(vb); X##h3 = tr_read<v_rd_off(D0, 3, 1)>(vb); } while (0)
#define AT_W8(N, X) asm volatile("s_waitcnt lgkmcnt(" #N ")" : "+v"(X##l0), "+v"(X##h0), "+v"(X##l1), "+v"(X##h1), "+v"(X##l2), "+v"(X##h2), "+v"(X##l3), "+v"(X##h3) :: "memory")
    const bool grpB = widu >= 4;
#define AT_BARBLK(T) do { if ((T) + 2 < NT) asm volatile("s_waitcnt vmcnt(1) lgkmcnt(0)" ::: "memory"); else asm volatile("s_waitcnt vmcnt(0) lgkmcnt(0)" ::: "memory"); \
        __builtin_amdgcn_s_barrier();     \
        if ((T) + 1 < NT) AT_DMA_V((T) + 1, sN); if ((T) + 3 < NT) AT_DMA_K((T) + 3, sK); } while (0)
#define AT_HALF(TAIL, PC0, PC1, PP0, PP1, T) do { \
        const int kb0 = ka[0] + sK, kb1 = ka[1] + sK, kb2 = ka[2] + sK, kb3 = ka[3] + sK; \
        bf16x8 a0 = k_read<0>(kb0), b0 = k_read<4096>(kb0), a1 = k_read<0>(kb1), b1 = k_read<4096>(kb1); \
        bf16x8 a2 = k_read<0>(kb2), b2 = k_read<4096>(kb2), a3 = k_read<0>(kb3), b3 = k_read<4096>(kb3); \
        AT_SBAR(); \
        if (TAIL) { AT_MF4(o[3], d); } \
        { const float init = -m_reg; _Pragma("unroll") for (int r = 0; r < 16; ++r) { PC0[r] = init; PC1[r] = init; } } \
        asm volatile("s_waitcnt lgkmcnt(6)" : "+v"(a0), "+v"(b0) :: "memory"); \
        PC0 = __builtin_amdgcn_mfma_f32_32x32x16_bf16(a0, qr[0], PC0, 0, 0, 0); PC1 = __builtin_amdgcn_mfma_f32_32x32x16_bf16(b0, qr[0], PC1, 0, 0, 0); \
        asm volatile("s_waitcnt lgkmcnt(4)" : "+v"(a1), "+v"(b1) :: "memory"); \
        PC0 = __builtin_amdgcn_mfma_f32_32x32x16_bf16(a1, qr[1], PC0, 0, 0, 0); PC1 = __builtin_amdgcn_mfma_f32_32x32x16_bf16(b1, qr[1], PC1, 0, 0, 0); \
        asm volatile("s_waitcnt lgkmcnt(2)" : "+v"(a2), "+v"(b2) :: "memory"); \
        PC0 = __builtin_amdgcn_mfma_f32_32x32x16_bf16(a2, qr[2], PC0, 0, 0, 0); PC1 = __builtin_amdgcn_mfma_f32_32x32x16_bf16(b2, qr[2], PC1, 0, 0, 0); \
        asm volatile("s_waitcnt lgkmcnt(0)" : "+v"(a3), "+v"(b3) :: "memory"); \
        PC0 = __builtin_amdgcn_mfma_f32_32x32x16_bf16(a3, qr[3], PC0, 0, 0, 0); PC1 = __builtin_amdgcn_mfma_f32_32x32x16_bf16(b3, qr[3], PC1, 0, 0, 0); \
        finishFast(PP0, PP1, ovf, l_reg, pa0, pa1, pa2, pa3); AT_SBAR(); \
        if (grpB) AT_BARBLK(T); \
        AT_SBAR(); \
        { const int vb = vb0 + sV; AT_TR8(0, a); AT_TR8(1, b); \
          AT_W8(8, a); AT_TR8(2, c); AT_MF4(o[0], a); \
          AT_W8(8, b); AT_TR8S(3, d); AT_MF4(o[1], b); \
          AT_W8(8, c); AT_MF4(o[2], c); \
          AT_W8(0, d); } \
        expSM(PC0); \
        if (!grpB) AT_BARBLK(T); \
        { const int _t = sV; sV = sK; sK = sN; sN = _t; } } while (0)
    AT_DMA_K(0, 0); AT_DMA_V(0, 0); AT_DMA_K(1, SLOT); AT_DMA_V(1, SLOT); AT_DMA_K(2, 2 * SLOT);
    asm volatile("s_waitcnt vmcnt(4)" ::: "memory"); __syncthreads();
    if (tid == 0) *(LAS int*)(lds + OFF_FLAG) = 0;
    qkt(pA0, pA1, lds + SHM_V, qr, r32, hi, 0.f); partialSM<true>(pA0, pA1, m_reg, alA);
    asm volatile("s_waitcnt vmcnt(1)" ::: "memory"); __syncthreads();
    AT_DMA_K(3, 0);
    AT_HALF(false, pB0, pB1, pA0, pA1, 1);
    for (int j = 2; j + 1 < NT; j += 2) {
        AT_HALF(true, pA0, pA1, pB0, pB1, j);
        AT_HALF(true, pB0, pB1, pA0, pA1, j + 1);
    }
    AT_MF4(o[3], d);
    finishFast(pB0, pB1, ovf, l_reg, pa0, pa1, pa2, pa3); AT_SBAR();
    pv_d0(o, vb0 + sV, pa0, pa1, pa2, pa3);
#undef AT_HALF
#undef AT_BARBLK
#undef AT_W8
#undef AT_TR8S
#undef AT_DMA_K
#undef AT_DMA_V
    any_ovf = !(l_reg < TOVF);
    }
    if (hi == 0) li_l[r32] = l_reg;
    asm volatile("s_waitcnt lgkmcnt(0)" ::: "memory");
#pragma unroll
    for (int r = 0; r < 16; ++r) { const float rl = __builtin_amdgcn_rcpf(li_l[crow(r, hi)]);
#pragma unroll
        for (int d = 0; d < 4; ++d) o[d][r] *= rl; }
    if constexpr (!ROBUST) { if (__any(any_ovf) && lane == 0) *(LAS int*)(lds + OFF_FLAG) = 1; }
    __syncthreads();
    if constexpr (!ROBUST) return __builtin_amdgcn_readfirstlane(*(LAS int*)(lds + OFF_FLAG)) != 0;
    return false;
#undef AT_ROW
#undef AT_SLOAD
#undef AT_SWRITE
#undef AT_SWAIT
#undef AT_RESC
}

__device__ __forceinline__ void attn_unit(bf16_t* __restrict__ proj, LAS char* lds, int qrow0, int b, int h, int NT, float lam, float post, const float* __restrict__ gsub) {
    const int ctxrow0 = TL + b * CTXL, latrow0 = b * SEQ;
    LAS unsigned* stash = (LAS unsigned*)(lds + OFF_STASH);
    f32x16 o[4];
#pragma unroll 1
    for (int comp = 0; comp < 2; ++comp) {
        if (attn_pass<false>(proj, lds, qrow0, ctxrow0, latrow0, NT, h, comp, o)) attn_pass<true>(proj, lds, qrow0, ctxrow0, latrow0, NT, h, comp, o);
        if (comp == 0) {
            int tid = threadIdx.x; asm volatile("" : "+v"(tid));
#pragma unroll
            for (int d = 0; d < 4; ++d)
#pragma unroll
                for (int r = 0; r < 16; r += 2) stash[(d * 8 + (r >> 1)) * NTHR + tid] = cvt_pk_bf16(o[d][r], o[d][r + 1]);
        }
    }
    int tid = threadIdx.x; asm volatile("" : "+v"(tid));
    const int wid = tid >> 6, lane = tid & 63, r32 = lane & 31, hi = lane >> 5;
    float ss[16];
#pragma unroll
    for (int r = 0; r < 16; ++r) ss[r] = 0.f;
#pragma unroll
    for (int d = 0; d < 4; ++d)
#pragma unroll
        for (int r = 0; r < 16; r += 2) {
            const unsigned w = stash[(d * 8 + (r >> 1)) * NTHR + tid];
            const float a0 = bf_lo(w) - lam * o[d][r], a1 = bf_hi(w) - lam * o[d][r + 1];
            o[d][r] = a0; o[d][r + 1] = a1; ss[r] += a0 * a0; ss[r + 1] += a1 * a1;
        }
#pragma unroll
    for (int r = 0; r < 16; ++r) {
        const float v = half32_sum(ss[r]);
        ss[r] = rsqrtf(v * (1.f / 128.f) + EPS) * post;
    }
    bf16_t* Ow = proj + (size_t)(qrow0 + wid * 32) * INW + C_Q + h * 128;
#pragma unroll
    for (int d = 0; d < 4; ++d) { const float g = gsub[d * 32 + r32];
#pragma unroll
        for (int r = 0; r < 16; ++r) Ow[(size_t)crow(r, hi) * INW + d * 32 + r32] = f2bf(o[d][r] * ss[r] * g); }
}
}

__device__ __forceinline__ void phase_attn(const Frame& F, const Params& P, int l) {
    const float lam = F.lam()[l], lam_init = 0.8f - 0.6f * expf(-0.3f * (float)l), post = 1.f - lam_init;
    const float* gsub = P.g_subln + l * 128;
    const int nlat = NB * 4 * 32, nun = nlat + (l == 0 ? NB * 4 : 0);
    for (int i = 0;; ++i) {
        int u = i * F.nwg + F.wg;
        if (F.nwg == 256 && i < 4) u = ((i * 8 + (F.wg & 7)) << 5) + (F.wg >> 3);
        if (u >= nun) break;
        int qrow0, b, h, NT;
        if (u < nlat) { b = u >> 7; h = (u >> 5) & 3; qrow0 = b * SEQ + (u & 31) * 256; NT = 132; }
        else { const int v = u - nlat; b = v >> 2; h = v & 3; qrow0 = TL + b * CTXL; NT = 4; }
        at::attn_unit(F.proj(), (LAS char*)F.lds, qrow0, b, h, NT, lam, post, gsub);
    }
}

namespace ff {
using at::tr_read; using at::v_rd_off; using at::v_st; using at::v_rd_base; using at::crow;
template <int D0> __device__ __forceinline__ void xt_two(f32x16& od1, f32x16& od2, int vb, const bf16x8 (&b1)[4], const bf16x8 (&b2)[4]) {
    const s16x4 l0 = tr_read<v_rd_off(D0, 0, 0)>(vb), h0 = tr_read<v_rd_off(D0, 0, 1)>(vb), l1 = tr_read<v_rd_off(D0, 1, 0)>(vb), h1 = tr_read<v_rd_off(D0, 1, 1)>(vb);
    const s16x4 l2 = tr_read<v_rd_off(D0, 2, 0)>(vb), h2 = tr_read<v_rd_off(D0, 2, 1)>(vb), l3 = tr_read<v_rd_off(D0, 3, 0)>(vb), h3 = tr_read<v_rd_off(D0, 3, 1)>(vb);
    asm volatile("s_waitcnt lgkmcnt(0)" ::: "memory"); __builtin_amdgcn_sched_barrier(0);
    const bf16x8 a0 = AT_PKV(l0, h0), a1 = AT_PKV(l1, h1), a2 = AT_PKV(l2, h2), a3 = AT_PKV(l3, h3);
    od1 = __builtin_amdgcn_mfma_f32_32x32x16_bf16(a0, b1[0], od1, 0, 0, 0); od2 = __builtin_amdgcn_mfma_f32_32x32x16_bf16(a0, b2[0], od2, 0, 0, 0);
    od1 = __builtin_amdgcn_mfma_f32_32x32x16_bf16(a1, b1[1], od1, 0, 0, 0); od2 = __builtin_amdgcn_mfma_f32_32x32x16_bf16(a1, b2[1], od2, 0, 0, 0);
    od1 = __builtin_amdgcn_mfma_f32_32x32x16_bf16(a2, b1[2], od1, 0, 0, 0); od2 = __builtin_amdgcn_mfma_f32_32x32x16_bf16(a2, b2[2], od2, 0, 0, 0);
    od1 = __builtin_amdgcn_mfma_f32_32x32x16_bf16(a3, b1[3], od1, 0, 0, 0); od2 = __builtin_amdgcn_mfma_f32_32x32x16_bf16(a3, b2[3], od2, 0, 0, 0);
}
}

__device__ __forceinline__ void phase_fft_a(const Frame& F) {
    const int tid = F.tid, wid = F.wid, lane = F.lane, r32 = lane & 31, hi = lane >> 5;
    LAS char* Vt = (LAS char*)F.lds;
    const int sr = tid >> 4, sc = (tid & 15) * 8;
    const int rb = wid & 3, chh = wid >> 2, k1 = 32 * rb + r32;
    const bf16_t* dc = F.dft(); const bf16_t* ds = F.dft() + 16384;
    const int NU = NB * 64 * 4;
    bf16x8 pf[4];
#define FA_LOAD(u) do { const int _b = (u) >> 8, _n2 = ((u) >> 2) & 63, _cb = (u) & 3; \
        _Pragma("unroll") for (int _q = 0; _q < 4; ++_q) { const int _n1 = (_q >> 1) * 64 + (_q & 1) * 32 + sr; \
            pf[_q] = *(const bf16x8*)(F.proj() + (size_t)(_b * SEQ + 64 * _n1 + _n2) * INW + C_FX + _cb * 128 + sc); } } while (0)
    int u = F.wg, par = 0;
    if (u < NU) FA_LOAD(u);
    for (; u < NU; u += F.nwg, par ^= 1) {
        const int b = u >> 8, n2 = (u >> 2) & 63, cb = u & 3;
        LAS char* img = Vt + par * 32768;
#pragma unroll
        for (int q = 0; q < 4; ++q) *(LAS bf16x8*)(img + (q >> 1) * 16384 + ff::v_st((q & 1) * 32 + sr, sc)) = pf[q];
        __syncthreads();
        if (u + F.nwg < NU) FA_LOAD(u + F.nwg);
        f32x16 zc[2] = {f32x16{}, f32x16{}}, zs[2] = {f32x16{}, f32x16{}};
#pragma unroll
        for (int t = 0; t < 2; ++t) {
            bf16x8 bc[4], bs[4];
#pragma unroll
            for (int ks = 0; ks < 4; ++ks) { const int o = k1 * 128 + t * 64 + ks * 16 + hi * 8; bc[ks] = *(const bf16x8*)(dc + o); bs[ks] = *(const bf16x8*)(ds + o); }
            const int vb = (int)(uintptr_t)img + t * 16384 + ff::v_rd_base(lane) + chh * 1024;
            ff::xt_two<0>(zc[0], zs[0], vb, bc, bs);
            ff::xt_two<1>(zc[1], zs[1], vb, bc, bs);
        }
        const f32x2 t2 = *(const f32x2*)(F.tw() + (size_t)(k1 * 64 + n2) * 2);
        bf16_t* zp = F.zm() + (size_t)((b * 128 + k1) * 64 + n2) * DM + cb * 128 + 64 * chh + 4 * hi;
#pragma unroll
        for (int dd = 0; dd < 2; ++dd)
#pragma unroll
            for (int g = 0; g < 4; ++g) {
                float p[4], q[4];
#pragma unroll
                for (int j = 0; j < 4; ++j) { const float c = zc[dd][4 * g + j], s = zs[dd][4 * g + j]; p[j] = c * t2.x - s * t2.y; q[j] = c * t2.y + s * t2.x; }
                u32x2 wp, wq; wp.x = cvt_pk_bf16(p[0], p[1]); wp.y = cvt_pk_bf16(p[2], p[3]); wq.x = cvt_pk_bf16(q[0], q[1]); wq.y = cvt_pk_bf16(q[2], q[3]);
                *(u32x2*)(zp + dd * 32 + 8 * g) = wp; *(u32x2*)(zp + 512 + dd * 32 + 8 * g) = wq;
            }
    }
#undef FA_LOAD
    __syncthreads();
}

__device__ __forceinline__ void phase_fft_b(const Frame& F) {
    const int tid = F.tid, wid = F.wid, lane = F.lane, r32 = lane & 31, hi = lane >> 5;
    LAS char* Vt = (LAS char*)F.lds;
    const int sr = tid >> 4, sc = (tid & 15) * 8;
    const int rb = wid & 1, cq = wid >> 1, k2 = 32 * rb + r32;
    const bf16_t* dc = F.dft() + 32768; const bf16_t* ds = dc + 4096; const bf16_t* dn = dc + 8192;
    bf16x8 bc[4], bs[4], bn[4];
#pragma unroll
    for (int ks = 0; ks < 4; ++ks) { const int o = k2 * 64 + ks * 16 + hi * 8; bc[ks] = *(const bf16x8*)(dc + o); bs[ks] = *(const bf16x8*)(ds + o); bn[ks] = *(const bf16x8*)(dn + o); }
    const int NU = NB * 128 * 4;
    bf16x8 pf[4];
#define FB_LOAD(u) do { const int _b = (u) >> 9, _k1 = ((u) >> 2) & 127, _cb = (u) & 3; \
        _Pragma("unroll") for (int _q = 0; _q < 4; ++_q) pf[_q] = *(const bf16x8*)(F.zm() + (size_t)((_b * 128 + _k1) * 64 + (_q & 1) * 32 + sr) * DM + (_q >> 1) * 512 + _cb * 128 + sc); } while (0)
    int u = F.wg, par = 0;
    if (u < NU) FB_LOAD(u);
    for (; u < NU; u += F.nwg, par ^= 1) {
        const int b = u >> 9, k1 = (u >> 2) & 127, cb = u & 3;
        LAS char* img = Vt + par * 32768;
#pragma unroll
        for (int q = 0; q < 4; ++q) *(LAS bf16x8*)(img + (q >> 1) * 16384 + ff::v_st((q & 1) * 32 + sr, sc)) = pf[q];
        __syncthreads();
        if (u + F.nwg < NU) FB_LOAD(u + F.nwg);
        f32x16 ar = f32x16{}, bi = f32x16{};
        const int vbP = (int)(uintptr_t)img + ff::v_rd_base(lane) + cq * 512;
        ff::xt_two<0>(ar, bi, vbP, bc, bs);
        ff::xt_two<0>(ar, bi, vbP + 16384, bn, bc);
        bf16_t* op = F.proj() + (size_t)(b * SEQ + k1 + 128 * k2) * INW + cb * 128 + 32 * cq + 4 * hi;
#pragma unroll
        for (int g = 0; g < 4; ++g) {
            u32x2 wa, wb;
            wa.x = cvt_pk_bf16(ar[4 * g] * 0.011048543456039806f, ar[4 * g + 1] * 0.011048543456039806f); wa.y = cvt_pk_bf16(ar[4 * g + 2] * 0.011048543456039806f, ar[4 * g + 3] * 0.011048543456039806f);
            wb.x = cvt_pk_bf16(bi[4 * g] * 0.011048543456039806f, bi[4 * g + 1] * 0.011048543456039806f); wb.y = cvt_pk_bf16(bi[4 * g + 2] * 0.011048543456039806f, bi[4 * g + 3] * 0.011048543456039806f);
            *(u32x2*)(op + C_K + 8 * g) = wa; *(u32x2*)(op + C_V + 8 * g) = wb;
        }
    }
#undef FB_LOAD
    __syncthreads();
}

__device__ __forceinline__ void phase_ctx_dft(const Frame& F) {
    const int tid = F.tid, wid = F.wid, lane = F.lane, r32 = lane & 31, hi = lane >> 5;
    LAS char* Vt = (LAS char*)F.lds;
    const int sr = tid >> 4, sc = (tid & 15) * 8, np = 32 * wid + r32;
    const bf16_t* dc = F.dft256(); const bf16_t* ds = dc + 65536;
    for (int u = F.wg; u < NB * 4; u += F.nwg) {
        const int b = u >> 2, cb = u & 3;
#pragma unroll
        for (int q = 0; q < 8; ++q) {
            const int key = (q & 1) * 32 + sr, n = (q >> 1) * 64 + key;
            const bf16x8 v = *(const bf16x8*)(F.proj() + (size_t)(TL + b * CTXL + n) * INW + C_FX + cb * 128 + sc);
            *(LAS bf16x8*)(Vt + (q >> 1) * 16384 + ff::v_st(key, sc)) = v;
        }
        __syncthreads();
        bf16_t* op = F.zm() + (size_t)(TL + b * CTXL + np) * DM + cb * 128 + 4 * hi;
#pragma unroll 1
        for (int hf = 0; hf < 2; ++hf) {
            f32x16 ac[2] = {f32x16{}, f32x16{}}, as[2] = {f32x16{}, f32x16{}};
#pragma unroll
            for (int q = 0; q < 4; ++q) {
                bf16x8 bc[4], bs[4];
#pragma unroll
                for (int ks = 0; ks < 4; ++ks) { const int o = np * 256 + q * 64 + ks * 16 + hi * 8; bc[ks] = *(const bf16x8*)(dc + o); bs[ks] = *(const bf16x8*)(ds + o); }
                const int vb = (int)(uintptr_t)Vt + q * 16384 + ff::v_rd_base(lane) + hf * 1024;
                ff::xt_two<0>(ac[0], as[0], vb, bc, bs); ff::xt_two<1>(ac[1], as[1], vb, bc, bs);
            }
#pragma unroll
            for (int dd = 0; dd < 2; ++dd)
#pragma unroll
                for (int g = 0; g < 4; ++g) {
                    u32x2 wa, wb;
                    wa.x = cvt_pk_bf16(ac[dd][4 * g] * 0.0625f, ac[dd][4 * g + 1] * 0.0625f); wa.y = cvt_pk_bf16(ac[dd][4 * g + 2] * 0.0625f, ac[dd][4 * g + 3] * 0.0625f);
                    wb.x = cvt_pk_bf16(as[dd][4 * g] * 0.0625f, as[dd][4 * g + 1] * 0.0625f); wb.y = cvt_pk_bf16(as[dd][4 * g + 2] * 0.0625f, as[dd][4 * g + 3] * 0.0625f);
                    *(u32x2*)(op + 64 * hf + 32 * dd + 8 * g) = wa; *(u32x2*)(op + 512 + 64 * hf + 32 * dd + 8 * g) = wb;
                }
        }
        __syncthreads();
    }
}

__device__ __forceinline__ int moe_rows_per_wg(int nrows, int nwg) { return (nrows + nwg - 1) / nwg; }
__device__ __forceinline__ void phase_norm2_route(const Frame& F, const Params& P, int l, int nrows, long long dctx) {
    constexpr int WROW = 1024 + 8;
    LAS bf16_t* whi = (LAS bf16_t*)F.lds; LAS bf16_t* wlo = whi + 32 * WROW;
    LAS int* hist = (LAS int*)(F.lds + 2 * 32 * WROW * 2);
    const float* wr = P.w_router + (size_t)l * DM * NEXP;
    for (int i = F.tid; i < DM * NEXP; i += NTHR) {
        const int d = i >> 5, e = i & 31; const float w = wr[i]; const bf16_t h = f2bf(w);
        whi[e * WROW + d] = h; wlo[e * WROW + d] = f2bf(w - bf2f(h));
    }
    if (F.tid < 32) hist[F.tid] = 0;
    const float* g = P.g_norm2 + l * DM;
    const int per = moe_rows_per_wg(nrows, F.nwg), r0 = F.wg * per, r1 = min(nrows, r0 + per);
    bf16_t* LO = F.proj();
    for (int rowA = r0 + F.wid; rowA < r1; rowA += 16) {
        const int rowB = rowA + 8; const bool hasB = rowB < r1; const int rowBs = hasB ? rowB : rowA;
        const float* xa = xrow_ptr(P.out, dctx, rowA); const float* xb = xrow_ptr(P.out, dctx, rowBs);
        f32x4 va[4], vb[4]; float sa = 0.f, sb = 0.f;
#pragma unroll
        for (int j = 0; j < 4; ++j) { va[j] = *(const f32x4*)(xa + F.lane * 4 + 256 * j); vb[j] = *(const f32x4*)(xb + F.lane * 4 + 256 * j); }
#pragma unroll
        for (int j = 0; j < 4; ++j) { sa += va[j][0] * va[j][0] + va[j][1] * va[j][1] + va[j][2] * va[j][2] + va[j][3] * va[j][3]; sb += vb[j][0] * vb[j][0] + vb[j][1] * vb[j][1] + vb[j][2] * vb[j][2] + vb[j][3] * vb[j][3]; }
        sa = wave_sum(sa); sb = wave_sum(sb);
        const float ra = rsqrtf(sa * (1.f / 1024.f) + EPS), rb = rsqrtf(sb * (1.f / 1024.f) + EPS);
        const float* mda = F.mods() + (size_t)(l * 9 + (rowA < TL ? (rowA >> 13) : 8)) * 6144;
        const float* mdb = F.mods() + (size_t)(l * 9 + (rowBs < TL ? (rowBs >> 13) : 8)) * 6144;
#pragma unroll
        for (int j = 0; j < 4; ++j) {
            const int col = F.lane * 4 + 256 * j;
            const f32x4 gg = *(const f32x4*)(g + col);
            const f32x4 sha = *(const f32x4*)(mda + 3 * 1024 + col), sca = *(const f32x4*)(mda + 4 * 1024 + col);
            const f32x4 shb = *(const f32x4*)(mdb + 3 * 1024 + col), scb = *(const f32x4*)(mdb + 4 * 1024 + col);
            float oa[4], ob[4];
#pragma unroll
            for (int i = 0; i < 4; ++i) { oa[i] = va[j][i] * ra * gg[i] * (1.f + sca[i]) + sha[i]; ob[i] = vb[j][i] * rb * gg[i] * (1.f + scb[i]) + shb[i]; }
            u32x2 ha, hb, la, lb;
            ha.x = cvt_pk_bf16(oa[0], oa[1]); ha.y = cvt_pk_bf16(oa[2], oa[3]); hb.x = cvt_pk_bf16(ob[0], ob[1]); hb.y = cvt_pk_bf16(ob[2], ob[3]);
            la.x = cvt_pk_bf16(oa[0] - bf_lo(ha.x), oa[1] - bf_hi(ha.x)); la.y = cvt_pk_bf16(oa[2] - bf_lo(ha.y), oa[3] - bf_hi(ha.y));
            lb.x = cvt_pk_bf16(ob[0] - bf_lo(hb.x), ob[1] - bf_hi(hb.x)); lb.y = cvt_pk_bf16(ob[2] - bf_lo(hb.y), ob[3] - bf_hi(hb.y));
            *(u32x2*)(F.H() + (size_t)rowA * DM + col) = ha; *(u32x2*)(LO + (size_t)rowA * DM + col) = la;
            if (hasB) { *(u32x2*)(F.H() + (size_t)rowB * DM + col) = hb; *(u32x2*)(LO + (size_t)rowB * DM + col) = lb; }
        }
    }
    asm volatile("s_waitcnt vmcnt(0)" ::: "memory");
    __syncthreads();
    const int r32 = F.lane & 31, hi = F.lane >> 5;
    const float bias = P.b_router[l * NEXP + r32];
    const int ntile = (r1 - r0 + 31) >> 5;
    for (int t = F.wid; t < ntile; t += 8) {
        const int rowbase = r0 + t * 32, myrow = min(rowbase + r32, r1 - 1);
        const bf16_t* ph = F.H() + (size_t)myrow * DM + hi * 8; const bf16_t* pl = LO + (size_t)myrow * DM + hi * 8;
        const LAS bf16_t* bh = whi + r32 * WROW + hi * 8; const LAS bf16_t* bl = wlo + r32 * WROW + hi * 8;
        f32x16 acc = f32x16{};
        bf16x8 ahA[8], alA[8], ahB[8], alB[8];
#pragma unroll
        for (int q = 0; q < 8; ++q) { ahA[q] = *(const bf16x8*)(ph + q * 16); alA[q] = *(const bf16x8*)(pl + q * 16); }
#pragma unroll
        for (int bt = 0; bt < 8; bt += 2) {
#pragma unroll
            for (int q = 0; q < 8; ++q) { ahB[q] = *(const bf16x8*)(ph + ((bt + 1) * 8 + q) * 16); alB[q] = *(const bf16x8*)(pl + ((bt + 1) * 8 + q) * 16); }
#pragma unroll
            for (int q = 0; q < 8; ++q) { const int ks = bt * 8 + q;
                const bf16x8 wh = *(const LAS bf16x8*)(bh + ks * 16), wl = *(const LAS bf16x8*)(bl + ks * 16);
                acc = __builtin_amdgcn_mfma_f32_32x32x16_bf16(ahA[q], wh, acc, 0, 0, 0); acc = __builtin_amdgcn_mfma_f32_32x32x16_bf16(ahA[q], wl, acc, 0, 0, 0); acc = __builtin_amdgcn_mfma_f32_32x32x16_bf16(alA[q], wh, acc, 0, 0, 0); }
            if (bt + 2 < 8) {
#pragma unroll
                for (int q = 0; q < 8; ++q) { ahA[q] = *(const bf16x8*)(ph + ((bt + 2) * 8 + q) * 16); alA[q] = *(const bf16x8*)(pl + ((bt + 2) * 8 + q) * 16); }
            }
#pragma unroll
            for (int q = 0; q < 8; ++q) { const int ks = (bt + 1) * 8 + q;
                const bf16x8 wh = *(const LAS bf16x8*)(bh + ks * 16), wl = *(const LAS bf16x8*)(bl + ks * 16);
                acc = __builtin_amdgcn_mfma_f32_32x32x16_bf16(ahB[q], wh, acc, 0, 0, 0); acc = __builtin_amdgcn_mfma_f32_32x32x16_bf16(ahB[q], wl, acc, 0, 0, 0); acc = __builtin_amdgcn_mfma_f32_32x32x16_bf16(alB[q], wh, acc, 0, 0, 0); }
        }
#pragma unroll
        for (int r = 0; r < 16; ++r) {
            float v = acc[r] + bias;
            float tv[4]; int ti[4];
#pragma unroll
            for (int k = 0; k < 4; ++k) {
                float bv = v; int bi = r32;
#define RT_STEP(CTRL) do { const float ov = dpp_f<CTRL>(bv); const int oi = dpp_i<CTRL>(bi); const bool take = (ov > bv) || (ov == bv && oi < bi); bv = take ? ov : bv; bi = take ? oi : bi; } while (0)
                RT_STEP(DPP_X1); RT_STEP(DPP_X2); RT_STEP(DPP_HMIR); RT_STEP(DPP_MIR);
#undef RT_STEP
                {
                    const auto rv = __builtin_amdgcn_permlane16_swap(__float_as_uint(bv), __float_as_uint(bv), false, false);
                    const auto ri = __builtin_amdgcn_permlane16_swap((unsigned)bi, (unsigned)bi, false, false);
                    const float v0 = __uint_as_float(rv[0]), v1 = __uint_as_float(rv[1]); const int i0 = (int)ri[0], i1 = (int)ri[1];
                    const bool take1 = (v1 > v0) || (v1 == v0 && i1 < i0);
                    bv = take1 ? v1 : v0; bi = take1 ? i1 : i0;
                }
                tv[k] = bv; ti[k] = bi;
                v = (r32 == bi) ? -3.0e38f : v;
            }
            const int row = rowbase + at::crow(r, hi);
            if (r32 == r && row < r1) {
                float w4[4], den = 0.f;
#pragma unroll
                for (int k = 0; k < 4; ++k) { w4[k] = __expf(tv[k] - tv[0]); den += w4[k]; }
                const float inv = 1.f / den;
#pragma unroll
                for (int k = 0; k < 4; ++k) {
                    F.sele()[(size_t)row * 4 + k] = ti[k]; F.selw()[(size_t)row * 4 + k] = w4[k] * inv;
                    __hip_atomic_fetch_add(&hist[ti[k]], 1, __ATOMIC_RELAXED, __HIP_MEMORY_SCOPE_WORKGROUP);
                }
            }
        }
    }
    __syncthreads();
    if (F.tid < 32) F.cntw()[F.wg * 32 + F.tid] = hist[F.tid];
    __syncthreads();
}

__device__ __forceinline__ LAS int* moe_tb(const Frame& F) { return (LAS int*)(F.lds + LDS_MISC + 64); }
__device__ __forceinline__ void moe_sum_counts(const Frame& F, LAS int* tot, LAS int* pre, LAS int* scratch) {
    const int e = F.tid & 31, q = F.tid >> 5;
    int st = 0, sp = 0;
    for (int w = q; w < F.nwg; w += 16) { const int c = F.cntw()[w * 32 + e]; st += c; sp += (w < F.wg) ? c : 0; }
    scratch[q * 32 + e] = st; scratch[512 + q * 32 + e] = sp;
    __syncthreads();
    if (F.tid < 32) { int a = 0, b = 0;
        for (int k = 0; k < 16; ++k) { a += scratch[k * 32 + F.tid]; b += scratch[512 + k * 32 + F.tid]; }
        tot[F.tid] = a; pre[F.tid] = b; }
    __syncthreads();
}
__device__ __forceinline__ void moe_build_tb(const Frame& F) {
    LAS int* tb = moe_tb(F); LAS int* tot = tb + 40; LAS int* pre = tb + 80; LAS int* scratch = (LAS int*)F.lds;
    moe_sum_counts(F, tot, pre, scratch);
    if (F.tid == 0) { int acc = 0; tb[0] = 0; for (int e = 0; e < 32; ++e) { acc += (tot[e] + 255) >> 8; tb[e + 1] = acc; } }
    __syncthreads();
}
__device__ __forceinline__ void phase_positions(const Frame& F, int l, int nrows) {
    LAS int* tb = moe_tb(F); LAS int* tot = tb + 40; LAS int* pre = tb + 80;
    LAS int* rank = (LAS int*)(F.lds + 8192);
    moe_build_tb(F);
    if (F.tid < 32) rank[F.tid] = 0;
    __syncthreads();
    const int per = moe_rows_per_wg(nrows, F.nwg), r0 = F.wg * per, r1 = min(nrows, r0 + per);
    for (int i = r0 * 4 + F.tid; i < r1 * 4; i += NTHR) {
        const int e = F.sele()[i], r = __hip_atomic_fetch_add(&rank[e], 1, __ATOMIC_RELAXED, __HIP_MEMORY_SCOPE_WORKGROUP);
        const int pos = tb[e] * 256 + pre[e] + r;
        F.rtok()[pos] = i; F.rw()[pos] = F.selw()[i];
    }
    for (int e = F.wg; e < 32; e += F.nwg) {
        const int base = tb[e] * 256 + tot[e], end = tb[e + 1] * 256;
        for (int p = base + F.tid; p < end; p += NTHR) { F.rtok()[p] = -1; F.rw()[p] = 0.f; }
    }
    __syncthreads();
}

constexpr int NPHL = 11;
constexpr int NPHASE = 1 + 2 * NPHL + 1;

__device__ __forceinline__ void launder(Frame& F) { int t = threadIdx.x; asm volatile("" : "+v"(t)); F.tid = t; F.lane = t & 63; F.wid = __builtin_amdgcn_readfirstlane(t >> 6);
    unsigned long long w = (unsigned long long)F.ws; asm volatile("" : "+s"(w)); F.ws = (unsigned char*)(__attribute__((address_space(1))) unsigned char*)w; }
__global__ void __launch_bounds__(NTHR, 2) fwd_kernel(Params prm) {
    extern __shared__ __attribute__((aligned(16))) unsigned char lds_raw[];
    Frame F;
    const Params& P = prm;
    F.tid = threadIdx.x; F.lane = F.tid & 63; F.wid = __builtin_amdgcn_readfirstlane(F.tid >> 6); F.wg = blockIdx.x; F.nwg = gridDim.x;
    F.lds = (LAS unsigned char*)lds_raw;
    F.ws = prm.ws;

    volatile LAS unsigned* misc = (volatile LAS unsigned*)(F.lds + LDS_MISC);
    if (F.tid < 16) misc[F.tid] = 0u;
    __syncthreads();
    const int lo = prm.ph_lo, hi = prm.ph_hi;
    XcdBarrier bar; bar.bar = F.ctl() + CW_BAR; bar.x = 0; bar.st = misc;
    if (hi - lo > 1) bar = xcd_barrier_post(F.ctl() + CW_BAR, misc);
#ifndef PH_MASK
#define PH_MASK 0xFFF
#endif
#define EN(g) (((PH_MASK) >> (g)) & 1)
#define IN(k) (lo <= (k) && (k) < hi)
#ifdef PROBE_DOUBLE_BARRIER
#define SEAM(k) do { if (IN((k) + 1)) { xcd_barrier(bar); xcd_barrier(bar); } } while (0)
#else
#define SEAM(k) do { if (IN((k) + 1)) xcd_barrier(bar); } while (0)
#endif
#ifdef PROBE_MASK
#define PB_BEGIN(id) unsigned long long _pt0_##id = (((PROBE_MASK) >> (id)) & 1) ? __builtin_amdgcn_s_memrealtime() : 0ull
#define PB_END(id) do { if (((PROBE_MASK) >> (id)) & 1) { __syncthreads(); const unsigned long long _t1 = __builtin_amdgcn_s_memrealtime(), _w = (_t1 - _pt0_##id) * (PROBE_MUL); \
        while (__builtin_amdgcn_s_memrealtime() - _t1 < _w) __builtin_amdgcn_s_sleep(8); } } while (0)
#else
#define PB_BEGIN(id) do {} while (0)
#define PB_END(id) do {} while (0)
#endif

    if (EN(0) && IN(0)) { PB_BEGIN(0); launder(F); p0_prologue(F, P); PB_END(0); SEAM(0); }

    for (int l = 0; l < NLAYER; ++l) {
        const int PB = 1 + l * NPHL;
        const int nrows = (l == 0) ? TA : TL;
        const float* modl = F.mods() + (size_t)l * 9 * 6144;
        const int cx = (F.nwg % 8 == 0) ? (F.wg & 7) * (F.nwg / 8) + (F.wg >> 3) : F.wg;
        const float* xs = (l == 0) ? prm.x : prm.out;
        const long long dxs = (long long)(F.ctxb() - xs) - (long long)TL * DM;
        const long long dout = (long long)(F.ctxb() - prm.out) - (long long)TL * DM;
        const long long dcin = (l == 0) ? (long long)(prm.ctx - xs) - (long long)TL * DM : dxs;
        if (EN(1) && IN(PB + 0)) { PB_BEGIN(1); launder(F); phase_norm1(F, P, l, xs, dxs, l > 0, prm.out, dout); PB_END(1); SEAM(PB + 0); }
        if (EN(2) && IN(PB + 1)) {
            SchedProj S{(const char*)F.H(), (const char*)(F.win() + (size_t)l * INW * DM), (const char*)(F.wgate() + (size_t)l * INW * DM), l, F.nwg, F.wg};
            EpiProj E{F.proj(), F.rope(), F.g8(), prm.b_mgate + l * INW};
#ifdef DRY_GEMM1
            { EpiDry ED{F.proj()}; SchedProjDry SD{S}; gm::gemm_phase<true>(F.lds, SD, ED); }
#endif
            PB_BEGIN(2); gm::gemm_phase<true>(F.lds, S, E); PB_END(2);
            SEAM(PB + 1);
        }
        if (EN(3) && IN(PB + 2)) {
#ifndef SUB3
#define SUB3 15
#endif
            PB_BEGIN(3); launder(F); if (SUB3 & 1) phase_conv(F, P, l, nrows); launder(F); PB_END(3); PB_BEGIN(4);
            if (SUB3 & 2) phase_fft_a(F);
            launder(F); if ((SUB3 & 4) && l == 0) phase_ctx_dft(F); launder(F); PB_END(4); PB_BEGIN(5);
            if (SUB3 & 8) phase_attn(F, P, l);
            PB_END(5);
            SEAM(PB + 2);
        }
        if (EN(4) && IN(PB + 3)) {
            PB_BEGIN(6); launder(F); phase_fft_b(F); PB_END(6);
            PB_BEGIN(7); launder(F); phase_pool(F, nrows);
            launder(F); if (l == 0) phase_ctx_dft_copy(F); PB_END(7);
            SEAM(PB + 3);
        }
        if (EN(5) && IN(PB + 4)) {
            const bool split0 = (l == 0) && (F.nwg == 256);
            SchedMerge S{(const char*)F.proj(), (const char*)(F.wbr() + (size_t)l * DM * WBR_K), ((l == 0 && !split0) ? 264 : 256) * 4, F.nwg, F.wg, false};
            EpiMerge E{F.g8(), F.zm()};
            PB_BEGIN(8); gm::gemm_phase<true>(F.lds, S, E); PB_END(8);
            SEAM(PB + 4);
        }
        if (EN(6) && IN(PB + 5)) {
            const bool split0 = (l == 0) && (F.nwg == 256);
            EpiOut E{xs, prm.out, dcin, dout, modl};
            if (split0) {
                { SchedMerge SM{(const char*)F.proj(), (const char*)(F.wbr() + (size_t)l * DM * WBR_K), 0, F.nwg, F.wg, true};
                  EpiMerge EM{F.g8(), F.zm()};
                  gm::gemm_phase<true>(F.lds, SM, EM);
                  asm volatile("s_waitcnt vmcnt(0)" ::: "memory");
                  __syncthreads();
                  if (F.tid == 0 && F.wg < 32) { __builtin_amdgcn_fence(__ATOMIC_RELEASE, "agent"); (void)xb_add(F.ctl() + CW_CTXM, 1u); } }
            }
            { SchedOut S{(const char*)F.zm(), (const char*)(F.wout() + (size_t)l * DM * DM), (l == 0 ? 264 : 256) * 4, F.nwg, F.wg, split0 ? 1 : 0};
              PB_BEGIN(9); gm::gemm_phase<false>(F.lds, S, E); PB_END(9); }
            if (split0) {
                if (F.tid == 0 && F.wg >= 96 && F.wg < 128) { unsigned* barw = F.ctl() + CW_BAR; XB_SPIN(xb_ld(F.ctl() + CW_CTXM) < 32u, barw); __builtin_amdgcn_fence(__ATOMIC_ACQUIRE, "agent"); }
                __syncthreads();
                SchedOut SC{(const char*)F.zm(), (const char*)(F.wout() + (size_t)l * DM * DM), 0, F.nwg, F.wg, 2};
                gm::gemm_phase<false>(F.lds, SC, E);
            }
            SEAM(PB + 5);
        }
        if (EN(7) && IN(PB + 6)) {
            PB_BEGIN(11); launder(F); phase_norm2_route(F, P, l, nrows, dout); PB_END(11);
            asm volatile("s_waitcnt vmcnt(0)" ::: "memory");
            __syncthreads();
            if (F.tid == 0) { __builtin_amdgcn_fence(__ATOMIC_RELEASE, "agent"); (void)xb_add(F.ctl() + CW_ROUTED + l * 64, 1u); }
            PB_BEGIN(10); launder(F); cvt_experts(F, P, l); PB_END(10);
            if (F.tid == 0) { unsigned* barw = F.ctl() + CW_BAR; XB_SPIN(xb_ld(F.ctl() + CW_ROUTED + l * 64) < (unsigned)F.nwg, barw); __builtin_amdgcn_fence(__ATOMIC_ACQUIRE, "agent"); }
            __syncthreads();
            PB_BEGIN(12); launder(F); phase_positions(F, l, nrows); PB_END(12);
            SEAM(PB + 6);
        }
        if (EN(9) && IN(PB + 8)) {
            launder(F); moe_build_tb(F);
            const int G = F.nwg, c = (G % 8 == 0) ? (F.wg & 7) * (G / 8) + (F.wg >> 3) : F.wg;
            const int nfull = (moe_tb(F)[32] / G) * G, nrem8 = (moe_tb(F)[32] - nfull) * 8;
            unsigned* gudone = F.ctl() + CW_GUDONE + l * 64;
            {
                SchedMoeSplit<true> S2{(const char*)F.H(), (const char*)F.gu(), F.rtok(), moe_tb(F), nfull, G, F.wg};
                EpiMoe E2{(char*)F.acts2(), prm.b_e_gate + (size_t)l * NEXP * DM, prm.b_e_up + (size_t)l * NEXP * DM, prm.b_e_down + (size_t)l * NEXP * DM, F.rtok(), F.rw(), F.Y(), false};
                PB_BEGIN(14); gm::gemm_phase<true>(F.lds, S2, E2); PB_END(14);
                asm volatile("s_waitcnt vmcnt(0)" ::: "memory");
                __syncthreads();
                if (F.tid == 0) {
                    const int mine = (nrem8 > F.wg) ? (nrem8 - F.wg + G - 1) / G : 0;
                    if (mine > 0) { __builtin_amdgcn_fence(__ATOMIC_RELEASE, "agent"); (void)xb_add(gudone, (unsigned)mine); }
                }
            }
            {
                SchedMoeFused S{(const char*)F.H(), (const char*)F.gu(), (const char*)F.dn(), (const char*)F.acts(), F.rtok(), moe_tb(F), nfull, G, c, (unsigned)F.wg * (256u * 2048u)};
                EpiMoe E{(char*)F.acts(), prm.b_e_gate + (size_t)l * NEXP * DM, prm.b_e_up + (size_t)l * NEXP * DM, prm.b_e_down + (size_t)l * NEXP * DM, F.rtok(), F.rw(), F.Y(), true};
                PB_BEGIN(13); gm::gemm_phase<true>(F.lds, S, E); PB_END(13);
            }
            {
                if (F.tid == 0) {
                    unsigned* barw = F.ctl() + CW_BAR;
                    XB_SPIN(xb_ld(gudone) < (unsigned)nrem8, barw);
                    __builtin_amdgcn_fence(__ATOMIC_ACQUIRE, "agent");
                }
                __syncthreads();
                SchedMoeSplit<false> S3{(const char*)F.acts2(), (const char*)F.dn(), F.rtok(), moe_tb(F), nfull, G, G - 1 - F.wg};
                EpiMoe E3{(char*)F.acts(), prm.b_e_gate + (size_t)l * NEXP * DM, prm.b_e_up + (size_t)l * NEXP * DM, prm.b_e_down + (size_t)l * NEXP * DM, F.rtok(), F.rw(), F.Y(), false};
                PB_BEGIN(14); gm::gemm_phase<true>(F.lds, S3, E3); PB_END(14);
            }
            SEAM(PB + 8);
        }
    }
    if (EN(11) && IN(NPHASE - 1)) { PB_BEGIN(15); launder(F); phase_final(F, P); PB_END(15); }
#undef IN
#undef SEAM
}

#ifndef N_LAUNCH_MODE
#define N_LAUNCH_MODE 0
#endif
extern "C" void kernel_launch(void* const* d_in, const int* in_sizes, int n_in, void* d_out, int out_size, void* d_ws, size_t ws_size, hipStream_t stream) {
    static int grid = 0;
    if (grid == 0) {
        if (n_in != 27 || out_size != TL * DM || ws_size < WS_END) { fprintf(stderr, "kernel_launch: unexpected shapes (n_in %d out %d ws %zu need %zu)\n", n_in, out_size, ws_size, (size_t)WS_END); grid = -1; return; }
        int dev = 0, cus = 0, per_cu = 0;
        if (hipGetDevice(&dev) != hipSuccess || hipDeviceGetAttribute(&cus, hipDeviceAttributeMultiprocessorCount, dev) != hipSuccess) { grid = -1; return; }
        if (hipFuncSetAttribute((const void*)fwd_kernel, hipFuncAttributeMaxDynamicSharedMemorySize, LDS_BYTES) != hipSuccess) { fprintf(stderr, "kernel_launch: hipFuncSetAttribute failed\n"); grid = -1; return; }
        if (hipOccupancyMaxActiveBlocksPerMultiprocessor(&per_cu, (const void*)fwd_kernel, NTHR, LDS_BYTES) != hipSuccess || per_cu < 1) { fprintf(stderr, "kernel_launch: occupancy query says %d\n", per_cu); }
        (void)hipGetLastError();
        grid = cus;
    }
    if (grid < 0) return;
    (void)hipMemsetAsync((char*)d_ws + WS_CTL, 0, CTL_BYTES, stream);
    Params p{};
    const float** pf = (const float**)&p;
    for (int i = 0; i < 27; ++i) pf[i] = (const float*)d_in[i];
    p.out = (float*)d_out; p.ws = (unsigned char*)d_ws;
#if N_LAUNCH_MODE == 0
    p.ph_lo = 0; p.ph_hi = NPHASE;
    hipLaunchKernelGGL(fwd_kernel, dim3(grid), dim3(NTHR), LDS_BYTES, stream, p);
#else
    for (int ph = 0; ph < NPHASE; ++ph) { p.ph_lo = ph; p.ph_hi = ph + 1; hipLaunchKernelGGL(fwd_kernel, dim3(grid), dim3(NTHR), LDS_BYTES, stream, p); }
#endif
    const hipError_t le = hipPeekAtLastError();
    if (le != hipSuccess) fprintf(stderr, "kernel_launch: launch failed: %s\n", hipGetErrorName(le));
}
```

```cpp
#include <hip/hip_runtime.h>
#include <stdint.h>
#include <stdio.h>

#define LAS __attribute__((address_space(3)))
typedef unsigned short bf16_t;
typedef short bf16x8 __attribute__((ext_vector_type(8)));
typedef short s16x4 __attribute__((ext_vector_type(4)));
typedef float f32x2 __attribute__((ext_vector_type(2)));
typedef float f32x4 __attribute__((ext_vector_type(4)));
typedef float f32x16 __attribute__((ext_vector_type(16)));
typedef unsigned u32x2 __attribute__((ext_vector_type(2)));
typedef unsigned u32x4 __attribute__((ext_vector_type(4)));

constexpr int DM = 1024, NB = 8, SEQ = 8192, CTXL = 256, NLAYER = 2;
constexpr int TL = NB * SEQ;
constexpr int TC = NB * CTXL;
constexpr int TA = TL + TC;
constexpr int INW = 4096;
constexpr int C_Q = 0, C_K = 512, C_V = 1024, C_SX = 1536, C_SB = 2048, C_SC = 2560, C_FX = 3072, C_PX = 3584;
constexpr int NEXP = 32, TOPK = 4;
constexpr int MAXROWS = 4 * TA + NEXP * 256;
constexpr int WBR_K = 2560;
constexpr float EPS = 1e-6f;
constexpr int NTHR = 512;

constexpr size_t al256(size_t x) { return (x + 255) & ~(size_t)255; }
constexpr size_t WS_CTL = 0, CTL_BYTES = 256 * 1024;
constexpr size_t WS_MODS = WS_CTL + CTL_BYTES;
constexpr size_t WS_ROPE = al256(WS_MODS + (size_t)2 * 9 * 6144 * 4);
constexpr size_t WS_TW = al256(WS_ROPE + 2 * 128 * 16 * 4);
constexpr size_t WS_DFT = al256(WS_TW + 128 * 64 * 2 * 4);
constexpr size_t WS_DFT256 = al256(WS_DFT + (size_t)(2 * 128 * 128 + 3 * 64 * 64) * 2);
constexpr size_t WS_LAM = al256(WS_DFT256 + (size_t)2 * 256 * 256 * 2);
constexpr size_t WS_CTXB = al256(WS_LAM + 256);
constexpr size_t WS_WIN = al256(WS_CTXB + (size_t)TC * DM * 4);
constexpr size_t WS_WGATE = al256(WS_WIN + (size_t)2 * INW * DM * 2);
constexpr size_t WS_WBR = al256(WS_WGATE + (size_t)2 * INW * DM * 2);
constexpr size_t WS_WOUT = al256(WS_WBR + (size_t)2 * DM * WBR_K * 2);
constexpr size_t WS_GU = al256(WS_WOUT + (size_t)2 * DM * DM * 2);
constexpr size_t WS_DN = al256(WS_GU + (size_t)NEXP * 2048 * DM * 2);
constexpr size_t WS_ACT2 = al256(WS_DN + (size_t)NEXP * 1024 * DM * 2);
constexpr size_t WS_G8 = WS_GU;
constexpr size_t WS_H = al256(WS_GU + (size_t)TA * INW);
static_assert(WS_ACT2 + (size_t)64 * 256 * 1024 * 2 <= WS_H, "remainder act tiles must fit in the slack of the gate-byte region");
constexpr size_t WS_PROJ = al256(WS_H + (size_t)TA * DM * 2);
constexpr size_t WS_ZM = al256(WS_PROJ + (size_t)TA * INW * 2);
constexpr size_t WS_SELE = al256(WS_ZM + (size_t)TA * DM * 2);
constexpr size_t WS_SELW = al256(WS_SELE + (size_t)TA * 4 * 4);
constexpr size_t WS_RTOK = al256(WS_SELW + (size_t)TA * 4 * 4);
constexpr size_t WS_RW = al256(WS_RTOK + (size_t)MAXROWS * 4);
constexpr size_t WS_CNTW = al256(WS_RW + (size_t)MAXROWS * 4);
constexpr size_t WS_END = al256(WS_CNTW + (size_t)1024 * 32 * 4);
constexpr size_t WS_MST = WS_H;
static_assert((size_t)TA * INW >= (size_t)NEXP * 3 * DM * DM * 2, "experts fit under the gate bytes");
static_assert((size_t)256 * 128 * 512 * 4 <= (size_t)TA * DM * 2, "stash fits in H");
constexpr size_t WS_Y = WS_PROJ;
constexpr size_t WS_ACTS = WS_ZM;
static_assert((size_t)256 * 256 * DM * 2 <= (size_t)TA * DM * 2, "act tiles fit in ZM");

constexpr int CW_BAR = 1024;
constexpr int CW_GUDONE = 6144;
constexpr int CW_CTXM = 6336;
constexpr int CW_ROUTED = 6464;
constexpr int CW_CNT = 8192;

constexpr int LDS_BYTES = 147456;
constexpr int LDS_MISC = 131072 + 12288;

__device__ __forceinline__ unsigned cvt_pk_bf16(float lo, float hi) { unsigned r; asm volatile("v_cvt_pk_bf16_f32 %0, %1, %2" : "=v"(r) : "v"(lo), "v"(hi)); return r; }
__device__ __forceinline__ float bf_lo(unsigned w) { return __uint_as_float(w << 16); }
__device__ __forceinline__ float bf_hi(unsigned w) { return __uint_as_float(w & 0xffff0000u); }
__device__ __forceinline__ float bf2f(bf16_t b) { return __uint_as_float(((unsigned)b) << 16); }
__device__ __forceinline__ bf16_t f2bf(float f) { return (bf16_t)(cvt_pk_bf16(f, 0.f) & 0xffffu); }
template <int CTRL> __device__ __forceinline__ float dpp_f(float v) { return __int_as_float(__builtin_amdgcn_update_dpp(0, __float_as_int(v), CTRL, 0xF, 0xF, true)); }
template <int CTRL> __device__ __forceinline__ int dpp_i(int v) { return __builtin_amdgcn_update_dpp(0, v, CTRL, 0xF, 0xF, true); }
constexpr int DPP_X1 = 0xB1, DPP_X2 = 0x4E, DPP_HMIR = 0x141, DPP_MIR = 0x140;
__device__ __forceinline__ float row16_sum(float v) { v += dpp_f<DPP_X1>(v); v += dpp_f<DPP_X2>(v); v += dpp_f<DPP_HMIR>(v); v += dpp_f<DPP_MIR>(v); return v; }
__device__ __forceinline__ float half32_sum(float v) {
    v = row16_sum(v);
    const auto r = __builtin_amdgcn_permlane16_swap(__float_as_uint(v), __float_as_uint(v), false, false);
    return __uint_as_float(r[0]) + __uint_as_float(r[1]);
}
__device__ __forceinline__ float wave_sum(float v) {
    v = half32_sum(v);
    const auto r = __builtin_amdgcn_permlane32_swap(__float_as_uint(v), __float_as_uint(v), false, false);
    return __uint_as_float(r[0]) + __uint_as_float(r[1]);
}
__device__ __forceinline__ void ld8bf(const bf16_t* p, float (&v)[8]) {
    const u32x4 w = *(const u32x4*)p;
    v[0] = bf_lo(w.x); v[1] = bf_hi(w.x); v[2] = bf_lo(w.y); v[3] = bf_hi(w.y); v[4] = bf_lo(w.z); v[5] = bf_hi(w.z); v[6] = bf_lo(w.w); v[7] = bf_hi(w.w);
}
__device__ __forceinline__ void st8bf(bf16_t* p, const float (&v)[8]) {
    u32x4 w; w.x = cvt_pk_bf16(v[0], v[1]); w.y = cvt_pk_bf16(v[2], v[3]); w.z = cvt_pk_bf16(v[4], v[5]); w.w = cvt_pk_bf16(v[6], v[7]);
    *(u32x4*)p = w;
}

struct Params {
    const float* x; const float* c; const float* ctx; const float* c_ctx; const float* w_ada; const float* b_ada; const float* g_norm1;
    const float* w_in; const float* da_lambda; const float* g_subln; const float* w_conv; const float* w_pool; const float* pool_scale;
    const float* w_branch; const float* w_mgate; const float* b_mgate; const float* w_out; const float* g_norm2; const float* w_router; const float* b_router;
    const float* w_e_gate; const float* b_e_gate; const float* w_e_up; const float* b_e_up; const float* w_e_down; const float* b_e_down; const float* g_final;
    float* out; unsigned char* ws; int ph_lo, ph_hi;
};

#define XB_TMO      128
#define XB_XCNT(j)  (256  + 64 * (j))
#define XB_XSUB(j)  (1280 + 64 * (j))
#define XB_XGEN(j)  (2304 + 64 * (j))
#define XB_TOP      3328
#define XB_TOPGEN   3392
#define XCD_BAR_WORDS 3456
#define XB_SPIN_CAP (1u << 20)
__device__ __forceinline__ unsigned xb_ld(unsigned* p)              { return __hip_atomic_load(p, __ATOMIC_RELAXED, __HIP_MEMORY_SCOPE_AGENT); }
__device__ __forceinline__ unsigned xb_add(unsigned* p, unsigned v) { return __hip_atomic_fetch_add(p, v, __ATOMIC_RELAXED, __HIP_MEMORY_SCOPE_AGENT); }
__device__ __forceinline__ unsigned xb_xcc_id() { return (unsigned)__builtin_amdgcn_s_getreg((3 << 11) | 20) & 0xFu; }
#define XB_SPIN(cond, bar) do { unsigned _sp = 0; while (cond) { __builtin_amdgcn_s_sleep(1); \
    if ((++_sp & 255u) == 0u) { if (xb_ld(&(bar)[XB_TMO])) break; if (_sp > XB_SPIN_CAP) { atomicAdd(&(bar)[XB_TMO], 1u); break; } } } } while (0)
struct XcdBarrier { unsigned* bar; unsigned x; volatile LAS unsigned* st; };
__device__ __forceinline__ XcdBarrier xcd_barrier_post(unsigned* bar, volatile LAS unsigned* st) {
    XcdBarrier b; b.bar = bar; b.x = xb_xcc_id(); b.st = st;
    if (threadIdx.x == 0) (void)xb_add(&bar[XB_XCNT(b.x)], 1u);
    return b;
}
__device__ __forceinline__ void xcd_barrier_complete(unsigned* bar, unsigned x, unsigned& nloc, unsigned& nx) {
    const unsigned G = gridDim.x * gridDim.y * gridDim.z;
    unsigned sum, cnt, mine, sp = 0u;
    for (;;) {
        sum = 0u; cnt = 0u; mine = 0u;
#pragma unroll
        for (unsigned j = 0; j < 16; ++j) { const unsigned c = xb_ld(&bar[XB_XCNT(j)]); sum += c; cnt += (c > 0u) ? 1u : 0u; mine = (j == x) ? c : mine; }
        if (sum == G) break;
        __builtin_amdgcn_s_sleep(1);
        if ((++sp & 255u) == 0u) { if (xb_ld(&bar[XB_TMO])) break; if (sp > XB_SPIN_CAP) { atomicAdd(&bar[XB_TMO], 1u); break; } }
    }
    nloc = mine > 0u ? mine : 1u; nx = cnt > 0u ? cnt : 1u;
}
__device__ __forceinline__ void xcd_barrier(const XcdBarrier& b) {
    asm volatile("s_waitcnt vmcnt(0)" ::: "memory");
    __syncthreads();
    if (threadIdx.x == 0) {
        unsigned long long barw = (unsigned long long)b.bar;
        asm volatile("" : "+s"(barw));
        unsigned* bar = (unsigned*)(__attribute__((address_space(1))) unsigned*)barw;
        __builtin_amdgcn_s_waitcnt(0);
        unsigned nloc = b.st[0], nx = b.st[1];
        if (nloc == 0u) { xcd_barrier_complete(bar, b.x, nloc, nx); b.st[0] = nloc; b.st[1] = nx; }
        const unsigned old = xb_add(&bar[XB_XSUB(b.x)], 1u);
        const unsigned gen = old / nloc;
        if (old + 1u == (gen + 1u) * nloc) {
            __builtin_amdgcn_fence(__ATOMIC_RELEASE, "agent");
            asm volatile("s_waitcnt vmcnt(0)" ::: "memory");
            const unsigned og = xb_add(&bar[XB_TOP], 1u);
            const unsigned tg = og / nx;
            if (og + 1u == (tg + 1u) * nx) xb_add(&bar[XB_TOPGEN], 1u);
            else XB_SPIN(xb_ld(&bar[XB_TOPGEN]) == tg, bar);
            __builtin_amdgcn_fence(__ATOMIC_ACQUIRE, "agent");
            xb_add(&bar[XB_XGEN(b.x)], 1u);
            asm volatile("s_waitcnt vmcnt(0)" ::: "memory");
        } else {
            XB_SPIN(xb_ld(&bar[XB_XGEN(b.x)]) == gen, bar);
            __builtin_amdgcn_fence(__ATOMIC_ACQUIRE, "agent");
            asm volatile("s_waitcnt vmcnt(0)" ::: "memory");
        }
    }
    __syncthreads();
}

struct Frame {
    int tid, lane, wid, wg, nwg;
    LAS unsigned char* lds;
    unsigned char* ws;
    __device__ __forceinline__ unsigned* ctl() const { return (unsigned*)(ws + WS_CTL); }
    __device__ __forceinline__ float* mods() const { return (float*)(ws + WS_MODS); }
    __device__ __forceinline__ float* rope() const { return (float*)(ws + WS_ROPE); }
    __device__ __forceinline__ float* tw() const { return (float*)(ws + WS_TW); }
    __device__ __forceinline__ bf16_t* dft() const { return (bf16_t*)(ws + WS_DFT); }
    __device__ __forceinline__ float* lam() const { return (float*)(ws + WS_LAM); }
    __device__ __forceinline__ float* ctxb() const { return (float*)(ws + WS_CTXB); }
    __device__ __forceinline__ bf16_t* win() const { return (bf16_t*)(ws + WS_WIN); }
    __device__ __forceinline__ bf16_t* wgate() const { return (bf16_t*)(ws + WS_WGATE); }
    __device__ __forceinline__ bf16_t* wbr() const { return (bf16_t*)(ws + WS_WBR); }
    __device__ __forceinline__ bf16_t* wout() const { return (bf16_t*)(ws + WS_WOUT); }
    __device__ __forceinline__ bf16_t* gu() const { return (bf16_t*)(ws + WS_GU); }
    __device__ __forceinline__ bf16_t* dn() const { return (bf16_t*)(ws + WS_DN); }
    __device__ __forceinline__ bf16_t* H() const { return (bf16_t*)(ws + WS_H); }
    __device__ __forceinline__ bf16_t* proj() const { return (bf16_t*)(ws + WS_PROJ); }
    __device__ __forceinline__ bf16_t* zm() const { return (bf16_t*)(ws + WS_ZM); }
    __device__ __forceinline__ bf16_t* act() const { return (bf16_t*)(ws + WS_PROJ); }
    __device__ __forceinline__ int* sele() const { return (int*)(ws + WS_SELE); }
    __device__ __forceinline__ float* selw() const { return (float*)(ws + WS_SELW); }
    __device__ __forceinline__ int* rtok() const { return (int*)(ws + WS_RTOK); }
    __device__ __forceinline__ float* rw() const { return (float*)(ws + WS_RW); }
    __device__ __forceinline__ bf16_t* dft256() const { return (bf16_t*)(ws + WS_DFT256); }
    __device__ __forceinline__ int* cntw() const { return (int*)(ws + WS_CNTW); }
    __device__ __forceinline__ bf16_t* Y() const { return (bf16_t*)(ws + WS_Y); }
    __device__ __forceinline__ bf16_t* acts() const { return (bf16_t*)(ws + WS_ACTS); }
    __device__ __forceinline__ bf16_t* acts2() const { return (bf16_t*)(ws + WS_ACT2); }
    __device__ __forceinline__ unsigned char* g8() const { return ws + WS_G8; }
    __device__ __forceinline__ float* mst() const { return (float*)(ws + WS_MST) + (size_t)wg * 128 * NTHR; }
};

__device__ __forceinline__ int qk_rowmap(int n) {
    if (n >= 1024) return n;
    const int g = n & ~31, d = n & 31;
    const int p = d < 16 ? 8 * (d >> 2) + (d & 3) : 8 * ((d - 16) >> 2) + 4 + (d & 3);
    return g + p;
}
__device__ __forceinline__ int gu_rowmap(int c, int up) { return 32 * (c >> 4) + 8 * ((c & 15) >> 2) + (c & 3) + 4 * up; }

template <int MODE>
__device__ __forceinline__ void cvt_tile(const Frame& F, const float* __restrict__ src, int src_ld, int k0, int n0, bf16_t* __restrict__ dst, int dst_ld, int dst_k0) {
    LAS float* tile = (LAS float*)F.lds;
#pragma unroll
    for (int q = 0; q < 2; ++q) {
        const int idx = F.tid + q * NTHR, r = idx >> 4, c4 = idx & 15;
        const f32x4 v = *(const f32x4*)(src + (size_t)(k0 + r) * src_ld + n0 + c4 * 4);
        tile[r * 65 + c4 * 4 + 0] = v[0]; tile[r * 65 + c4 * 4 + 1] = v[1]; tile[r * 65 + c4 * 4 + 2] = v[2]; tile[r * 65 + c4 * 4 + 3] = v[3];
    }
    __syncthreads();
    {
        const int n = F.tid >> 3, kc = F.tid & 7;
        float v[8];
#pragma unroll
        for (int j = 0; j < 8; ++j) v[j] = tile[(kc * 8 + j) * 65 + n];
        int row = n0 + n;
        if (MODE == 1) row = qk_rowmap(row);
        if (MODE == 2) row = gu_rowmap(row, 0);
        if (MODE == 3) row = gu_rowmap(row, 1);
        st8bf(dst + (size_t)row * dst_ld + dst_k0 + k0 + kc * 8, v);
    }
    __syncthreads();
}

__device__ __forceinline__ void p0_mods(const Frame& F, const Params& P, int item) {
    LAS float* sl = (LAS float*)F.lds;
    LAS float* red = sl + 9 * 1024;
    for (int i = F.tid; i < 9 * 1024; i += NTHR) {
        const int r = i >> 10, d = i & 1023;
        const float v = (r < 8) ? P.c[r * 1024 + d] : P.c_ctx[d];
        sl[i] = v / (1.f + __expf(-v));
    }
    __syncthreads();
    const int col0 = item * 128, l = col0 / 6144, j0 = col0 % 6144;
    const int cq = F.tid & 31, ds = F.tid >> 5;
    f32x4 acc[9];
#pragma unroll
    for (int r = 0; r < 9; ++r) acc[r] = (f32x4){0.f, 0.f, 0.f, 0.f};
    const float* w = P.w_ada + (size_t)l * 1024 * 6144 + j0 + cq * 4;
#pragma unroll 16
    for (int i = 0; i < 64; ++i) {
        const int d = ds * 64 + i;
        const f32x4 wv = *(const f32x4*)(w + (size_t)d * 6144);
#pragma unroll
        for (int r = 0; r < 9; ++r) acc[r] += wv * sl[r * 1024 + d];
    }
#pragma unroll
    for (int r = 0; r < 9; ++r) {
#pragma unroll
        for (int q = 0; q < 4; ++q) red[(ds * 9 + r) * 128 + cq * 4 + q] = acc[r][q];
    }
    __syncthreads();
    for (int i = F.tid; i < 9 * 128; i += NTHR) {
        const int r = i >> 7, c = i & 127;
        float s = 0.f;
#pragma unroll
        for (int k = 0; k < 16; ++k) s += red[(k * 9 + r) * 128 + c];
        F.mods()[(size_t)(l * 9 + r) * 6144 + j0 + c] = s + P.b_ada[l * 6144 + j0 + c];
    }
    __syncthreads();
}

__device__ __forceinline__ void p0_fold(const Frame& F, const Params& P, int item) {
    const int l = item / 192, rem = item % 192, which = rem / 64, c8 = rem % 64;
    const int cbase = c8 * 8, g = cbase >> 7, cl = cbase & 127;
    LAS float* coef = (LAS float*)F.lds;
    for (int i = F.tid; i < 1024; i += NTHR) {
        const int cp = i >> 3, j = i & 7, c = cl + j;
        float v;
        if (which == 2) v = P.w_pool[((size_t)(l * 4 + g) * 128 + c) * 128 + cp] * P.pool_scale[l * 512 + g * 128 + cp];
        else { float sn, cs; sincospif(2.f * (float)((c * cp) & 127) / 128.f, &sn, &cs); v = (which == 0 ? cs : -sn) * 0.08838834764831845f; }
        coef[i] = v;
    }
    __syncthreads();
    const float* wb = P.w_branch + ((size_t)(l * 4 + (which == 2 ? 3 : 2)) * 512 + g * 128) * 1024;
    const int kofs = (which == 0 ? 1024 : which == 1 ? 1536 : 2048) + cbase;
    {
        float acc0[8], acc1[8];
#pragma unroll
        for (int j = 0; j < 8; ++j) { acc0[j] = 0.f; acc1[j] = 0.f; }
#pragma unroll 1
        for (int cp0 = 0; cp0 < 128; cp0 += 16) {
            float w0[16], w1[16];
#pragma unroll
            for (int q = 0; q < 16; ++q) { w0[q] = wb[(size_t)(cp0 + q) * 1024 + F.tid]; w1[q] = wb[(size_t)(cp0 + q) * 1024 + F.tid + NTHR]; }
#pragma unroll
            for (int q = 0; q < 16; ++q)
#pragma unroll
                for (int j = 0; j < 8; ++j) { const float cf = coef[(cp0 + q) * 8 + j]; acc0[j] += cf * w0[q]; acc1[j] += cf * w1[q]; }
        }
        st8bf(F.wbr() + ((size_t)l * 1024 + F.tid) * WBR_K + kofs, acc0);
        st8bf(F.wbr() + ((size_t)l * 1024 + F.tid + NTHR) * WBR_K + kofs, acc1);
    }
    __syncthreads();
}

__device__ __forceinline__ void p0_tables(const Frame& F, const Params& P, int item) {
    const int idx = item * NTHR + F.tid;
    if (idx < 2048) {
        const int pos = idx >> 4, i = idx & 15;
        const float inv = powf(10000.f, -(float)(2 * i) / 32.f);
        const float ang = (float)pos * inv;
        F.rope()[idx] = cosf(ang); F.rope()[2048 + idx] = sinf(ang);
    }
    if (idx < 8192) {
        const int k1 = idx >> 6, n2 = idx & 63;
        float sn, cs; sincospif(2.f * (float)(k1 * n2) / 8192.f, &sn, &cs);
        F.tw()[idx * 2] = cs; F.tw()[idx * 2 + 1] = sn;
    }
    if (idx < 16384) {
        const int k = idx >> 7, n = idx & 127;
        float sn, cs; sincospif(2.f * (float)((k * n) & 127) / 128.f, &sn, &cs);
        F.dft()[idx] = f2bf(cs); F.dft()[16384 + idx] = f2bf(sn);
    }
    if (idx < 4096) {
        const int k = idx >> 6, n = idx & 63;
        float sn, cs; sincospif(2.f * (float)((k * n) & 63) / 64.f, &sn, &cs);
        F.dft()[32768 + idx] = f2bf(cs); F.dft()[32768 + 4096 + idx] = f2bf(sn); F.dft()[32768 + 8192 + idx] = f2bf(-sn);
    }
    if (idx < 2) {
        const float* lm = P.da_lambda + idx * 256;
        float s1 = 0.f, s2 = 0.f;
        for (int i = 0; i < 64; ++i) { s1 += lm[i] * lm[64 + i]; s2 += lm[128 + i] * lm[192 + i]; }
        const float lam_init = 0.8f - 0.6f * expf(-0.3f * (float)idx);
        F.lam()[idx] = expf(s1) - expf(s2) + lam_init;
    }
}

__device__ __forceinline__ void p0_prologue(const Frame& F, const Params& P) {
    for (int it = F.wg; it < 96 + 384 + 64; it += F.nwg) {
        if (it < 96) p0_mods(F, P, it);
        else if (it < 480) { const int f = it - 96; p0_fold(F, P, (f & 7) * 48 + (f >> 3)); }
        else p0_tables(F, P, it - 480);
    }
    for (int idx = F.wg * NTHR + F.tid; idx < 65536; idx += F.nwg * NTHR) {
        const int k = idx >> 8, n = idx & 255;
        float sn, cs; sincospif(2.f * (float)((k * n) & 255) / 256.f, &sn, &cs);
        F.dft256()[idx] = f2bf(cs); F.dft256()[65536 + idx] = f2bf(sn);
    }
    for (size_t i = (size_t)F.wg * NTHR + F.tid; i < (size_t)TC * DM / 4; i += (size_t)F.nwg * NTHR) ((f32x4*)F.ctxb())[i] = ((const f32x4*)P.ctx)[i];
    {
        constexpr int NWS = 2 * 640, TP = 257;
#define WS_DESC(it, src, sld, k0, n0) do { const int _l = (it) / 640; int _r = (it) % 640; \
            if (_r < 256) { src = P.w_in + (size_t)_l * DM * INW; sld = INW; k0 = (_r >> 4) * 64; n0 = (_r & 15) * 256; } \
            else if (_r < 512) { _r -= 256; src = P.w_mgate + (size_t)_l * DM * INW; sld = INW; k0 = (_r >> 4) * 64; n0 = (_r & 15) * 256; } \
            else if (_r < 576) { _r -= 512; src = P.w_out + (size_t)_l * DM * DM; sld = DM; k0 = (_r >> 2) * 64; n0 = (_r & 3) * 256; } \
            else { _r -= 576; const int _k = _r >> 5; _r &= 31; src = P.w_branch + (size_t)(_l * 4 + _k) * 512 * 1024; sld = 1024; k0 = (_r >> 2) * 64; n0 = (_r & 3) * 256; } } while (0)
#define WS_LOAD(it) do { const float* _s; int _sld, _k0, _n0; WS_DESC(it, _s, _sld, _k0, _n0); \
            _Pragma("unroll") for (int _q = 0; _q < 8; ++_q) { const int _i = F.tid + _q * NTHR; wv[_q] = *(const f32x4*)(_s + (size_t)(_k0 + (_i >> 6)) * _sld + _n0 + (_i & 63) * 4); } } while (0)
        LAS float* tile = (LAS float*)F.lds;
        f32x4 wv[8];
        int it = F.wg, par = 0;
        if (it < NWS) WS_LOAD(it);
        for (; it < NWS; it += F.nwg, par ^= 1) {
            LAS float* tl = tile + par * (64 * TP);
#pragma unroll
            for (int q = 0; q < 8; ++q) { const int i = F.tid + q * NTHR, r = i >> 6, c = (i & 63) * 4; tl[r * TP + c] = wv[q][0]; tl[r * TP + c + 1] = wv[q][1]; tl[r * TP + c + 2] = wv[q][2]; tl[r * TP + c + 3] = wv[q][3]; }
            __syncthreads();
            if (it + F.nwg < NWS) WS_LOAD(it + F.nwg);
            const int l = it / 640; int r = it % 640;
            bf16_t* dst; int dld, k0, n0, kofs = 0; bool qk = false;
            if (r < 256) { dst = F.win() + (size_t)l * INW * DM; dld = DM; k0 = (r >> 4) * 64; n0 = (r & 15) * 256; qk = true; }
            else if (r < 512) { r -= 256; dst = F.wgate() + (size_t)l * INW * DM; dld = DM; k0 = (r >> 4) * 64; n0 = (r & 15) * 256; }
            else if (r < 576) { r -= 512; dst = F.wout() + (size_t)l * DM * DM; dld = DM; k0 = (r >> 2) * 64; n0 = (r & 3) * 256; }
            else { r -= 576; const int k = r >> 5; r &= 31; dst = F.wbr() + (size_t)l * 1024 * WBR_K; dld = WBR_K; k0 = (r >> 2) * 64; n0 = (r & 3) * 256; kofs = k * 512; }
#pragma unroll
            for (int q = 0; q < 4; ++q) {
                const int p = F.tid + q * NTHR, n = p >> 3, kc = p & 7;
                float o[8];
#pragma unroll
                for (int j = 0; j < 8; ++j) o[j] = tl[(kc * 8 + j) * TP + n];
                const int row = qk ? qk_rowmap(n0 + n) : (n0 + n);
                st8bf(dst + (size_t)row * dld + kofs + k0 + kc * 8, o);
            }
        }
        __syncthreads();
#undef WS_DESC
#undef WS_LOAD
    }
}

__device__ __forceinline__ void cvt_experts(const Frame& F, const Params& P, int l) {
    constexpr int NS = NEXP * 3 * 64, TP = 257;
    LAS float* tile = (LAS float*)F.lds;
    f32x4 v[8];
#define CE_SRC(s, base, k0, n0) do { const int _e = (s) / 192, _r = (s) % 192, _w = _r >> 6, _t = _r & 63; k0 = (_t >> 2) * 64; n0 = (_t & 3) * 256; \
        base = (_w == 0 ? P.w_e_gate : _w == 1 ? P.w_e_up : P.w_e_down) + ((size_t)l * NEXP + _e) * DM * DM; } while (0)
#define CE_LOAD(s) do { const float* _b; int _k0, _n0; CE_SRC(s, _b, _k0, _n0); \
        _Pragma("unroll") for (int _q = 0; _q < 8; ++_q) { const int _i = F.tid + _q * NTHR; v[_q] = *(const f32x4*)(_b + (size_t)(_k0 + (_i >> 6)) * DM + _n0 + (_i & 63) * 4); } } while (0)
    int s = F.wg, par = 0;
    if (s < NS) CE_LOAD(s);
    for (; s < NS; s += F.nwg, par ^= 1) {
        LAS float* tl = tile + par * (64 * TP);
#pragma unroll
        for (int q = 0; q < 8; ++q) { const int i = F.tid + q * NTHR, r = i >> 6, c = (i & 63) * 4; tl[r * TP + c] = v[q][0]; tl[r * TP + c + 1] = v[q][1]; tl[r * TP + c + 2] = v[q][2]; tl[r * TP + c + 3] = v[q][3]; }
        __syncthreads();
        if (s + F.nwg < NS) CE_LOAD(s + F.nwg);
        const int e = s / 192, r = s % 192, w = r >> 6, t = r & 63, k0 = (t >> 2) * 64, n0 = (t & 3) * 256;
        bf16_t* dst = (w == 2) ? F.dn() + (size_t)e * DM * DM : F.gu() + (size_t)e * 2048 * DM;
#pragma unroll
        for (int q = 0; q < 4; ++q) {
            const int p = F.tid + q * NTHR, n = p >> 3, kc = p & 7;
            float o[8];
#pragma unroll
            for (int j = 0; j < 8; ++j) o[j] = tl[(kc * 8 + j) * TP + n];
            const int row = (w == 2) ? (n0 + n) : gu_rowmap(n0 + n, w);
            st8bf(dst + (size_t)row * DM + k0 + kc * 8, o);
        }
    }
#undef CE_SRC
#undef CE_LOAD
    __syncthreads();
}

__device__ __forceinline__ const float* xrow_ptr(const float* xs, long long dctx, int row) { return xs + (size_t)row * DM + (row >= TL ? dctx : 0ll); }
__device__ __forceinline__ void phase_norm1(const Frame& F, const Params& P, int l, const float* xs, long long dctx, bool combine, float* xw, long long dctxw) {
    const float* g = P.g_norm1 + l * DM;
    for (int row = F.wg * 8 + F.wid; row < TA; row += F.nwg * 8) {
        const float* xr = xrow_ptr(xs, dctx, row);
        const int b = row < TL ? (row >> 13) : 8;
        const float* md = F.mods() + (size_t)(l * 9 + b) * 6144;
        f32x4 v[4]; float ss = 0.f;
#pragma unroll
        for (int j = 0; j < 4; ++j) v[j] = *(const f32x4*)(xr + F.lane * 4 + 256 * j);
        if (combine) {
            const float* g5 = F.mods() + (size_t)((l - 1) * 9 + b) * 6144 + 5 * 1024;
            const bf16_t* yr = F.Y() + (size_t)row * 4 * DM;
            float* xo = xw + (size_t)row * DM + (row >= TL ? dctxw : 0ll);
#pragma unroll
            for (int j = 0; j < 4; ++j) {
                const int col = F.lane * 4 + 256 * j;
                f32x4 s = (f32x4){0.f, 0.f, 0.f, 0.f};
#pragma unroll
                for (int k = 0; k < 4; ++k) { const u32x2 w = __builtin_nontemporal_load((const u32x2*)(yr + (size_t)k * DM + col));     s[0] += bf_lo(w.x); s[1] += bf_hi(w.x); s[2] += bf_lo(w.y); s[3] += bf_hi(w.y); }
                v[j] += *(const f32x4*)(g5 + col) * s;
                *(f32x4*)(xo + col) = v[j];
            }
        }
#pragma unroll
        for (int j = 0; j < 4; ++j) ss += v[j][0] * v[j][0] + v[j][1] * v[j][1] + v[j][2] * v[j][2] + v[j][3] * v[j][3];
        ss = wave_sum(ss);
        const float rstd = rsqrtf(ss * (1.f / 1024.f) + EPS);
#pragma unroll
        for (int j = 0; j < 4; ++j) {
            const int col = F.lane * 4 + 256 * j;
            const f32x4 gg = *(const f32x4*)(g + col), sh = *(const f32x4*)(md + col), sc = *(const f32x4*)(md + 1024 + col);
            float o[4];
#pragma unroll
            for (int i = 0; i < 4; ++i) o[i] = v[j][i] * rstd * gg[i] * (1.f + sc[i]) + sh[i];
            u32x2 w; w.x = cvt_pk_bf16(o[0], o[1]); w.y = cvt_pk_bf16(o[2], o[3]);
            *(u32x2*)(F.H() + (size_t)row * DM + col) = w;
        }
    }
}

__device__ __forceinline__ void phase_final(const Frame& F, const Params& P) {
    for (int row = F.wg * 8 + F.wid; row < TL; row += F.nwg * 8) {
        float* xr = P.out + (size_t)row * DM;
        const float* g5 = F.mods() + (size_t)((NLAYER - 1) * 9 + (row >> 13)) * 6144 + 5 * 1024;
        const bf16_t* yr = F.Y() + (size_t)row * 4 * DM;
        f32x4 v[4]; float ss = 0.f;
#pragma unroll
        for (int j = 0; j < 4; ++j) {
            const int col = F.lane * 4 + 256 * j;
            v[j] = *(const f32x4*)(xr + col);
            f32x4 s = (f32x4){0.f, 0.f, 0.f, 0.f};
#pragma unroll
            for (int k = 0; k < 4; ++k) { const u32x2 w = __builtin_nontemporal_load((const u32x2*)(yr + (size_t)k * DM + col));     s[0] += bf_lo(w.x); s[1] += bf_hi(w.x); s[2] += bf_lo(w.y); s[3] += bf_hi(w.y); }
            v[j] += *(const f32x4*)(g5 + col) * s;
            ss += v[j][0] * v[j][0] + v[j][1] * v[j][1] + v[j][2] * v[j][2] + v[j][3] * v[j][3];
        }
        ss = wave_sum(ss);
        const float rstd = rsqrtf(ss * (1.f / 1024.f) + EPS);
#pragma unroll
        for (int j = 0; j < 4; ++j) {
            const int col = F.lane * 4 + 256 * j;
            const f32x4 gg = *(const f32x4*)(P.g_final + col);
            f32x4 o;
#pragma unroll
            for (int i = 0; i < 4; ++i) o[i] = v[j][i] * rstd * gg[i];
            *(f32x4*)(xr + col) = o;
        }
    }
}

__device__ __forceinline__ void seq_of(int row, int& s, int& n) { if (row < TL) { s = row & (SEQ - 1); n = SEQ; } else { s = (row - TL) & (CTXL - 1); n = CTXL; } }

__device__ __forceinline__ void phase_conv(const Frame& F, const Params& P, int l, int nrows) {
    const float* wc = P.w_conv + l * 3 * 512;
    for (size_t idx = (size_t)F.wg * NTHR + F.tid; idx < (size_t)(nrows / 4) * 64; idx += (size_t)F.nwg * NTHR) {
        const int row0 = (int)(idx >> 6) * 4, ch = (int)(idx & 63) * 8;
        int s0, n; seq_of(row0, s0, n);
        const char* pb = (const char*)F.proj();
        const unsigned off0 = (unsigned)(row0 * INW + ch) * 2u;
        u32x4 rx[6], rc[6], rb[4];
#pragma unroll
        for (int i = 0; i < 6; ++i) {
            const int s = s0 - 1 + i; const bool ok = s >= 0 && s < n; const unsigned o = off0 + (ok ? (unsigned)((i - 1) * INW * 2) : 0u);
            rx[i] = *(const u32x4*)(pb + (size_t)(o + C_SX * 2)); rc[i] = *(const u32x4*)(pb + (size_t)(o + C_SC * 2));
        }
#pragma unroll
        for (int i = 0; i < 4; ++i) rb[i] = *(const u32x4*)(pb + (size_t)(off0 + (unsigned)(i * INW * 2 + C_SB * 2)));
        bf16_t* base = F.proj() + (size_t)row0 * INW;
        float w0[8], w1[8], w2[8];
#pragma unroll
        for (int j = 0; j < 8; ++j) { w0[j] = wc[ch + j]; w1[j] = wc[512 + ch + j]; w2[j] = wc[1024 + ch + j]; }
        float u[6][8];
#pragma unroll
        for (int i = 0; i < 6; ++i) {
            const int s = s0 - 1 + i; const float z = (s >= 0 && s < n) ? 1.f : 0.f;
            u[i][0] = bf_lo(rx[i].x) * bf_lo(rc[i].x) * z; u[i][1] = bf_hi(rx[i].x) * bf_hi(rc[i].x) * z; u[i][2] = bf_lo(rx[i].y) * bf_lo(rc[i].y) * z; u[i][3] = bf_hi(rx[i].y) * bf_hi(rc[i].y) * z;
            u[i][4] = bf_lo(rx[i].z) * bf_lo(rc[i].z) * z; u[i][5] = bf_hi(rx[i].z) * bf_hi(rc[i].z) * z; u[i][6] = bf_lo(rx[i].w) * bf_lo(rc[i].w) * z; u[i][7] = bf_hi(rx[i].w) * bf_hi(rc[i].w) * z;
        }
#pragma unroll
        for (int i = 0; i < 4; ++i) {
            float bb[8], y[8];
            bb[0] = bf_lo(rb[i].x); bb[1] = bf_hi(rb[i].x); bb[2] = bf_lo(rb[i].y); bb[3] = bf_hi(rb[i].y); bb[4] = bf_lo(rb[i].z); bb[5] = bf_hi(rb[i].z); bb[6] = bf_lo(rb[i].w); bb[7] = bf_hi(rb[i].w);
#pragma unroll
            for (int j = 0; j < 8; ++j) y[j] = bb[j] * (w0[j] * u[i][j] + w1[j] * u[i + 1][j] + w2[j] * u[i + 2][j]);
            st8bf(base + (ptrdiff_t)i * INW + C_SB + ch, y);
        }
    }
}

template <int HW>
__device__ __forceinline__ void pool_group(const Frame& F, int nrows, int g, size_t idx) {
    constexpr int NR = 8 + 2 * HW - 1;
    {
        const int row0 = (int)(idx >> 4) * 8, ch = g * 128 + (int)(idx & 15) * 8;
        int s0, n; seq_of(row0, s0, n);
        const char* pb = (const char*)F.proj();
        const unsigned off0 = (unsigned)(row0 * INW + C_PX + ch) * 2u;
        u32x4 rx[NR];
#pragma unroll
        for (int i = 0; i < NR; ++i) {
            const int s = s0 - HW + i; const bool ok = s >= 0 && s < n;
            rx[i] = *(const u32x4*)(pb + (size_t)(off0 + (ok ? (unsigned)((i - HW) * INW * 2) : 0u)));
            if (!ok) rx[i] = (u32x4){0u, 0u, 0u, 0u};
        }
        float w[8];
#pragma unroll
        for (int j = 0; j < 8; ++j) w[j] = 0.f;
#pragma unroll
        for (int i = 0; i < 2 * HW; ++i) { w[0] += bf_lo(rx[i].x); w[1] += bf_hi(rx[i].x); w[2] += bf_lo(rx[i].y); w[3] += bf_hi(rx[i].y); w[4] += bf_lo(rx[i].z); w[5] += bf_hi(rx[i].z); w[6] += bf_lo(rx[i].w); w[7] += bf_hi(rx[i].w); }
#pragma unroll
        for (int t = 0; t < 8; ++t) {
            const int s = s0 + t, lo = max(s - HW, 0), hi = min(s + HW, n);
            const float ic = 1.f / (float)(hi - lo);
            u32x4 xc = rx[t + HW];
            asm volatile("" : "+v"(xc));
            float y[8];
            y[0] = w[0] * ic - bf_lo(xc.x); y[1] = w[1] * ic - bf_hi(xc.x); y[2] = w[2] * ic - bf_lo(xc.y); y[3] = w[3] * ic - bf_hi(xc.y);
            y[4] = w[4] * ic - bf_lo(xc.z); y[5] = w[5] * ic - bf_hi(xc.z); y[6] = w[6] * ic - bf_lo(xc.w); y[7] = w[7] * ic - bf_hi(xc.w);
            st8bf(F.proj() + (size_t)(row0 + t) * INW + C_FX + ch, y);
            if (t < 7) {
                u32x4 a = rx[t + 2 * HW], d = rx[t];
                asm volatile("" : "+v"(a), "+v"(d));
                w[0] += bf_lo(a.x) - bf_lo(d.x); w[1] += bf_hi(a.x) - bf_hi(d.x); w[2] += bf_lo(a.y) - bf_lo(d.y); w[3] += bf_hi(a.y) - bf_hi(d.y);
                w[4] += bf_lo(a.z) - bf_lo(d.z); w[5] += bf_hi(a.z) - bf_hi(d.z); w[6] += bf_lo(a.w) - bf_lo(d.w); w[7] += bf_hi(a.w) - bf_hi(d.w);
            }
        }
    }
}
__device__ __forceinline__ void phase_pool(const Frame& F, int nrows) {
    const size_t nit = (size_t)(nrows / 8) * 16 / 64;
    int it = 0;
    for (size_t base = (size_t)F.wg * 2 + (F.wid >> 2); base < nit; base += (size_t)F.nwg * 2, ++it) {
        const int g = __builtin_amdgcn_readfirstlane((F.wid + it) & 3);
        const size_t idx = base * 64 + F.lane;
        if (g == 0) pool_group<1>(F, nrows, 0, idx); else if (g == 1) pool_group<2>(F, nrows, 1, idx); else if (g == 2) pool_group<4>(F, nrows, 2, idx); else pool_group<8>(F, nrows, 3, idx);
    }
}

__device__ __forceinline__ void phase_ctx_dft_copy(const Frame& F) {
    for (size_t idx = (size_t)F.wg * NTHR + F.tid; idx < (size_t)TC * 128; idx += (size_t)F.nwg * NTHR) {
        const int r = (int)(idx >> 7), c = (int)(idx & 127) * 8;
        *(u32x4*)(F.proj() + (size_t)(TL + r) * INW + C_K + c) = *(const u32x4*)(F.zm() + (size_t)(TL + r) * DM + c);
    }
}

namespace gm {
constexpr int BM = 256, BK = 64, HALF = 128, HTB = HALF * BK * 2, STAGE_BYTES = 8 * HTB;
__device__ __forceinline__ int lds_byte(int r, int c) { const int st = (r >> 4) * 2 + (c >> 5), rr = r & 15, cc = c & 31, ob = rr * 64 + cc * 2; return st * 1024 + (ob ^ (((ob >> 9) & 1) << 5)); }
__device__ __forceinline__ void stage_rc(int b, int& R, int& C) { const int st = b / 1024, sb = b % 1024, swz = sb ^ (((sb >> 9) & 1) << 5); R = (st >> 1) * 16 + swz / 64; C = (st & 1) * 32 + (swz % 64) / 2; }
__device__ __forceinline__ int perm32(int rho) { const int n = rho >> 4, i = rho & 15; return 8 * (i >> 2) + 4 * n + (i & 3); }

struct GUnit {
    const char* A;
    const char* B;
    const int* gidx;
    unsigned lda, ldb;
    int nt;
    int pm, pn, sub, e;
    unsigned aux;
};

template <bool PERM, class Epi, class Sched>
__device__ __forceinline__ void gemm_phase(LAS unsigned char* lds, const Sched& S, const Epi& E) {
    int tid = threadIdx.x; asm volatile("" : "+v"(tid));
    const int wid = __builtin_amdgcn_readfirstlane(tid >> 6), lane = tid & 63, wr = wid >> 2, wc = wid & 3, fr = lane & 15, fq = lane >> 4;
    const unsigned ldsw = (unsigned)wid * 1024u;
    const int aoff = lds_byte(wr * 64 + fr, fq * 8), boff = lds_byte(wc * 32 + fr, fq * 8);
    const size_t kstep = (size_t)(BK * 2);
#define G_SA(b, h) (((b) * 2 + (h)) * gm::HTB)
#define G_SB(b, h) ((4 + (b) * 2 + (h)) * gm::HTB)
#define G_STAGE2(bufoff, gbase, v0, v1) do { \
        __builtin_amdgcn_global_load_lds((const unsigned*)((const char*)(gbase) + (v0)), (LAS unsigned*)(lds + (bufoff) + ldsw), 16, 0, 0); \
        __builtin_amdgcn_global_load_lds((const unsigned*)((const char*)(gbase) + (v1)), (LAS unsigned*)(lds + (bufoff) + ldsw + 8192), 16, 0, 0); } while (0)
#define G_LDA(dst, b, h) do { _Pragma("unroll") for (int m = 0; m < 4; ++m) _Pragma("unroll") for (int k = 0; k < 2; ++k) dst[m][k] = *(const LAS bf16x8*)(lds + G_SA(b, h) + aoff + m * 2048 + k * 1024); } while (0)
#define G_LDB(dst, b, h) do { _Pragma("unroll") for (int n = 0; n < 2; ++n) _Pragma("unroll") for (int k = 0; k < 2; ++k) dst[n][k] = *(const LAS bf16x8*)(lds + G_SB(b, h) + boff + n * 2048 + k * 1024); } while (0)
#define G_MMA(ai, bj, At, Bt) do { __builtin_amdgcn_s_setprio(1); _Pragma("unroll") for (int m = 0; m < 4; ++m) _Pragma("unroll") for (int n = 0; n < 2; ++n) _Pragma("unroll") for (int k = 0; k < 2; ++k) \
        acc[ai][bj][m][n] = __builtin_amdgcn_mfma_f32_16x16x32_bf16(Bt[n][k], At[m][k], acc[ai][bj][m][n], 0, 0, 0); __builtin_amdgcn_s_setprio(0); } while (0)
#define G_WAIT_V(n) asm volatile("s_waitcnt vmcnt(" #n ")" ::: "memory")
#define G_WAIT_L(n) asm volatile("s_waitcnt lgkmcnt(" #n ")" ::: "memory")
#define G_BAR __builtin_amdgcn_s_barrier()
#define G_SCHED __builtin_amdgcn_sched_barrier(0)
#define G_OFFS(u, va00, va01, va10, va11, vb0, vb1, hsB) do { \
        int _t = threadIdx.x; asm volatile("" : "+v"(_t));     \
        int R0, C0, R1, C1; gm::stage_rc(_t * 16, R0, C0); gm::stage_rc(_t * 16 + 8192, R1, C1); \
        const int Rb0 = PERM ? ((R0 & ~31) + gm::perm32(R0 & 31)) : R0, Rb1 = PERM ? ((R1 & ~31) + gm::perm32(R1 & 31)) : R1; \
        unsigned _lda = (u).lda, _ldb = (u).ldb; if (Sched::VAR_STRIDE) asm volatile("" : "+s"(_lda), "+s"(_ldb));     \
        int r00 = R0, r01 = R1, r10 = 128 + R0, r11 = 128 + R1; \
        if ((u).gidx) { r00 = (u).gidx[R0]; r01 = (u).gidx[R1]; r10 = (u).gidx[128 + R0]; r11 = (u).gidx[128 + R1]; r00 = r00 < 0 ? 0 : (r00 >> 2); r01 = r01 < 0 ? 0 : (r01 >> 2); r10 = r10 < 0 ? 0 : (r10 >> 2); r11 = r11 < 0 ? 0 : (r11 >> 2); }     \
        va00 = (unsigned)r00 * _lda + (unsigned)C0 * 2u; va01 = (unsigned)r01 * _lda + (unsigned)C1 * 2u; \
        va10 = (unsigned)r10 * _lda + (unsigned)C0 * 2u; va11 = (unsigned)r11 * _lda + (unsigned)C1 * 2u; \
        vb0 = (unsigned)Rb0 * _ldb + (unsigned)C0 * 2u; vb1 = (unsigned)Rb1 * _ldb + (unsigned)C1 * 2u; hsB = (size_t)128 * _ldb; } while (0)
    GUnit cur, nxt; int ui = 0;
    if (!S.next(0, cur)) return;
#ifndef GEMM_SKEW_TICKS
#define GEMM_SKEW_TICKS 0
#endif
    if (GEMM_SKEW_TICKS > 0 && Sched::SKEW) {
        const unsigned long long t0 = __builtin_amdgcn_s_memrealtime(), w = (unsigned long long)(blockIdx.x & 7u) * (GEMM_SKEW_TICKS);
        while (__builtin_amdgcn_s_memrealtime() - t0 < w) __builtin_amdgcn_s_sleep(8);
    }
    f32x4 acc[2][2][4][2];
#pragma unroll
    for (int a = 0; a < 2; ++a)
#pragma unroll
        for (int b = 0; b < 2; ++b)
#pragma unroll
            for (int m = 0; m < 4; ++m)
#pragma unroll
                for (int n = 0; n < 2; ++n) acc[a][b][m][n] = (f32x4){0.f, 0.f, 0.f, 0.f};
    bf16x8 At[4][2], B0[2][2], B1[2][2];
    unsigned va00, va01, va10, va11, vb0, vb1; size_t hsB;
    unsigned na00, na01, na10, na11, nb0, nb1; size_t nhsB;
    G_OFFS(cur, va00, va01, va10, va11, vb0, vb1, hsB);
    const char* cA = cur.A; const char* cB = cur.B;
    G_STAGE2(G_SB(0, 0), cB, vb0, vb1); G_STAGE2(G_SA(0, 0), cA, va00, va01); G_STAGE2(G_SB(0, 1), cB + hsB, vb0, vb1); G_STAGE2(G_SA(0, 1), cA, va10, va11);
    if (wr == 1) G_BAR;
    G_WAIT_V(4); G_BAR;
    G_STAGE2(G_SB(1, 0), cB + kstep, vb0, vb1); G_STAGE2(G_SA(1, 0), cA + kstep, va00, va01); G_STAGE2(G_SB(1, 1), cB + hsB + kstep, vb0, vb1);
    G_WAIT_V(6); G_BAR;
    for (;;) {
        const bool has_next = S.next(ui + 1, nxt);
        const char* nA = cA; const char* nB = cB;
        if (has_next) { nA = nxt.A; nB = nxt.B; }
        if (Sched::GATHER_A) {
            na00 = va00; na01 = va01; na10 = va10; na11 = va11; nb0 = vb0; nb1 = vb1; nhsB = hsB;
            if (has_next) {
                if (nxt.gidx != nullptr && nxt.gidx == cur.gidx) {
                    unsigned t0, t1, t2, t3; gm::GUnit ub = nxt; ub.gidx = nullptr; G_OFFS(ub, t0, t1, t2, t3, nb0, nb1, nhsB); (void)t0; (void)t1; (void)t2; (void)t3;
                } else G_OFFS(nxt, na00, na01, na10, na11, nb0, nb1, nhsB);
            }
        }
        const int nt = cur.nt;
        for (int t = 0; t < nt; t += 2) {
            const bool last = (t == nt - 2);
            const char* a1 = cA + (size_t)(t + 1) * kstep;
            G_LDB(B0, 0, 0); G_SCHED; G_LDA(At, 0, 0); G_STAGE2(G_SA(1, 1), a1, va10, va11);
            const char* a2 = last ? nA : cA + (size_t)(t + 2) * kstep; const char* b2 = last ? nB : cB + (size_t)(t + 2) * kstep;
            if (last) {
                if (Sched::GATHER_A) { va00 = na00; va01 = na01; va10 = na10; va11 = na11; vb0 = nb0; vb1 = nb1; hsB = nhsB; }
                else if (has_next) G_OFFS(nxt, va00, va01, va10, va11, vb0, vb1, hsB);
            }
            const char* a3 = a2 + kstep; const char* b3 = b2 + kstep;
            G_WAIT_L(8); G_BAR; G_WAIT_L(0); G_MMA(0, 0, At, B0); G_BAR; G_SCHED;
            G_LDB(B1, 0, 1); G_STAGE2(G_SB(0, 0), b2, vb0, vb1);
            G_BAR; G_WAIT_L(0); G_MMA(0, 1, At, B1); G_BAR;
            G_LDA(At, 0, 1); G_STAGE2(G_SA(0, 0), a2, va00, va01);
            G_BAR; G_WAIT_L(0); G_MMA(1, 0, At, B0); G_BAR; G_SCHED;
            G_STAGE2(G_SB(0, 1), b2 + hsB, vb0, vb1);
            G_WAIT_V(6); G_BAR; G_MMA(1, 1, At, B1); G_BAR;
            G_LDB(B0, 1, 0); G_SCHED; G_LDA(At, 1, 0); G_STAGE2(G_SA(0, 1), a2, va10, va11);
            G_WAIT_L(8); G_BAR; G_WAIT_L(0); G_MMA(0, 0, At, B0); G_BAR; G_SCHED;
            G_LDB(B1, 1, 1); G_STAGE2(G_SB(1, 0), b3, vb0, vb1);
            G_BAR; G_WAIT_L(0); G_MMA(0, 1, At, B1); G_BAR;
            G_LDA(At, 1, 1); G_STAGE2(G_SA(1, 0), a3, va00, va01);
            G_BAR; G_WAIT_L(0); G_MMA(1, 0, At, B0); G_BAR; G_SCHED;
            G_STAGE2(G_SB(1, 1), b3 + hsB, vb0, vb1);
            G_WAIT_V(6); G_BAR; G_MMA(1, 1, At, B1); G_BAR;
        }
        E(acc, cur, wr, wc, (int)(threadIdx.x & 15u), (int)((threadIdx.x >> 4) & 3u));
        if (!has_next) break;
        if constexpr (!Epi::MAYKEEP) {
#pragma unroll
            for (int a = 0; a < 2; ++a)
#pragma unroll
                for (int b = 0; b < 2; ++b)
#pragma unroll
                    for (int m = 0; m < 4; ++m)
#pragma unroll
                        for (int n = 0; n < 2; ++n) acc[a][b][m][n] = (f32x4){0.f, 0.f, 0.f, 0.f};
        }
        cur = nxt; cA = nA; cB = nB; ++ui;
    }
    G_WAIT_V(0);
    if (wr == 0) G_BAR;
    G_BAR;
}
}

__device__ __forceinline__ void grouped_order(int Ls, int nM, int nN, int& pm, int& pn) {
    const int n = nM * nN, q = n >> 3, r = n & 7, xcd = Ls & 7, off = Ls >> 3;
    const int wgid = (xcd < r ? xcd * (q + 1) : r * (q + 1) + (xcd - r) * q) + off;
    const int nig = 8 * nN, gid = wgid / nig, fm = gid * 8, gsz = (nM - fm) < 8 ? (nM - fm) : 8, w = wgid - gid * nig;
    pm = fm + (w % gsz); pn = w / gsz;
}
struct SchedProj {
    static constexpr bool VAR_STRIDE = false, GATHER_A = false, SKEW = true;
    const char* H; const char* W; const char* WG; int l, G, c;
    __device__ __forceinline__ bool next(int i, gm::GUnit& u) const {
        const int L = i * G + c, nlat = 256 * 16, nproj = nlat + (l == 0 ? 8 * 16 : 8 * 4), ngate = (l == 0 ? 264 : 256) * 16;
        if (L >= nproj + ngate) return false;
        int pm, pn, sub = 0;
        if (L < nlat) grouped_order(L, 256, 16, pm, pn);
        else if (L < nproj) { const int r = L - nlat; if (l == 0) { pm = 256 + (r >> 4); pn = r & 15; } else { pm = 256 + (r >> 2); pn = 2 + (r & 3); } }
        else { grouped_order(L - nproj, l == 0 ? 264 : 256, 16, pm, pn); sub = 1; }
        u.A = H + (size_t)pm * 256 * 2048; u.B = (sub ? WG : W) + (size_t)pn * 256 * 2048; u.gidx = nullptr; u.lda = 2048; u.ldb = 2048; u.nt = 16; u.pm = pm; u.pn = pn; u.sub = sub; u.e = 0; u.aux = 0;
        return true;
    }
};
struct SchedMerge {
    static constexpr bool VAR_STRIDE = true, GATHER_A = false, SKEW = false;
    const char* P; const char* WB; int ntile, G, c; bool ctxmode;
    __device__ __forceinline__ bool next(int i, gm::GUnit& u) const {
        const int k = i & 3;
        int pm, pn;
        if (ctxmode) { if (c >= 32 || i >= 4) return false; pm = 256 + (c >> 2); pn = c & 3; }
        else { const int L = (i >> 2) * G + c; if (L >= ntile) return false; grouped_order(L, ntile >> 2, 4, pm, pn); }
        u.gidx = nullptr; u.pm = pm; u.pn = pn; u.sub = k; u.e = 0; u.aux = 0;
        const int colofs = (k == 0) ? C_Q : (k == 1) ? C_SB : (k == 2) ? C_K : C_FX;
        const int kofs = (k == 0) ? 0 : (k == 1) ? 512 : (k == 2) ? 1024 : 2048;
        u.A = P + (size_t)pm * 256 * 8192 + colofs * 2; u.lda = 8192; u.B = WB + (size_t)pn * 256 * (WBR_K * 2) + kofs * 2; u.ldb = WBR_K * 2; u.nt = (k == 2) ? 16 : 8;
        return true;
    }
};
struct SchedOut {
    static constexpr bool VAR_STRIDE = false, GATHER_A = false, SKEW = false;
    const char* M; const char* W; int ntile, G, c, mode;
    __device__ __forceinline__ bool next(int i, gm::GUnit& u) const {
        int pm, pn;
        if (mode == 0) { const int L = i * G + c; if (L >= ntile) return false; grouped_order(L, ntile >> 2, 4, pm, pn); }
        else if (mode == 1) {
            const int w = c >> 3; int off;
            if (w < 4) { if (i >= 2) return false; off = w * 2 + i; }
            else if (i < 4) off = 8 + (w - 4) + 28 * i;
            else if (i == 4 && w < 12) off = 120 + (w - 4);
            else return false;
            grouped_order(off * 8 + (c & 7), 256, 4, pm, pn);
        } else {
            const int r = c - 96; if (i != 0 || r < 0 || r >= 32) return false;
            pm = 256 + (r >> 2); pn = r & 3;
        }
        u.A = M + (size_t)pm * 256 * 2048; u.B = W + (size_t)pn * 256 * 2048; u.gidx = nullptr; u.lda = 2048; u.ldb = 2048; u.nt = 16; u.pm = pm; u.pn = pn; u.sub = 0; u.e = 0;
        return true;
    }
};
__device__ __forceinline__ int moe_expert_of(const LAS int* tb, int rt) { int e = 0; while (tb[e + 1] <= rt) ++e; return e; }
struct SchedMoeFused {
    static constexpr bool VAR_STRIDE = false, GATHER_A = true, SKEW = true;
    const char* H; const char* GU; const char* DN; const char* act; const int* rtok; const LAS int* tb; int nfull, G, c; unsigned aux;
    __device__ __forceinline__ bool next(int i, gm::GUnit& u) const {
        const int ti = i / 12, s = i % 12, rt = ti * G + c;
        if (rt >= nfull) return false;
        const int e = moe_expert_of(tb, rt);
        u.pm = rt; u.sub = s; u.e = e; u.lda = 2048; u.ldb = 2048; u.nt = 16; u.aux = aux;
        if (s < 8) { u.pn = s; u.A = H; u.gidx = rtok + (size_t)rt * 256; u.B = GU + ((size_t)e * 2048 + s * 256) * 2048; }
        else { u.pn = s - 8; u.A = act + aux; u.gidx = nullptr; u.B = DN + ((size_t)e * 1024 + (s - 8) * 256) * 2048; }
        return true;
    }
};
template <bool GUPASS>
struct SchedMoeSplit {
    static constexpr bool VAR_STRIDE = false, GATHER_A = GUPASS, SKEW = false;
    const char* A; const char* W; const int* rtok; const LAS int* tb; int nfull, G, c;
    __device__ __forceinline__ bool next(int i, gm::GUnit& u) const {
        constexpr int NCT = GUPASS ? 8 : 4;
        const int L = i * G + c, rt = nfull + L / NCT, ct = L % NCT;
        if (rt >= tb[32]) return false;
        const int e = moe_expert_of(tb, rt);
        u.pm = rt; u.pn = ct; u.e = e; u.lda = 2048; u.ldb = 2048; u.nt = 16; u.aux = (unsigned)(rt - nfull) * (256u * 2048u);
        if (GUPASS) { u.sub = ct; u.A = A; u.gidx = rtok + (size_t)rt * 256; u.B = W + ((size_t)e * 2048 + ct * 256) * 2048; }
        else { u.sub = 8 + ct; u.A = A + u.aux; u.gidx = nullptr; u.B = W + ((size_t)e * 1024 + ct * 256) * 2048; }
        return true;
    }
};

typedef f32x4 AccT[2][2][4][2];
struct EpiProj {
    static constexpr bool MAYKEEP = false;
    bf16_t* P; const float* rope; unsigned char* G8; const float* bg;
    __device__ __forceinline__ void operator()(const AccT& acc, const gm::GUnit& u, int wr, int wc, int fr, int fq) const {
        asm volatile("" : "+v"(fr), "+v"(fq));
        if (u.sub == 1) {
            const float* bp = bg + u.pn * 256 + wc * 32 + 8 * fq;
            f32x4 bb[2][2];
#pragma unroll
            for (int bj = 0; bj < 2; ++bj) { bb[bj][0] = *(const f32x4*)(bp + bj * 128); bb[bj][1] = *(const f32x4*)(bp + bj * 128 + 4); }
            __builtin_amdgcn_sched_barrier(0);
#pragma unroll
            for (int bj = 0; bj < 2; ++bj) {
                const f32x4 b0 = bb[bj][0], b1 = bb[bj][1];
#pragma unroll
                for (int ai = 0; ai < 2; ++ai)
#pragma unroll
                    for (int m = 0; m < 4; ++m) {
                        const int row = u.pm * 256 + ai * 128 + wr * 64 + m * 16 + fr;
                        f32x4 v0 = (acc[ai][bj][m][0] + b0) * -1.4426950408889634f, v1 = (acc[ai][bj][m][1] + b1) * -1.4426950408889634f;
#pragma unroll
                        for (int j = 0; j < 4; ++j) { v0[j] = __builtin_amdgcn_exp2f(v0[j]); v1[j] = __builtin_amdgcn_exp2f(v1[j]); }
                        v0 = v0 + 1.f; v1 = v1 + 1.f;
#pragma unroll
                        for (int j = 0; j < 4; ++j) { v0[j] = __builtin_amdgcn_rcpf(v0[j]); v1[j] = __builtin_amdgcn_rcpf(v1[j]); }
                        v0 = v0 * 255.f + 0.5f; v1 = v1 * 255.f + 0.5f;
                        unsigned q[8];
#pragma unroll
                        for (int j = 0; j < 4; ++j) { q[j] = max((unsigned)v0[j], 1u); q[4 + j] = max((unsigned)v1[j], 1u); }
                        u32x2 w; w.x = q[0] | (q[1] << 8) | (q[2] << 16) | (q[3] << 24); w.y = q[4] | (q[5] << 8) | (q[6] << 16) | (q[7] << 24);
                        *(u32x2*)(G8 + (size_t)row * INW + u.pn * 256 + bj * 128 + wc * 32 + 8 * fq) = w;
                    }
            }
            return;
        }
        const bool dorope = (u.pn < 4) && (u.pm < 256);
f32x4 cs[2][4], sn[2][4];
#pragma unroll
        for (int ai = 0; ai < 2; ++ai)
#pragma unroll
            for (int m = 0; m < 4; ++m) { cs[ai][m] = (f32x4){1.f, 1.f, 1.f, 1.f}; sn[ai][m] = (f32x4){0.f, 0.f, 0.f, 0.f}; }
        if (dorope) {
#pragma unroll
            for (int ai = 0; ai < 2; ++ai)
#pragma unroll
                for (int m = 0; m < 4; ++m) {
                    const int row = u.pm * 256 + ai * 128 + wr * 64 + m * 16 + fr, s = row & (SEQ - 1), pos = (wc & 1) ? (s & 63) : (s >> 6);
                    cs[ai][m] = *(const f32x4*)(rope + pos * 16 + 4 * fq); sn[ai][m] = *(const f32x4*)(rope + 2048 + pos * 16 + 4 * fq);
                }
        }
        __builtin_amdgcn_sched_barrier(0);
#pragma unroll
        for (int ai = 0; ai < 2; ++ai)
#pragma unroll
            for (int m = 0; m < 4; ++m) {
                const int row = u.pm * 256 + ai * 128 + wr * 64 + m * 16 + fr;
                bf16_t* rowp = P + (size_t)row * INW + u.pn * 256 + wc * 32 + 8 * fq;
#pragma unroll
                for (int bj = 0; bj < 2; ++bj) {
                    const f32x4 x0 = acc[ai][bj][m][0], x1 = acc[ai][bj][m][1];
                    const f32x4 o0 = x0 * cs[ai][m] - x1 * sn[ai][m], o1 = x1 * cs[ai][m] + x0 * sn[ai][m];
                    u32x4 w; w.x = cvt_pk_bf16(o0[0], o0[1]); w.y = cvt_pk_bf16(o0[2], o0[3]); w.z = cvt_pk_bf16(o1[0], o1[1]); w.w = cvt_pk_bf16(o1[2], o1[3]);
                    *(u32x4*)(rowp + bj * 128) = w;
                }
            }
    }
};
struct EpiMerge {
    static constexpr bool MAYKEEP = true;
    const unsigned char* G8; bf16_t* M;
    __device__ __forceinline__ void operator()(AccT& acc, const gm::GUnit& u, int wr, int wc, int fr, int fq) const {
        asm volatile("" : "+v"(fr), "+v"(fq));
        const int k = u.sub;
        const unsigned char* gbase = G8 + (size_t)(u.pm * 256 + wr * 64 + fr) * INW + k * 1024 + u.pn * 256 + wc * 32 + 8 * fq;
#pragma unroll
        for (int q = 0; q < 4; ++q) {
            const int ai = q >> 1, m0 = (q & 1) * 2;
            u32x2 ga[2][2], gb[2][2];
#pragma unroll
            for (int mi = 0; mi < 2; ++mi)
#pragma unroll
                for (int bj = 0; bj < 2; ++bj) {
                    const unsigned char* gp = gbase + (size_t)(ai * 128 + (m0 + mi) * 16) * INW + bj * 128;
                    ga[mi][bj] = *(const u32x2*)gp;
                    gb[mi][bj] = (k < 3) ? *(const u32x2*)(gp + 1024) : (u32x2){0xffffffffu, 0xffffffffu};
                }
            __builtin_amdgcn_sched_barrier(0);
#pragma unroll
            for (int mi = 0; mi < 2; ++mi) {
                const int m = m0 + mi, row = u.pm * 256 + ai * 128 + wr * 64 + m * 16 + fr;
#pragma unroll
                for (int bj = 0; bj < 2; ++bj) {
                    const u32x2 a = ga[mi][bj], b = gb[mi][bj];
                    f32x4 r0, r1;
                    r0[0] = (float)(a.x & 255u) * __builtin_amdgcn_rcpf((float)(b.x & 255u)); r0[1] = (float)((a.x >> 8) & 255u) * __builtin_amdgcn_rcpf((float)((b.x >> 8) & 255u));
                    r0[2] = (float)((a.x >> 16) & 255u) * __builtin_amdgcn_rcpf((float)((b.x >> 16) & 255u)); r0[3] = (float)(a.x >> 24) * __builtin_amdgcn_rcpf((float)(b.x >> 24));
                    r1[0] = (float)(a.y & 255u) * __builtin_amdgcn_rcpf((float)(b.y & 255u)); r1[1] = (float)((a.y >> 8) & 255u) * __builtin_amdgcn_rcpf((float)((b.y >> 8) & 255u));
                    r1[2] = (float)((a.y >> 16) & 255u) * __builtin_amdgcn_rcpf((float)((b.y >> 16) & 255u)); r1[3] = (float)(a.y >> 24) * __builtin_amdgcn_rcpf((float)(b.y >> 24));
                    const f32x4 s0 = acc[ai][bj][m][0] * r0, s1 = acc[ai][bj][m][1] * r1;
                    if (k == 3) {
                        u32x4 w; w.x = cvt_pk_bf16(s0[0], s0[1]); w.y = cvt_pk_bf16(s0[2], s0[3]); w.z = cvt_pk_bf16(s1[0], s1[1]); w.w = cvt_pk_bf16(s1[2], s1[3]);
                        *(u32x4*)(M + (size_t)row * DM + u.pn * 256 + bj * 128 + wc * 32 + 8 * fq) = w;
                    }
                    const float kz = (k == 3) ? 0.f : 1.f;
                    acc[ai][bj][m][0] = s0 * kz; acc[ai][bj][m][1] = s1 * kz;
                }
            }
            __builtin_amdgcn_sched_barrier(0);
        }
    }
};
struct EpiOut {
    static constexpr bool MAYKEEP = false;
    const float* xin; float* xout; long long din, dout; const float* mods;
    __device__ __forceinline__ void operator()(const AccT& acc, const gm::GUnit& u, int wr, int wc, int fr, int fq) const {
        asm volatile("" : "+v"(fr), "+v"(fq));
        const bool lat = u.pm < 256;
        const int b = lat ? (u.pm >> 5) : 8;
        const float* gp = mods + (size_t)b * 6144 + 2 * 1024 + u.pn * 256 + wc * 32 + 4 * fq;
        f32x4 gv[2][2];
#pragma unroll
        for (int bj = 0; bj < 2; ++bj)
#pragma unroll
            for (int n = 0; n < 2; ++n) gv[bj][n] = *(const f32x4*)(gp + bj * 128 + n * 16);
#pragma unroll
        for (int q = 0; q < 4; ++q) {
            const int ai = q >> 1, m0 = (q & 1) * 2;
            f32x4 xv[2][2][2];
#pragma unroll
            for (int mi = 0; mi < 2; ++mi) {
                const int row = u.pm * 256 + ai * 128 + wr * 64 + (m0 + mi) * 16 + fr;
                const float* ip = xin + (size_t)row * DM + u.pn * 256 + wc * 32 + 4 * fq + (lat ? 0ll : din);
#pragma unroll
                for (int bj = 0; bj < 2; ++bj)
#pragma unroll
                    for (int n = 0; n < 2; ++n) xv[mi][bj][n] = *(const f32x4*)(ip + bj * 128 + n * 16);
            }
            __builtin_amdgcn_sched_barrier(0);
#pragma unroll
            for (int mi = 0; mi < 2; ++mi) {
                const int m = m0 + mi, row = u.pm * 256 + ai * 128 + wr * 64 + m * 16 + fr;
                float* op = xout + (size_t)row * DM + u.pn * 256 + wc * 32 + 4 * fq + (lat ? 0ll : dout);
#pragma unroll
                for (int bj = 0; bj < 2; ++bj)
#pragma unroll
                    for (int n = 0; n < 2; ++n) *(f32x4*)(op + bj * 128 + n * 16) = xv[mi][bj][n] + gv[bj][n] * acc[ai][bj][m][n];
            }
            __builtin_amdgcn_sched_barrier(0);
        }
    }
};
struct EpiMoe {
    static constexpr bool MAYKEEP = false;
    char* act; const float* bgate; const float* bup; const float* bd; const int* rtok; const float* rw; bf16_t* Y; bool fused;
    __device__ __forceinline__ void operator()(const AccT& acc, const gm::GUnit& u, int wr, int wc, int fr, int fq) const {
        asm volatile("" : "+v"(fr), "+v"(fq));
        if (u.sub < 8) {
            bf16_t* at = (bf16_t*)(act + u.aux);
            f32x4 bgs[2], bus[2];
#pragma unroll
            for (int bj = 0; bj < 2; ++bj) { const int col = u.pn * 128 + bj * 64 + wc * 16 + 4 * fq; bgs[bj] = *(const f32x4*)(bgate + u.e * 1024 + col); bus[bj] = *(const f32x4*)(bup + u.e * 1024 + col); }
            __builtin_amdgcn_sched_barrier(0);
#pragma unroll
            for (int bj = 0; bj < 2; ++bj) {
                const int col = u.pn * 128 + bj * 64 + wc * 16 + 4 * fq;
                const f32x4 bgv = bgs[bj], buv = bus[bj];
#pragma unroll
                for (int ai = 0; ai < 2; ++ai)
#pragma unroll
                    for (int m = 0; m < 4; ++m) {
                        const int row = ai * 128 + wr * 64 + m * 16 + fr;
                        f32x4 a4 = acc[ai][bj][m][0] + bgv, u4 = acc[ai][bj][m][1] + buv;
#pragma unroll
                        for (int j = 0; j < 4; ++j) { a4[j] = fminf(a4[j], 7.f); u4[j] = fminf(fmaxf(u4[j], -7.f), 7.f); }
                        f32x4 e4 = a4 * (-1.702f * 1.4426950408889634f);
#pragma unroll
                        for (int j = 0; j < 4; ++j) e4[j] = __builtin_amdgcn_exp2f(e4[j]);
                        e4 = e4 + 1.f;
#pragma unroll
                        for (int j = 0; j < 4; ++j) e4[j] = __builtin_amdgcn_rcpf(e4[j]);
                        const f32x4 g4 = a4 * e4, o = g4 * u4 + g4;
                        u32x2 w; w.x = cvt_pk_bf16(o[0], o[1]); w.y = cvt_pk_bf16(o[2], o[3]);
                        *(u32x2*)(at + (size_t)row * DM + col) = w;
                    }
            }
        } else {
            const int col = u.pn * 256 + wc * 32 + 8 * fq;
            f32x4 bv[2][2];
#pragma unroll
            for (int bj = 0; bj < 2; ++bj) { bv[bj][0] = *(const f32x4*)(bd + u.e * 1024 + col + bj * 128); bv[bj][1] = *(const f32x4*)(bd + u.e * 1024 + col + bj * 128 + 4); }
            int slots[8]; float ws8[8];
#pragma unroll
            for (int i = 0; i < 8; ++i) { const int row = u.pm * 256 + (i >> 2) * 128 + wr * 64 + (i & 3) * 16 + fr; slots[i] = rtok[row]; ws8[i] = rw[row]; }
            __builtin_amdgcn_sched_barrier(0);
#pragma unroll
            for (int ai = 0; ai < 2; ++ai)
#pragma unroll
                for (int m = 0; m < 4; ++m) {
                    const int slot = slots[ai * 4 + m];
                    if (slot >= 0) {
                        const float w = ws8[ai * 4 + m];
                        bf16_t* yp = Y + (size_t)slot * DM + col;
#pragma unroll
                        for (int bj = 0; bj < 2; ++bj) {
                            const f32x4 y0 = (acc[ai][bj][m][0] + bv[bj][0]) * w, y1 = (acc[ai][bj][m][1] + bv[bj][1]) * w;
                            u32x4 q; q.x = cvt_pk_bf16(y0[0], y0[1]); q.y = cvt_pk_bf16(y0[2], y0[3]); q.z = cvt_pk_bf16(y1[0], y1[1]); q.w = cvt_pk_bf16(y1[2], y1[3]);
                            *(u32x4*)(yp + bj * 128) = q;
                        }
                    }
                }
            if (fused && u.sub == 11) asm volatile("buffer_inv sc0\n\ts_waitcnt vmcnt(0)" ::: "memory");
        }
    }
};

struct EpiDry {
    static constexpr bool MAYKEEP = false;
    bf16_t* P;
    __device__ __forceinline__ void operator()(const AccT& acc, const gm::GUnit& u, int wr, int wc, int fr, int fq) const {
        float s = 0.f;
#pragma unroll
        for (int ai = 0; ai < 2; ++ai)
#pragma unroll
            for (int bj = 0; bj < 2; ++bj)
#pragma unroll
                for (int m = 0; m < 4; ++m)
#pragma unroll
                    for (int n = 0; n < 2; ++n) s += acc[ai][bj][m][n][0] + acc[ai][bj][m][n][1] + acc[ai][bj][m][n][2] + acc[ai][bj][m][n][3];
        if (s == 123456.789f) P[(size_t)u.pm * 256 * INW + fr] = 0;
    }
};

#ifndef DRY_NT
#define DRY_NT 16
#endif
struct SchedProjDry {
    static constexpr bool VAR_STRIDE = false, GATHER_A = false, SKEW = false;
    SchedProj S;
    __device__ __forceinline__ bool next(int i, gm::GUnit& u) const { const bool ok = S.next(i, u); u.nt = DRY_NT;
#ifdef DRY_SAME
        u.A = S.H; u.B = S.W;
#endif
        return ok; }
};

namespace at {
constexpr int SHM_V = 64 * 128 * 2, SHM_K = 64 * 64 * 2;
constexpr int SLOT = SHM_V + SHM_K;
constexpr int OFF_V = 0, OFF_K = 2 * SHM_V, OFF_WS = 3 * SLOT, OFF_STASH = OFF_WS + 8 * 64 * 4, OFF_FLAG = OFF_STASH + 65536;
constexpr float SCALE = 0.125f, THR = 8.f;
#define AT_KSWZ(row, colB) ((row) * 128 + ((colB) ^ ((((row) >> 1) & 7) << 4)))
#define AT_SBAR() __builtin_amdgcn_sched_barrier(0)
__device__ __forceinline__ int crow(int r, int hi) { return (r & 3) + 8 * (r >> 2) + 4 * hi; }

constexpr float THRL = THR * 1.4426950408889634f;
template <bool FIRST>
__device__ __forceinline__ void partialSM(f32x16& p0, f32x16& p1, float& m_reg, float& alpha) {
    float pmax = p0[0];
#pragma unroll
    for (int r = 1; r < 16; ++r) pmax = fmaxf(pmax, p0[r]);
#pragma unroll
    for (int r = 0; r < 16; ++r) pmax = fmaxf(pmax, p1[r]);
    { auto rr = __builtin_amdgcn_permlane32_swap(__float_as_uint(pmax), __float_as_uint(pmax), false, false);
      pmax = fmaxf(__uint_as_float(rr[0]), __uint_as_float(rr[1])); }
    if (!FIRST && __builtin_expect(__all(pmax <= THRL), 1)) { alpha = 1.f; }
    else {
        const float d = FIRST ? pmax : fmaxf(pmax, 0.f);
        alpha = FIRST ? 1.f : __builtin_amdgcn_exp2f(-d); m_reg += d;
#pragma unroll
        for (int r = 0; r < 16; ++r) { p0[r] -= d; p1[r] -= d; }
    }
#pragma unroll
    for (int r = 0; r < 16; ++r) p0[r] = __builtin_amdgcn_exp2f(p0[r]);
}
__device__ __forceinline__ void finishSM(f32x16& p0, f32x16& p1, float alpha, float& l_reg, bf16x8& pa0, bf16x8& pa1, bf16x8& pa2, bf16x8& pa3) {
#pragma unroll
    for (int r = 0; r < 16; ++r) p1[r] = __builtin_amdgcn_exp2f(p1[r]);
    float ps = 0;
#pragma unroll
    for (int r = 0; r < 16; ++r) ps += p0[r];
#pragma unroll
    for (int r = 0; r < 16; ++r) ps += p1[r];
    { auto rr = __builtin_amdgcn_permlane32_swap(__float_as_uint(ps), __float_as_uint(ps), false, false);
      ps = __uint_as_float(rr[0]) + __uint_as_float(rr[1]); }
    l_reg = l_reg * alpha + ps;
#define AT_PK4(P, BASE, OUT) do { unsigned a0 = cvt_pk_bf16(P[BASE + 0], P[BASE + 1]), a1 = cvt_pk_bf16(P[BASE + 2], P[BASE + 3]);   \
    unsigned b0 = cvt_pk_bf16(P[BASE + 4], P[BASE + 5]), b1 = cvt_pk_bf16(P[BASE + 6], P[BASE + 7]);                              \
    auto r0 = __builtin_amdgcn_permlane32_swap(a0, b0, false, false); auto r1 = __builtin_amdgcn_permlane32_swap(a1, b1, false, false); \
    u32x4 w = {r0[0], r1[0], r0[1], r1[1]}; OUT = *reinterpret_cast<bf16x8*>(&w); } while (0)
    AT_PK4(p0, 0, pa0); AT_PK4(p0, 8, pa1); AT_PK4(p1, 0, pa2); AT_PK4(p1, 8, pa3);
#undef AT_PK4
}
#ifndef AT_TOVF
#define AT_TOVF 1099511627776.f
#endif
constexpr float TOVF = AT_TOVF;
__device__ __forceinline__ void expSM(f32x16& p) {
#pragma unroll
    for (int r = 0; r < 16; ++r) p[r] = __builtin_amdgcn_exp2f(p[r]);
}
__device__ __forceinline__ void finishFast(f32x16& p0, f32x16& p1, bool& ovf, float& l_reg, bf16x8& pa0, bf16x8& pa1, bf16x8& pa2, bf16x8& pa3) {
    expSM(p1);
    typedef float f32x2_t __attribute__((ext_vector_type(2)));
    f32x2_t sa = {p0[0], p0[1]}, sb = {p0[8], p0[9]}, sc = {p1[0], p1[1]}, sd = {p1[8], p1[9]};
#pragma unroll
    for (int r = 2; r < 8; r += 2) { sa += f32x2_t{p0[r], p0[r + 1]}; sb += f32x2_t{p0[8 + r], p0[9 + r]}; sc += f32x2_t{p1[r], p1[r + 1]}; sd += f32x2_t{p1[8 + r], p1[9 + r]}; }
    const f32x2_t ps2 = (sa + sb) + (sc + sd);
    float ps = ps2.x + ps2.y;
    { auto rr = __builtin_amdgcn_permlane32_swap(__float_as_uint(ps), __float_as_uint(ps), false, false);
      ps = __uint_as_float(rr[0]) + __uint_as_float(rr[1]); }
    l_reg += ps;
#define AT_PK4(P, BASE, OUT) do { u32x4 w = {cvt_pk_bf16(P[BASE + 0], P[BASE + 1]), cvt_pk_bf16(P[BASE + 2], P[BASE + 3]), cvt_pk_bf16(P[BASE + 4], P[BASE + 5]), cvt_pk_bf16(P[BASE + 6], P[BASE + 7])}; \
    OUT = *reinterpret_cast<bf16x8*>(&w); } while (0)
    AT_PK4(p0, 0, pa0); AT_PK4(p0, 8, pa1); AT_PK4(p1, 0, pa2); AT_PK4(p1, 8, pa3);
#undef AT_PK4
}
__device__ __forceinline__ void qkt(f32x16& p0, f32x16& p1, const LAS char* Ks, const bf16x8* qr, int r32, int hi, float init) {
#pragma unroll
    for (int r = 0; r < 16; ++r) { p0[r] = init; p1[r] = init; }
#pragma unroll
    for (int d0 = 0; d0 < 4; ++d0) { const int cb = (d0 * 16 + hi * 8) * 2;
        const bf16x8 b0 = *(const LAS bf16x8*)(Ks + AT_KSWZ(r32, cb));
        const bf16x8 b1 = *(const LAS bf16x8*)(Ks + AT_KSWZ(32 + r32, cb));
        p0 = __builtin_amdgcn_mfma_f32_32x32x16_bf16(b0, qr[d0], p0, 0, 0, 0);
        p1 = __builtin_amdgcn_mfma_f32_32x32x16_bf16(b1, qr[d0], p1, 0, 0, 0); }
}
template <int OFF> __device__ __forceinline__ bf16x8 k_read(int ka) {
    bf16x8 r; asm volatile("ds_read_b128 %0, %1 offset:%2" : "=&v"(r) : "v"(ka), "i"(OFF) : "memory"); return r;
}
template <int BOFF>
__device__ __forceinline__ void qkt_pre(f32x16& p0, f32x16& p1, const int (&ka)[4], const bf16x8* qr, float init) {
    bf16x8 a0 = k_read<BOFF>(ka[0]), b0 = k_read<BOFF + 4096>(ka[0]), a1 = k_read<BOFF>(ka[1]), b1 = k_read<BOFF + 4096>(ka[1]);
    bf16x8 a2 = k_read<BOFF>(ka[2]), b2 = k_read<BOFF + 4096>(ka[2]), a3 = k_read<BOFF>(ka[3]), b3 = k_read<BOFF + 4096>(ka[3]);
#pragma unroll
    for (int r = 0; r < 16; ++r) { p0[r] = init; p1[r] = init; }
    asm volatile("s_waitcnt lgkmcnt(6)" : "+v"(a0), "+v"(b0) :: "memory");
    p0 = __builtin_amdgcn_mfma_f32_32x32x16_bf16(a0, qr[0], p0, 0, 0, 0); p1 = __builtin_amdgcn_mfma_f32_32x32x16_bf16(b0, qr[0], p1, 0, 0, 0);
    asm volatile("s_waitcnt lgkmcnt(4)" : "+v"(a1), "+v"(b1) :: "memory");
    p0 = __builtin_amdgcn_mfma_f32_32x32x16_bf16(a1, qr[1], p0, 0, 0, 0); p1 = __builtin_amdgcn_mfma_f32_32x32x16_bf16(b1, qr[1], p1, 0, 0, 0);
    asm volatile("s_waitcnt lgkmcnt(2)" : "+v"(a2), "+v"(b2) :: "memory");
    p0 = __builtin_amdgcn_mfma_f32_32x32x16_bf16(a2, qr[2], p0, 0, 0, 0); p1 = __builtin_amdgcn_mfma_f32_32x32x16_bf16(b2, qr[2], p1, 0, 0, 0);
    asm volatile("s_waitcnt lgkmcnt(0)" : "+v"(a3), "+v"(b3) :: "memory");
    p0 = __builtin_amdgcn_mfma_f32_32x32x16_bf16(a3, qr[3], p0, 0, 0, 0); p1 = __builtin_amdgcn_mfma_f32_32x32x16_bf16(b3, qr[3], p1, 0, 0, 0);
}
__device__ __forceinline__ int v_st(int k, int c) { const int kk = (k & ~0xC) | ((k & 4) << 1) | ((k & 8) >> 1); return ((kk >> 3) * 4 + (c >> 5)) * 512 + ((kk & 7) * 32 + (c & 31)) * 2; }
__device__ __forceinline__ int v_rd_base(int lane) { return ((lane & 3) << 3) | (((lane >> 2) & 3) << 6) | (((lane >> 4) & 1) << 5) | (((lane >> 5) & 1) << 8); }
constexpr int v_rd_off(int d0, int ks, int half) { return d0 * 512 + ks * 4096 + half * 2048; }
template <int OFF> __device__ __forceinline__ s16x4 tr_read(int vb) {
    s16x4 r; asm volatile("ds_read_b64_tr_b16 %0, %1 offset:%2" : "=&v"(r) : "v"(vb), "i"(OFF) : "memory"); return r;
}
#define AT_PKV(L, H) (bf16x8){L[0], L[1], L[2], L[3], H[0], H[1], H[2], H[3]}
template <int D0> __device__ __forceinline__ void pv_one(f32x16& od, int vb, bf16x8 pa0, bf16x8 pa1, bf16x8 pa2, bf16x8 pa3) {
    const s16x4 l0 = tr_read<v_rd_off(D0, 0, 0)>(vb), h0 = tr_read<v_rd_off(D0, 0, 1)>(vb), l1 = tr_read<v_rd_off(D0, 1, 0)>(vb), h1 = tr_read<v_rd_off(D0, 1, 1)>(vb);
    const s16x4 l2 = tr_read<v_rd_off(D0, 2, 0)>(vb), h2 = tr_read<v_rd_off(D0, 2, 1)>(vb), l3 = tr_read<v_rd_off(D0, 3, 0)>(vb), h3 = tr_read<v_rd_off(D0, 3, 1)>(vb);
    asm volatile("s_waitcnt lgkmcnt(0)" ::: "memory"); AT_SBAR();
    od = __builtin_amdgcn_mfma_f32_32x32x16_bf16(pa0, AT_PKV(l0, h0), od, 0, 0, 0);
    od = __builtin_amdgcn_mfma_f32_32x32x16_bf16(pa1, AT_PKV(l1, h1), od, 0, 0, 0);
    od = __builtin_amdgcn_mfma_f32_32x32x16_bf16(pa2, AT_PKV(l2, h2), od, 0, 0, 0);
    od = __builtin_amdgcn_mfma_f32_32x32x16_bf16(pa3, AT_PKV(l3, h3), od, 0, 0, 0);
}
#ifndef AT_PVPIPE
#define AT_PVPIPE 2
#endif
#define AT_TR8(D0, X) s16x4 X##l0 = tr_read<v_rd_off(D0, 0, 0)>(vb), X##h0 = tr_read<v_rd_off(D0, 0, 1)>(vb), X##l1 = tr_read<v_rd_off(D0, 1, 0)>(vb), X##h1 = tr_read<v_rd_off(D0, 1, 1)>(vb), \
    X##l2 = tr_read<v_rd_off(D0, 2, 0)>(vb), X##h2 = tr_read<v_rd_off(D0, 2, 1)>(vb), X##l3 = tr_read<v_rd_off(D0, 3, 0)>(vb), X##h3 = tr_read<v_rd_off(D0, 3, 1)>(vb)
#define AT_MF4(OD, X) do { OD = __builtin_amdgcn_mfma_f32_32x32x16_bf16(pa0, AT_PKV(X##l0, X##h0), OD, 0, 0, 0); OD = __builtin_amdgcn_mfma_f32_32x32x16_bf16(pa1, AT_PKV(X##l1, X##h1), OD, 0, 0, 0); \
    OD = __builtin_amdgcn_mfma_f32_32x32x16_bf16(pa2, AT_PKV(X##l2, X##h2), OD, 0, 0, 0); OD = __builtin_amdgcn_mfma_f32_32x32x16_bf16(pa3, AT_PKV(X##l3, X##h3), OD, 0, 0, 0); } while (0)
__device__ __forceinline__ void pv_d0(f32x16* o, int vb, bf16x8 pa0, bf16x8 pa1, bf16x8 pa2, bf16x8 pa3) {
#if AT_PVPIPE == 2
#define AT_W8(N, X) asm volatile("s_waitcnt lgkmcnt(" #N ")" : "+v"(X##l0), "+v"(X##h0), "+v"(X##l1), "+v"(X##h1), "+v"(X##l2), "+v"(X##h2), "+v"(X##l3), "+v"(X##h3) :: "memory")
    AT_TR8(0, a); AT_TR8(1, b);
    AT_W8(8, a); AT_TR8(2, c); AT_MF4(o[0], a);
    AT_W8(8, b); AT_TR8(3, d); AT_MF4(o[1], b);
    AT_W8(8, c); AT_MF4(o[2], c);
    AT_W8(0, d); AT_MF4(o[3], d);
#undef AT_W8
#elif AT_PVPIPE == 1
    AT_TR8(0, a);
    asm volatile("s_waitcnt lgkmcnt(0)" ::: "memory"); AT_SBAR(); AT_TR8(1, b); AT_SBAR(); AT_MF4(o[0], a);
    asm volatile("s_waitcnt lgkmcnt(0)" ::: "memory"); AT_SBAR(); AT_TR8(2, c); AT_SBAR(); AT_MF4(o[1], b);
    asm volatile("s_waitcnt lgkmcnt(0)" ::: "memory"); AT_SBAR(); AT_TR8(3, d); AT_SBAR(); AT_MF4(o[2], c);
    asm volatile("s_waitcnt lgkmcnt(0)" ::: "memory"); AT_SBAR(); AT_MF4(o[3], d);
#else
    pv_one<0>(o[0], vb, pa0, pa1, pa2, pa3); pv_one<1>(o[1], vb, pa0, pa1, pa2, pa3); pv_one<2>(o[2], vb, pa0, pa1, pa2, pa3); pv_one<3>(o[3], vb, pa0, pa1, pa2, pa3);
#endif
}

template <bool ROBUST>
__device__ __forceinline__ bool attn_pass(const bf16_t* __restrict__ proj, LAS char* lds, int qrow0, int ctxrow0, int latrow0, int NT, int h, int comp, f32x16 (&o)[4]) {
    int tid = threadIdx.x; asm volatile("" : "+v"(tid));
    const int wid = tid >> 6, lane = tid & 63, r32 = lane & 31, hi = lane >> 5;
    LAS char* V_lds = lds + OFF_V; LAS char* K_lds = lds + OFF_K;
    LAS float* ws = (LAS float*)(lds + OFF_WS) + wid * 64; LAS float* li_l = ws; LAS float* al_l = ws + 32;
    float m_reg = 0.f, l_reg = 0.f;
#pragma unroll
    for (int d = 0; d < 4; ++d) o[d] = f32x16{};
    bf16x8 qr[4];
    { const bf16_t* Qw = proj + (size_t)(qrow0 + wid * 32 + r32) * INW + C_Q + h * 128 + comp * 64 + hi * 8;
#pragma unroll
      for (int d0 = 0; d0 < 4; ++d0) {
          const u32x4 w = *(const u32x4*)(Qw + d0 * 16); constexpr float C = SCALE * 1.4426950408889634f; u32x4 s;
          s.x = cvt_pk_bf16(bf_lo(w.x) * C, bf_hi(w.x) * C); s.y = cvt_pk_bf16(bf_lo(w.y) * C, bf_hi(w.y) * C); s.z = cvt_pk_bf16(bf_lo(w.z) * C, bf_hi(w.z) * C); s.w = cvt_pk_bf16(bf_lo(w.w) * C, bf_hi(w.w) * C);
          qr[d0] = *reinterpret_cast<bf16x8*>(&s); } }
    const int sr = tid >> 4, sc = (tid & 15) * 8, vst0 = v_st(sr, sc), vst1 = v_st(32 + sr, sc);
    const int kr = tid >> 3, kc = (tid & 7) * 8, kst = AT_KSWZ(kr, kc * 2);
    const int vb0 = (int)(uintptr_t)V_lds + v_rd_base(lane);
    const char* pb = (const char*)proj;
    const unsigned voV0 = (unsigned)((sr * INW + C_V + h * 128 + sc) * 2), voV1 = voV0 + 32u * INW * 2u, voK = (unsigned)((kr * INW + C_K + h * 128 + comp * 64 + kc) * 2);
    bf16x8 vsA0, vsA1, ksA, vsB0, vsB1, ksB;
#define AT_ROW(j) ((j) < 4 ? ctxrow0 + (j) * 64 : latrow0 + ((j) - 4) * 64)
#define AT_SLOAD(S, j) do { const char* _p = pb + (size_t)__builtin_amdgcn_readfirstlane(AT_ROW(j)) * (INW * 2); vs##S##0 = *(const bf16x8*)(_p + voV0); vs##S##1 = *(const bf16x8*)(_p + voV1); \
        ks##S = *(const bf16x8*)(_p + voK); } while (0)
#define AT_SWRITE(b, S) do { *(LAS bf16x8*)(V_lds + (b) * SHM_V + vst0) = vs##S##0; *(LAS bf16x8*)(V_lds + (b) * SHM_V + vst1) = vs##S##1; \
        *(LAS bf16x8*)(K_lds + (b) * SHM_K + kst) = ks##S; } while (0)
#define AT_SWAIT() asm volatile("s_waitcnt vmcnt(3)" ::: "memory")
#define AT_RESC(a) do { if (__any((a) < 1.f)) { if (hi == 0) al_l[r32] = (a); asm volatile("s_waitcnt lgkmcnt(0)" ::: "memory"); \
        _Pragma("unroll") for (int d = 0; d < 4; ++d) _Pragma("unroll") for (int r = 0; r < 16; ++r) o[d][r] *= al_l[crow(r, hi)]; } } while (0)
    bool any_ovf = false;
    if constexpr (ROBUST) {
    f32x16 pA0, pA1, pB0, pB1; float alA, alB; bf16x8 pa0, pa1, pa2, pa3;
    AT_SLOAD(A, 0); asm volatile("s_waitcnt vmcnt(0)" ::: "memory"); AT_SWRITE(0, A); __syncthreads();
    qkt(pA0, pA1, K_lds, qr, r32, hi, 0.f); partialSM<true>(pA0, pA1, m_reg, alA);
    AT_SLOAD(B, 1); if (2 < NT) AT_SLOAD(A, 2);
    AT_SWAIT(); AT_SWRITE(1, B); __syncthreads();
    for (int j = 1; j + 1 < NT; j += 2) {
        AT_SBAR(); qkt(pB0, pB1, K_lds + SHM_K, qr, r32, hi, -m_reg);
        finishSM(pA0, pA1, alA, l_reg, pa0, pa1, pa2, pa3); AT_SBAR();
        AT_SLOAD(B, j + 2); AT_SBAR();
        pv_d0(o, vb0, pa0, pa1, pa2, pa3); partialSM<false>(pB0, pB1, m_reg, alB);
        __syncthreads(); AT_SWAIT(); AT_SWRITE(0, A);
        AT_RESC(alB); __syncthreads();
        AT_SBAR(); qkt(pA0, pA1, K_lds, qr, r32, hi, -m_reg);
        finishSM(pB0, pB1, alB, l_reg, pa0, pa1, pa2, pa3); AT_SBAR();
        if (j + 3 < NT) AT_SLOAD(A, j + 3); AT_SBAR();
        pv_d0(o, vb0 + SHM_V, pa0, pa1, pa2, pa3); partialSM<false>(pA0, pA1, m_reg, alA);
        __syncthreads(); AT_SWAIT(); AT_SWRITE(1, B);
        AT_RESC(alA); __syncthreads();
    }
    AT_SBAR(); qkt(pB0, pB1, K_lds + SHM_K, qr, r32, hi, -m_reg);
    finishSM(pA0, pA1, alA, l_reg, pa0, pa1, pa2, pa3); AT_SBAR();
    pv_d0(o, vb0, pa0, pa1, pa2, pa3); partialSM<false>(pB0, pB1, m_reg, alB);
    __syncthreads(); AT_RESC(alB);
    finishSM(pB0, pB1, alB, l_reg, pa0, pa1, pa2, pa3); AT_SBAR();
    pv_d0(o, vb0 + SHM_V, pa0, pa1, pa2, pa3);
    } else {
    f32x16 pA0, pA1, pB0, pB1; bf16x8 pa0, pa1, pa2, pa3; bool ovf = false; float alA;
    int ka[4];
#pragma unroll
    for (int d0 = 0; d0 < 4; ++d0) ka[d0] = (int)(uintptr_t)(lds + SHM_V) + AT_KSWZ(r32, (d0 * 16 + hi * 8) * 2);
    const int widu = __builtin_amdgcn_readfirstlane(wid), l5 = lane >> 5, lp = lane & 31;
    const int kv = wid * 8 + (lp >> 2);
    const unsigned dV0 = (unsigned)((kv * INW + C_V + h * 128 + l5 * 32 + (lp & 3) * 8) * 2), dV1 = dV0 + 128u;
    const int krow = wid * 8 + (lane >> 3);
    const unsigned dK = (unsigned)((krow * INW + C_K + h * 128 + comp * 64) * 2 + (((lane & 7) ^ ((krow >> 1) & 7)) << 4));
#define AT_DMA_K(j, so) do { const char* _p = pb + (size_t)__builtin_amdgcn_readfirstlane(AT_ROW(j)) * (INW * 2); \
        __builtin_amdgcn_global_load_lds((const unsigned*)(_p + dK), (LAS unsigned*)(lds + (so) + SHM_V + widu * 1024), 16, 0, 0); } while (0)
#define AT_DMA_V(j, so) do { const char* _p = pb + (size_t)__builtin_amdgcn_readfirstlane(AT_ROW(j)) * (INW * 2); \
        __builtin_amdgcn_global_load_lds((const unsigned*)(_p + dV0), (LAS unsigned*)(lds + (so) + widu * 2048), 16, 0, 0); \
        __builtin_amdgcn_global_load_lds((const unsigned*)(_p + dV1), (LAS unsigned*)(lds + (so) + widu * 2048 + 1024), 16, 0, 0); } while (0)
    s16x4 dl0, dh0, dl1, dh1, dl2, dh2, dl3, dh3;
    int sV = 0, sK = SLOT, sN = 2 * SLOT;
#define AT_TR8S(D0, X) do { X##l0 = tr_read<v_rd_off(D0, 0, 0)>(vb); X##h0 = tr_read<v_rd_off(D0, 0, 1)>(vb); X##l1 = tr_read<v_rd_off(D0, 1, 0)>(vb); X##h1 = tr_read<v_rd_off(D0, 1, 1)>(vb); \
        X##l2 = tr_read<v_rd_off(D0, 2, 0)>(vb); X##h2 = tr_read<v_rd_off(D0, 2, 1)>(vb); X##l3 = tr_read<v_rd_off(D0, 3, 0)>(vb); X##h3 = tr_read<v_rd_off(D0, 3, 1)>(vb); } while (0)
#define AT_W8(N, X) asm volatile("s_waitcnt lgkmcnt(" #N ")" : "+v"(X##l0), "+v"(X##h0), "+v"(X##l1), "+v"(X##h1), "+v"(X##l2), "+v"(X##h2), "+v"(X##l3), "+v"(X##h3) :: "memory")
    const bool grpB = widu >= 4;
#define AT_BARBLK(T) do { if ((T) + 2 < NT) asm volatile("s_waitcnt vmcnt(1) lgkmcnt(0)" ::: "memory"); else asm volatile("s_waitcnt vmcnt(0) lgkmcnt(0)" ::: "memory"); \
        __builtin_amdgcn_s_barrier();     \
        if ((T) + 1 < NT) AT_DMA_V((T) + 1, sN); if ((T) + 3 < NT) AT_DMA_K((T) + 3, sK); } while (0)
#define AT_HALF(TAIL, PC0, PC1, PP0, PP1, T) do { \
        const int kb0 = ka[0] + sK, kb1 = ka[1] + sK, kb2 = ka[2] + sK, kb3 = ka[3] + sK; \
        bf16x8 a0 = k_read<0>(kb0), b0 = k_read<4096>(kb0), a1 = k_read<0>(kb1), b1 = k_read<4096>(kb1); \
        bf16x8 a2 = k_read<0>(kb2), b2 = k_read<4096>(kb2), a3 = k_read<0>(kb3), b3 = k_read<4096>(kb3); \
        AT_SBAR(); \
        if (TAIL) { AT_MF4(o[3], d); } \
        { const float init = -m_reg; _Pragma("unroll") for (int r = 0; r < 16; ++r) { PC0[r] = init; PC1[r] = init; } } \
        asm volatile("s_waitcnt lgkmcnt(6)" : "+v"(a0), "+v"(b0) :: "memory"); \
        PC0 = __builtin_amdgcn_mfma_f32_32x32x16_bf16(a0, qr[0], PC0, 0, 0, 0); PC1 = __builtin_amdgcn_mfma_f32_32x32x16_bf16(b0, qr[0], PC1, 0, 0, 0); \
        asm volatile("s_waitcnt lgkmcnt(4)" : "+v"(a1), "+v"(b1) :: "memory"); \
        PC0 = __builtin_amdgcn_mfma_f32_32x32x16_bf16(a1, qr[1], PC0, 0, 0, 0); PC1 = __builtin_amdgcn_mfma_f32_32x32x16_bf16(b1, qr[1], PC1, 0, 0, 0); \
        asm volatile("s_waitcnt lgkmcnt(2)" : "+v"(a2), "+v"(b2) :: "memory"); \
        PC0 = __builtin_amdgcn_mfma_f32_32x32x16_bf16(a2, qr[2], PC0, 0, 0, 0); PC1 = __builtin_amdgcn_mfma_f32_32x32x16_bf16(b2, qr[2], PC1, 0, 0, 0); \
        asm volatile("s_waitcnt lgkmcnt(0)" : "+v"(a3), "+v"(b3) :: "memory"); \
        PC0 = __builtin_amdgcn_mfma_f32_32x32x16_bf16(a3, qr[3], PC0, 0, 0, 0); PC1 = __builtin_amdgcn_mfma_f32_32x32x16_bf16(b3, qr[3], PC1, 0, 0, 0); \
        finishFast(PP0, PP1, ovf, l_reg, pa0, pa1, pa2, pa3); AT_SBAR(); \
        if (grpB) AT_BARBLK(T); \
        AT_SBAR(); \
        { const int vb = vb0 + sV; AT_TR8(0, a); AT_TR8(1, b); \
          AT_W8(8, a); AT_TR8(2, c); AT_MF4(o[0], a); \
          AT_W8(8, b); AT_TR8S(3, d); AT_MF4(o[1], b); \
          AT_W8(8, c); AT_MF4(o[2], c); \
          AT_W8(0, d); } \
        expSM(PC0); \
        if (!grpB) AT_BARBLK(T); \
        { const int _t = sV; sV = sK; sK = sN; sN = _t; } } while (0)
    AT_DMA_K(0, 0); AT_DMA_V(0, 0); AT_DMA_K(1, SLOT); AT_DMA_V(1, SLOT); AT_DMA_K(2, 2 * SLOT);
    asm volatile("s_waitcnt vmcnt(4)" ::: "memory"); __syncthreads();
    if (tid == 0) *(LAS int*)(lds + OFF_FLAG) = 0;
    qkt(pA0, pA1, lds + SHM_V, qr, r32, hi, 0.f); partialSM<true>(pA0, pA1, m_reg, alA);
    asm volatile("s_waitcnt vmcnt(1)" ::: "memory"); __syncthreads();
    AT_DMA_K(3, 0);
    AT_HALF(false, pB0, pB1, pA0, pA1, 1);
    for (int j = 2; j + 1 < NT; j += 2) {
        AT_HALF(true, pA0, pA1, pB0, pB1, j);
        AT_HALF(true, pB0, pB1, pA0, pA1, j + 1);
    }
    AT_MF4(o[3], d);
    finishFast(pB0, pB1, ovf, l_reg, pa0, pa1, pa2, pa3); AT_SBAR();
    pv_d0(o, vb0 + sV, pa0, pa1, pa2, pa3);
#undef AT_HALF
#undef AT_BARBLK
#undef AT_W8
#undef AT_TR8S
#undef AT_DMA_K
#undef AT_DMA_V
    any_ovf = !(l_reg < TOVF);
    }
    if (hi == 0) li_l[r32] = l_reg;
    asm volatile("s_waitcnt lgkmcnt(0)" ::: "memory");
#pragma unroll
    for (int r = 0; r < 16; ++r) { const float rl = __builtin_amdgcn_rcpf(li_l[crow(r, hi)]);
#pragma unroll
        for (int d = 0; d < 4; ++d) o[d][r] *= rl; }
    if constexpr (!ROBUST) { if (__any(any_ovf) && lane == 0) *(LAS int*)(lds + OFF_FLAG) = 1; }
    __syncthreads();
    if constexpr (!ROBUST) return __builtin_amdgcn_readfirstlane(*(LAS int*)(lds + OFF_FLAG)) != 0;
    return false;
#undef AT_ROW
#undef AT_SLOAD
#undef AT_SWRITE
#undef AT_SWAIT
#undef AT_RESC
}

__device__ __forceinline__ void attn_unit(bf16_t* __restrict__ proj, LAS char* lds, int qrow0, int b, int h, int NT, float lam, float post, const float* __restrict__ gsub) {
    const int ctxrow0 = TL + b * CTXL, latrow0 = b * SEQ;
    LAS unsigned* stash = (LAS unsigned*)(lds + OFF_STASH);
    f32x16 o[4];
#pragma unroll 1
    for (int comp = 0; comp < 2; ++comp) {
        if (attn_pass<false>(proj, lds, qrow0, ctxrow0, latrow0, NT, h, comp, o)) attn_pass<true>(proj, lds, qrow0, ctxrow0, latrow0, NT, h, comp, o);
        if (comp == 0) {
            int tid = threadIdx.x; asm volatile("" : "+v"(tid));
#pragma unroll
            for (int d = 0; d < 4; ++d)
#pragma unroll
                for (int r = 0; r < 16; r += 2) stash[(d * 8 + (r >> 1)) * NTHR + tid] = cvt_pk_bf16(o[d][r], o[d][r + 1]);
        }
    }
    int tid = threadIdx.x; asm volatile("" : "+v"(tid));
    const int wid = tid >> 6, lane = tid & 63, r32 = lane & 31, hi = lane >> 5;
    float ss[16];
#pragma unroll
    for (int r = 0; r < 16; ++r) ss[r] = 0.f;
#pragma unroll
    for (int d = 0; d < 4; ++d)
#pragma unroll
        for (int r = 0; r < 16; r += 2) {
            const unsigned w = stash[(d * 8 + (r >> 1)) * NTHR + tid];
            const float a0 = bf_lo(w) - lam * o[d][r], a1 = bf_hi(w) - lam * o[d][r + 1];
            o[d][r] = a0; o[d][r + 1] = a1; ss[r] += a0 * a0; ss[r + 1] += a1 * a1;
        }
#pragma unroll
    for (int r = 0; r < 16; ++r) {
        const float v = half32_sum(ss[r]);
        ss[r] = rsqrtf(v * (1.f / 128.f) + EPS) * post;
    }
    bf16_t* Ow = proj + (size_t)(qrow0 + wid * 32) * INW + C_Q + h * 128;
#pragma unroll
    for (int d = 0; d < 4; ++d) { const float g = gsub[d * 32 + r32];
#pragma unroll
        for (int r = 0; r < 16; ++r) Ow[(size_t)crow(r, hi) * INW + d * 32 + r32] = f2bf(o[d][r] * ss[r] * g); }
}
}

__device__ __forceinline__ void phase_attn(const Frame& F, const Params& P, int l) {
    const float lam = F.lam()[l], lam_init = 0.8f - 0.6f * expf(-0.3f * (float)l), post = 1.f - lam_init;
    const float* gsub = P.g_subln + l * 128;
    const int nlat = NB * 4 * 32, nun = nlat + (l == 0 ? NB * 4 : 0);
    for (int i = 0;; ++i) {
        int u = i * F.nwg + F.wg;
        if (F.nwg == 256 && i < 4) u = ((i * 8 + (F.wg & 7)) << 5) + (F.wg >> 3);
        if (u >= nun) break;
        int qrow0, b, h, NT;
        if (u < nlat) { b = u >> 7; h = (u >> 5) & 3; qrow0 = b * SEQ + (u & 31) * 256; NT = 132; }
        else { const int v = u - nlat; b = v >> 2; h = v & 3; qrow0 = TL + b * CTXL; NT = 4; }
        at::attn_unit(F.proj(), (LAS char*)F.lds, qrow0, b, h, NT, lam, post, gsub);
    }
}

namespace ff {
using at::tr_read; using at::v_rd_off; using at::v_st; using at::v_rd_base; using at::crow;
template <int D0> __device__ __forceinline__ void xt_two(f32x16& od1, f32x16& od2, int vb, const bf16x8 (&b1)[4], const bf16x8 (&b2)[4]) {
    const s16x4 l0 = tr_read<v_rd_off(D0, 0, 0)>(vb), h0 = tr_read<v_rd_off(D0, 0, 1)>(vb), l1 = tr_read<v_rd_off(D0, 1, 0)>(vb), h1 = tr_read<v_rd_off(D0, 1, 1)>(vb);
    const s16x4 l2 = tr_read<v_rd_off(D0, 2, 0)>(vb), h2 = tr_read<v_rd_off(D0, 2, 1)>(vb), l3 = tr_read<v_rd_off(D0, 3, 0)>(vb), h3 = tr_read<v_rd_off(D0, 3, 1)>(vb);
    asm volatile("s_waitcnt lgkmcnt(0)" ::: "memory"); __builtin_amdgcn_sched_barrier(0);
    const bf16x8 a0 = AT_PKV(l0, h0), a1 = AT_PKV(l1, h1), a2 = AT_PKV(l2, h2), a3 = AT_PKV(l3, h3);
    od1 = __builtin_amdgcn_mfma_f32_32x32x16_bf16(a0, b1[0], od1, 0, 0, 0); od2 = __builtin_amdgcn_mfma_f32_32x32x16_bf16(a0, b2[0], od2, 0, 0, 0);
    od1 = __builtin_amdgcn_mfma_f32_32x32x16_bf16(a1, b1[1], od1, 0, 0, 0); od2 = __builtin_amdgcn_mfma_f32_32x32x16_bf16(a1, b2[1], od2, 0, 0, 0);
    od1 = __builtin_amdgcn_mfma_f32_32x32x16_bf16(a2, b1[2], od1, 0, 0, 0); od2 = __builtin_amdgcn_mfma_f32_32x32x16_bf16(a2, b2[2], od2, 0, 0, 0);
    od1 = __builtin_amdgcn_mfma_f32_32x32x16_bf16(a3, b1[3], od1, 0, 0, 0); od2 = __builtin_amdgcn_mfma_f32_32x32x16_bf16(a3, b2[3], od2, 0, 0, 0);
}
}

__device__ __forceinline__ void phase_fft_a(const Frame& F) {
    const int tid = F.tid, wid = F.wid, lane = F.lane, r32 = lane & 31, hi = lane >> 5;
    LAS char* Vt = (LAS char*)F.lds;
    const int sr = tid >> 4, sc = (tid & 15) * 8;
    const int rb = wid & 3, chh = wid >> 2, k1 = 32 * rb + r32;
    const bf16_t* dc = F.dft(); const bf16_t* ds = F.dft() + 16384;
    const int NU = NB * 64 * 4;
    bf16x8 pf[4];
#define FA_LOAD(u) do { const int _b = (u) >> 8, _n2 = ((u) >> 2) & 63, _cb = (u) & 3; \
        _Pragma("unroll") for (int _q = 0; _q < 4; ++_q) { const int _n1 = (_q >> 1) * 64 + (_q & 1) * 32 + sr; \
            pf[_q] = *(const bf16x8*)(F.proj() + (size_t)(_b * SEQ + 64 * _n1 + _n2) * INW + C_FX + _cb * 128 + sc); } } while (0)
    int u = F.wg, par = 0;
    if (u < NU) FA_LOAD(u);
    for (; u < NU; u += F.nwg, par ^= 1) {
        const int b = u >> 8, n2 = (u >> 2) & 63, cb = u & 3;
        LAS char* img = Vt + par * 32768;
#pragma unroll
        for (int q = 0; q < 4; ++q) *(LAS bf16x8*)(img + (q >> 1) * 16384 + ff::v_st((q & 1) * 32 + sr, sc)) = pf[q];
        __syncthreads();
        if (u + F.nwg < NU) FA_LOAD(u + F.nwg);
        f32x16 zc[2] = {f32x16{}, f32x16{}}, zs[2] = {f32x16{}, f32x16{}};
#pragma unroll
        for (int t = 0; t < 2; ++t) {
            bf16x8 bc[4], bs[4];
#pragma unroll
            for (int ks = 0; ks < 4; ++ks) { const int o = k1 * 128 + t * 64 + ks * 16 + hi * 8; bc[ks] = *(const bf16x8*)(dc + o); bs[ks] = *(const bf16x8*)(ds + o); }
            const int vb = (int)(uintptr_t)img + t * 16384 + ff::v_rd_base(lane) + chh * 1024;
            ff::xt_two<0>(zc[0], zs[0], vb, bc, bs);
            ff::xt_two<1>(zc[1], zs[1], vb, bc, bs);
        }
        const f32x2 t2 = *(const f32x2*)(F.tw() + (size_t)(k1 * 64 + n2) * 2);
        bf16_t* zp = F.zm() + (size_t)((b * 128 + k1) * 64 + n2) * DM + cb * 128 + 64 * chh + 4 * hi;
#pragma unroll
        for (int dd = 0; dd < 2; ++dd)
#pragma unroll
            for (int g = 0; g < 4; ++g) {
                float p[4], q[4];
#pragma unroll
                for (int j = 0; j < 4; ++j) { const float c = zc[dd][4 * g + j], s = zs[dd][4 * g + j]; p[j] = c * t2.x - s * t2.y; q[j] = c * t2.y + s * t2.x; }
                u32x2 wp, wq; wp.x = cvt_pk_bf16(p[0], p[1]); wp.y = cvt_pk_bf16(p[2], p[3]); wq.x = cvt_pk_bf16(q[0], q[1]); wq.y = cvt_pk_bf16(q[2], q[3]);
                *(u32x2*)(zp + dd * 32 + 8 * g) = wp; *(u32x2*)(zp + 512 + dd * 32 + 8 * g) = wq;
            }
    }
#undef FA_LOAD
    __syncthreads();
}

__device__ __forceinline__ void phase_fft_b(const Frame& F) {
    const int tid = F.tid, wid = F.wid, lane = F.lane, r32 = lane & 31, hi = lane >> 5;
    LAS char* Vt = (LAS char*)F.lds;
    const int sr = tid >> 4, sc = (tid & 15) * 8;
    const int rb = wid & 1, cq = wid >> 1, k2 = 32 * rb + r32;
    const bf16_t* dc = F.dft() + 32768; const bf16_t* ds = dc + 4096; const bf16_t* dn = dc + 8192;
    bf16x8 bc[4], bs[4], bn[4];
#pragma unroll
    for (int ks = 0; ks < 4; ++ks) { const int o = k2 * 64 + ks * 16 + hi * 8; bc[ks] = *(const bf16x8*)(dc + o); bs[ks] = *(const bf16x8*)(ds + o); bn[ks] = *(const bf16x8*)(dn + o); }
    const int NU = NB * 128 * 4;
    bf16x8 pf[4];
#define FB_LOAD(u) do { const int _b = (u) >> 9, _k1 = ((u) >> 2) & 127, _cb = (u) & 3; \
        _Pragma("unroll") for (int _q = 0; _q < 4; ++_q) pf[_q] = *(const bf16x8*)(F.zm() + (size_t)((_b * 128 + _k1) * 64 + (_q & 1) * 32 + sr) * DM + (_q >> 1) * 512 + _cb * 128 + sc); } while (0)
    int u = F.wg, par = 0;
    if (u < NU) FB_LOAD(u);
    for (; u < NU; u += F.nwg, par ^= 1) {
        const int b = u >> 9, k1 = (u >> 2) & 127, cb = u & 3;
        LAS char* img = Vt + par * 32768;
#pragma unroll
        for (int q = 0; q < 4; ++q) *(LAS bf16x8*)(img + (q >> 1) * 16384 + ff::v_st((q & 1) * 32 + sr, sc)) = pf[q];
        __syncthreads();
        if (u + F.nwg < NU) FB_LOAD(u + F.nwg);
        f32x16 ar = f32x16{}, bi = f32x16{};
        const int vbP = (int)(uintptr_t)img + ff::v_rd_base(lane) + cq * 512;
        ff::xt_two<0>(ar, bi, vbP, bc, bs);
        ff::xt_two<0>(ar, bi, vbP + 16384, bn, bc);
        bf16_t* op = F.proj() + (size_t)(b * SEQ + k1 + 128 * k2) * INW + cb * 128 + 32 * cq + 4 * hi;
#pragma unroll
        for (int g = 0; g < 4; ++g) {
            u32x2 wa, wb;
            wa.x = cvt_pk_bf16(ar[4 * g] * 0.011048543456039806f, ar[4 * g + 1] * 0.011048543456039806f); wa.y = cvt_pk_bf16(ar[4 * g + 2] * 0.011048543456039806f, ar[4 * g + 3] * 0.011048543456039806f);
            wb.x = cvt_pk_bf16(bi[4 * g] * 0.011048543456039806f, bi[4 * g + 1] * 0.011048543456039806f); wb.y = cvt_pk_bf16(bi[4 * g + 2] * 0.011048543456039806f, bi[4 * g + 3] * 0.011048543456039806f);
            *(u32x2*)(op + C_K + 8 * g) = wa; *(u32x2*)(op + C_V + 8 * g) = wb;
        }
    }
#undef FB_LOAD
    __syncthreads();
}

__device__ __forceinline__ void phase_ctx_dft(const Frame& F) {
    const int tid = F.tid, wid = F.wid, lane = F.lane, r32 = lane & 31, hi = lane >> 5;
    LAS char* Vt = (LAS char*)F.lds;
    const int sr = tid >> 4, sc = (tid & 15) * 8, np = 32 * wid + r32;
    const bf16_t* dc = F.dft256(); const bf16_t* ds = dc + 65536;
    for (int u = F.wg; u < NB * 4; u += F.nwg) {
        const int b = u >> 2, cb = u & 3;
#pragma unroll
        for (int q = 0; q < 8; ++q) {
            const int key = (q & 1) * 32 + sr, n = (q >> 1) * 64 + key;
            const bf16x8 v = *(const bf16x8*)(F.proj() + (size_t)(TL + b * CTXL + n) * INW + C_FX + cb * 128 + sc);
            *(LAS bf16x8*)(Vt + (q >> 1) * 16384 + ff::v_st(key, sc)) = v;
        }
        __syncthreads();
        bf16_t* op = F.zm() + (size_t)(TL + b * CTXL + np) * DM + cb * 128 + 4 * hi;
#pragma unroll 1
        for (int hf = 0; hf < 2; ++hf) {
            f32x16 ac[2] = {f32x16{}, f32x16{}}, as[2] = {f32x16{}, f32x16{}};
#pragma unroll
            for (int q = 0; q < 4; ++q) {
                bf16x8 bc[4], bs[4];
#pragma unroll
                for (int ks = 0; ks < 4; ++ks) { const int o = np * 256 + q * 64 + ks * 16 + hi * 8; bc[ks] = *(const bf16x8*)(dc + o); bs[ks] = *(const bf16x8*)(ds + o); }
                const int vb = (int)(uintptr_t)Vt + q * 16384 + ff::v_rd_base(lane) + hf * 1024;
                ff::xt_two<0>(ac[0], as[0], vb, bc, bs); ff::xt_two<1>(ac[1], as[1], vb, bc, bs);
            }
#pragma unroll
            for (int dd = 0; dd < 2; ++dd)
#pragma unroll
                for (int g = 0; g < 4; ++g) {
                    u32x2 wa, wb;
                    wa.x = cvt_pk_bf16(ac[dd][4 * g] * 0.0625f, ac[dd][4 * g + 1] * 0.0625f); wa.y = cvt_pk_bf16(ac[dd][4 * g + 2] * 0.0625f, ac[dd][4 * g + 3] * 0.0625f);
                    wb.x = cvt_pk_bf16(as[dd][4 * g] * 0.0625f, as[dd][4 * g + 1] * 0.0625f); wb.y = cvt_pk_bf16(as[dd][4 * g + 2] * 0.0625f, as[dd][4 * g + 3] * 0.0625f);
                    *(u32x2*)(op + 64 * hf + 32 * dd + 8 * g) = wa; *(u32x2*)(op + 512 + 64 * hf + 32 * dd + 8 * g) = wb;
                }
        }
        __syncthreads();
    }
}

__device__ __forceinline__ int moe_rows_per_wg(int nrows, int nwg) { return (nrows + nwg - 1) / nwg; }
__device__ __forceinline__ void phase_norm2_route(const Frame& F, const Params& P, int l, int nrows, long long dctx) {
    constexpr int WROW = 1024 + 8;
    LAS bf16_t* whi = (LAS bf16_t*)F.lds; LAS bf16_t* wlo = whi + 32 * WROW;
    LAS int* hist = (LAS int*)(F.lds + 2 * 32 * WROW * 2);
    const float* wr = P.w_router + (size_t)l * DM * NEXP;
    for (int i = F.tid; i < DM * NEXP; i += NTHR) {
        const int d = i >> 5, e = i & 31; const float w = wr[i]; const bf16_t h = f2bf(w);
        whi[e * WROW + d] = h; wlo[e * WROW + d] = f2bf(w - bf2f(h));
    }
    if (F.tid < 32) hist[F.tid] = 0;
    const float* g = P.g_norm2 + l * DM;
    const int per = moe_rows_per_wg(nrows, F.nwg), r0 = F.wg * per, r1 = min(nrows, r0 + per);
    bf16_t* LO = F.proj();
    for (int rowA = r0 + F.wid; rowA < r1; rowA += 16) {
        const int rowB = rowA + 8; const bool hasB = rowB < r1; const int rowBs = hasB ? rowB : rowA;
        const float* xa = xrow_ptr(P.out, dctx, rowA); const float* xb = xrow_ptr(P.out, dctx, rowBs);
        f32x4 va[4], vb[4]; float sa = 0.f, sb = 0.f;
#pragma unroll
        for (int j = 0; j < 4; ++j) { va[j] = *(const f32x4*)(xa + F.lane * 4 + 256 * j); vb[j] = *(const f32x4*)(xb + F.lane * 4 + 256 * j); }
#pragma unroll
        for (int j = 0; j < 4; ++j) { sa += va[j][0] * va[j][0] + va[j][1] * va[j][1] + va[j][2] * va[j][2] + va[j][3] * va[j][3]; sb += vb[j][0] * vb[j][0] + vb[j][1] * vb[j][1] + vb[j][2] * vb[j][2] + vb[j][3] * vb[j][3]; }
        sa = wave_sum(sa); sb = wave_sum(sb);
        const float ra = rsqrtf(sa * (1.f / 1024.f) + EPS), rb = rsqrtf(sb * (1.f / 1024.f) + EPS);
        const float* mda = F.mods() + (size_t)(l * 9 + (rowA < TL ? (rowA >> 13) : 8)) * 6144;
        const float* mdb = F.mods() + (size_t)(l * 9 + (rowBs < TL ? (rowBs >> 13) : 8)) * 6144;
#pragma unroll
        for (int j = 0; j < 4; ++j) {
            const int col = F.lane * 4 + 256 * j;
            const f32x4 gg = *(const f32x4*)(g + col);
            const f32x4 sha = *(const f32x4*)(mda + 3 * 1024 + col), sca = *(const f32x4*)(mda + 4 * 1024 + col);
            const f32x4 shb = *(const f32x4*)(mdb + 3 * 1024 + col), scb = *(const f32x4*)(mdb + 4 * 1024 + col);
            float oa[4], ob[4];
#pragma unroll
            for (int i = 0; i < 4; ++i) { oa[i] = va[j][i] * ra * gg[i] * (1.f + sca[i]) + sha[i]; ob[i] = vb[j][i] * rb * gg[i] * (1.f + scb[i]) + shb[i]; }
            u32x2 ha, hb, la, lb;
            ha.x = cvt_pk_bf16(oa[0], oa[1]); ha.y = cvt_pk_bf16(oa[2], oa[3]); hb.x = cvt_pk_bf16(ob[0], ob[1]); hb.y = cvt_pk_bf16(ob[2], ob[3]);
            la.x = cvt_pk_bf16(oa[0] - bf_lo(ha.x), oa[1] - bf_hi(ha.x)); la.y = cvt_pk_bf16(oa[2] - bf_lo(ha.y), oa[3] - bf_hi(ha.y));
            lb.x = cvt_pk_bf16(ob[0] - bf_lo(hb.x), ob[1] - bf_hi(hb.x)); lb.y = cvt_pk_bf16(ob[2] - bf_lo(hb.y), ob[3] - bf_hi(hb.y));
            *(u32x2*)(F.H() + (size_t)rowA * DM + col) = ha; *(u32x2*)(LO + (size_t)rowA * DM + col) = la;
            if (hasB) { *(u32x2*)(F.H() + (size_t)rowB * DM + col) = hb; *(u32x2*)(LO + (size_t)rowB * DM + col) = lb; }
        }
    }
    asm volatile("s_waitcnt vmcnt(0)" ::: "memory");
    __syncthreads();
    const int r32 = F.lane & 31, hi = F.lane >> 5;
    const float bias = P.b_router[l * NEXP + r32];
    const int ntile = (r1 - r0 + 31) >> 5;
    for (int t = F.wid; t < ntile; t += 8) {
        const int rowbase = r0 + t * 32, myrow = min(rowbase + r32, r1 - 1);
        const bf16_t* ph = F.H() + (size_t)myrow * DM + hi * 8; const bf16_t* pl = LO + (size_t)myrow * DM + hi * 8;
        const LAS bf16_t* bh = whi + r32 * WROW + hi * 8; const LAS bf16_t* bl = wlo + r32 * WROW + hi * 8;
        f32x16 acc = f32x16{};
        bf16x8 ahA[8], alA[8], ahB[8], alB[8];
#pragma unroll
        for (int q = 0; q < 8; ++q) { ahA[q] = *(const bf16x8*)(ph + q * 16); alA[q] = *(const bf16x8*)(pl + q * 16); }
#pragma unroll
        for (int bt = 0; bt < 8; bt += 2) {
#pragma unroll
            for (int q = 0; q < 8; ++q) { ahB[q] = *(const bf16x8*)(ph + ((bt + 1) * 8 + q) * 16); alB[q] = *(const bf16x8*)(pl + ((bt + 1) * 8 + q) * 16); }
#pragma unroll
            for (int q = 0; q < 8; ++q) { const int ks = bt * 8 + q;
                const bf16x8 wh = *(const LAS bf16x8*)(bh + ks * 16), wl = *(const LAS bf16x8*)(bl + ks * 16);
                acc = __builtin_amdgcn_mfma_f32_32x32x16_bf16(ahA[q], wh, acc, 0, 0, 0); acc = __builtin_amdgcn_mfma_f32_32x32x16_bf16(ahA[q], wl, acc, 0, 0, 0); acc = __builtin_amdgcn_mfma_f32_32x32x16_bf16(alA[q], wh, acc, 0, 0, 0); }
            if (bt + 2 < 8) {
#pragma unroll
                for (int q = 0; q < 8; ++q) { ahA[q] = *(const bf16x8*)(ph + ((bt + 2) * 8 + q) * 16); alA[q] = *(const bf16x8*)(pl + ((bt + 2) * 8 + q) * 16); }
            }
#pragma unroll
            for (int q = 0; q < 8; ++q) { const int ks = (bt + 1) * 8 + q;
                const bf16x8 wh = *(const LAS bf16x8*)(bh + ks * 16), wl = *(const LAS bf16x8*)(bl + ks * 16);
                acc = __builtin_amdgcn_mfma_f32_32x32x16_bf16(ahB[q], wh, acc, 0, 0, 0); acc = __builtin_amdgcn_mfma_f32_32x32x16_bf16(ahB[q], wl, acc, 0, 0, 0); acc = __builtin_amdgcn_mfma_f32_32x32x16_bf16(alB[q], wh, acc, 0, 0, 0); }
        }
#pragma unroll
        for (int r = 0; r < 16; ++r) {
            float v = acc[r] + bias;
            float tv[4]; int ti[4];
#pragma unroll
            for (int k = 0; k < 4; ++k) {
                float bv = v; int bi = r32;
#define RT_STEP(CTRL) do { const float ov = dpp_f<CTRL>(bv); const int oi = dpp_i<CTRL>(bi); const bool take = (ov > bv) || (ov == bv && oi < bi); bv = take ? ov : bv; bi = take ? oi : bi; } while (0)
                RT_STEP(DPP_X1); RT_STEP(DPP_X2); RT_STEP(DPP_HMIR); RT_STEP(DPP_MIR);
#undef RT_STEP
                {
                    const auto rv = __builtin_amdgcn_permlane16_swap(__float_as_uint(bv), __float_as_uint(bv), false, false);
                    const auto ri = __builtin_amdgcn_permlane16_swap((unsigned)bi, (unsigned)bi, false, false);
                    const float v0 = __uint_as_float(rv[0]), v1 = __uint_as_float(rv[1]); const int i0 = (int)ri[0], i1 = (int)ri[1];
                    const bool take1 = (v1 > v0) || (v1 == v0 && i1 < i0);
                    bv = take1 ? v1 : v0; bi = take1 ? i1 : i0;
                }
                tv[k] = bv; ti[k] = bi;
                v = (r32 == bi) ? -3.0e38f : v;
            }
            const int row = rowbase + at::crow(r, hi);
            if (r32 == r && row < r1) {
                float w4[4], den = 0.f;
#pragma unroll
                for (int k = 0; k < 4; ++k) { w4[k] = __expf(tv[k] - tv[0]); den += w4[k]; }
                const float inv = 1.f / den;
#pragma unroll
                for (int k = 0; k < 4; ++k) {
                    F.sele()[(size_t)row * 4 + k] = ti[k]; F.selw()[(size_t)row * 4 + k] = w4[k] * inv;
                    __hip_atomic_fetch_add(&hist[ti[k]], 1, __ATOMIC_RELAXED, __HIP_MEMORY_SCOPE_WORKGROUP);
                }
            }
        }
    }
    __syncthreads();
    if (F.tid < 32) F.cntw()[F.wg * 32 + F.tid] = hist[F.tid];
    __syncthreads();
}

__device__ __forceinline__ LAS int* moe_tb(const Frame& F) { return (LAS int*)(F.lds + LDS_MISC + 64); }
__device__ __forceinline__ void moe_sum_counts(const Frame& F, LAS int* tot, LAS int* pre, LAS int* scratch) {
    const int e = F.tid & 31, q = F.tid >> 5;
    int st = 0, sp = 0;
    for (int w = q; w < F.nwg; w += 16) { const int c = F.cntw()[w * 32 + e]; st += c; sp += (w < F.wg) ? c : 0; }
    scratch[q * 32 + e] = st; scratch[512 + q * 32 + e] = sp;
    __syncthreads();
    if (F.tid < 32) { int a = 0, b = 0;
        for (int k = 0; k < 16; ++k) { a += scratch[k * 32 + F.tid]; b += scratch[512 + k * 32 + F.tid]; }
        tot[F.tid] = a; pre[F.tid] = b; }
    __syncthreads();
}
__device__ __forceinline__ void moe_build_tb(const Frame& F) {
    LAS int* tb = moe_tb(F); LAS int* tot = tb + 40; LAS int* pre = tb + 80; LAS int* scratch = (LAS int*)F.lds;
    moe_sum_counts(F, tot, pre, scratch);
    if (F.tid == 0) { int acc = 0; tb[0] = 0; for (int e = 0; e < 32; ++e) { acc += (tot[e] + 255) >> 8; tb[e + 1] = acc; } }
    __syncthreads();
}
__device__ __forceinline__ void phase_positions(const Frame& F, int l, int nrows) {
    LAS int* tb = moe_tb(F); LAS int* tot = tb + 40; LAS int* pre = tb + 80;
    LAS int* rank = (LAS int*)(F.lds + 8192);
    moe_build_tb(F);
    if (F.tid < 32) rank[F.tid] = 0;
    __syncthreads();
    const int per = moe_rows_per_wg(nrows, F.nwg), r0 = F.wg * per, r1 = min(nrows, r0 + per);
    for (int i = r0 * 4 + F.tid; i < r1 * 4; i += NTHR) {
        const int e = F.sele()[i], r = __hip_atomic_fetch_add(&rank[e], 1, __ATOMIC_RELAXED, __HIP_MEMORY_SCOPE_WORKGROUP);
        const int pos = tb[e] * 256 + pre[e] + r;
        F.rtok()[pos] = i; F.rw()[pos] = F.selw()[i];
    }
    for (int e = F.wg; e < 32; e += F.nwg) {
        const int base = tb[e] * 256 + tot[e], end = tb[e + 1] * 256;
        for (int p = base + F.tid; p < end; p += NTHR) { F.rtok()[p] = -1; F.rw()[p] = 0.f; }
    }
    __syncthreads();
}

constexpr int NPHL = 11;
constexpr int NPHASE = 1 + 2 * NPHL + 1;

__device__ __forceinline__ void launder(Frame& F) { int t = threadIdx.x; asm volatile("" : "+v"(t)); F.tid = t; F.lane = t & 63; F.wid = __builtin_amdgcn_readfirstlane(t >> 6);
    unsigned long long w = (unsigned long long)F.ws; asm volatile("" : "+s"(w)); F.ws = (unsigned char*)(__attribute__((address_space(1))) unsigned char*)w; }
__global__ void __launch_bounds__(NTHR, 2) fwd_kernel(Params prm) {
    extern __shared__ __attribute__((aligned(16))) unsigned char lds_raw[];
    Frame F;
    const Params& P = prm;
    F.tid = threadIdx.x; F.lane = F.tid & 63; F.wid = __builtin_amdgcn_readfirstlane(F.tid >> 6); F.wg = blockIdx.x; F.nwg = gridDim.x;
    F.lds = (LAS unsigned char*)lds_raw;
    F.ws = prm.ws;

    volatile LAS unsigned* misc = (volatile LAS unsigned*)(F.lds + LDS_MISC);
    if (F.tid < 16) misc[F.tid] = 0u;
    __syncthreads();
    const int lo = prm.ph_lo, hi = prm.ph_hi;
    XcdBarrier bar; bar.bar = F.ctl() + CW_BAR; bar.x = 0; bar.st = misc;
    if (hi - lo > 1) bar = xcd_barrier_post(F.ctl() + CW_BAR, misc);
#ifndef PH_MASK
#define PH_MASK 0xFFF
#endif
#define EN(g) (((PH_MASK) >> (g)) & 1)
#define IN(k) (lo <= (k) && (k) < hi)
#ifdef PROBE_DOUBLE_BARRIER
#define SEAM(k) do { if (IN((k) + 1)) { xcd_barrier(bar); xcd_barrier(bar); } } while (0)
#else
#define SEAM(k) do { if (IN((k) + 1)) xcd_barrier(bar); } while (0)
#endif
#ifdef PROBE_MASK
#define PB_BEGIN(id) unsigned long long _pt0_##id = (((PROBE_MASK) >> (id)) & 1) ? __builtin_amdgcn_s_memrealtime() : 0ull
#define PB_END(id) do { if (((PROBE_MASK) >> (id)) & 1) { __syncthreads(); const unsigned long long _t1 = __builtin_amdgcn_s_memrealtime(), _w = (_t1 - _pt0_##id) * (PROBE_MUL); \
        while (__builtin_amdgcn_s_memrealtime() - _t1 < _w) __builtin_amdgcn_s_sleep(8); } } while (0)
#else
#define PB_BEGIN(id) do {} while (0)
#define PB_END(id) do {} while (0)
#endif

    if (EN(0) && IN(0)) { PB_BEGIN(0); launder(F); p0_prologue(F, P); PB_END(0); SEAM(0); }

    for (int l = 0; l < NLAYER; ++l) {
        const int PB = 1 + l * NPHL;
        const int nrows = (l == 0) ? TA : TL;
        const float* modl = F.mods() + (size_t)l * 9 * 6144;
        const int cx = (F.nwg % 8 == 0) ? (F.wg & 7) * (F.nwg / 8) + (F.wg >> 3) : F.wg;
        const float* xs = (l == 0) ? prm.x : prm.out;
        const long long dxs = (long long)(F.ctxb() - xs) - (long long)TL * DM;
        const long long dout = (long long)(F.ctxb() - prm.out) - (long long)TL * DM;
        const long long dcin = (l == 0) ? (long long)(prm.ctx - xs) - (long long)TL * DM : dxs;
        if (EN(1) && IN(PB + 0)) { PB_BEGIN(1); launder(F); phase_norm1(F, P, l, xs, dxs, l > 0, prm.out, dout); PB_END(1); SEAM(PB + 0); }
        if (EN(2) && IN(PB + 1)) {
            SchedProj S{(const char*)F.H(), (const char*)(F.win() + (size_t)l * INW * DM), (const char*)(F.wgate() + (size_t)l * INW * DM), l, F.nwg, F.wg};
            EpiProj E{F.proj(), F.rope(), F.g8(), prm.b_mgate + l * INW};
#ifdef DRY_GEMM1
            { EpiDry ED{F.proj()}; SchedProjDry SD{S}; gm::gemm_phase<true>(F.lds, SD, ED); }
#endif
            PB_BEGIN(2); gm::gemm_phase<true>(F.lds, S, E); PB_END(2);
            SEAM(PB + 1);
        }
        if (EN(3) && IN(PB + 2)) {
#ifndef SUB3
#define SUB3 15
#endif
            PB_BEGIN(3); launder(F); if (SUB3 & 1) phase_conv(F, P, l, nrows); launder(F); PB_END(3); PB_BEGIN(4);
            if (SUB3 & 2) phase_fft_a(F);
            launder(F); if ((SUB3 & 4) && l == 0) phase_ctx_dft(F); launder(F); PB_END(4); PB_BEGIN(5);
            if (SUB3 & 8) phase_attn(F, P, l);
            PB_END(5);
            SEAM(PB + 2);
        }
        if (EN(4) && IN(PB + 3)) {
            PB_BEGIN(6); launder(F); phase_fft_b(F); PB_END(6);
            PB_BEGIN(7); launder(F); phase_pool(F, nrows);
            launder(F); if (l == 0) phase_ctx_dft_copy(F); PB_END(7);
            SEAM(PB + 3);
        }
        if (EN(5) && IN(PB + 4)) {
            const bool split0 = (l == 0) && (F.nwg == 256);
            SchedMerge S{(const char*)F.proj(), (const char*)(F.wbr() + (size_t)l * DM * WBR_K), ((l == 0 && !split0) ? 264 : 256) * 4, F.nwg, F.wg, false};
            EpiMerge E{F.g8(), F.zm()};
            PB_BEGIN(8); gm::gemm_phase<true>(F.lds, S, E); PB_END(8);
            SEAM(PB + 4);
        }
        if (EN(6) && IN(PB + 5)) {
            const bool split0 = (l == 0) && (F.nwg == 256);
            EpiOut E{xs, prm.out, dcin, dout, modl};
            if (split0) {
                { SchedMerge SM{(const char*)F.proj(), (const char*)(F.wbr() + (size_t)l * DM * WBR_K), 0, F.nwg, F.wg, true};
                  EpiMerge EM{F.g8(), F.zm()};
                  gm::gemm_phase<true>(F.lds, SM, EM);
                  asm volatile("s_waitcnt vmcnt(0)" ::: "memory");
                  __syncthreads();
                  if (F.tid == 0 && F.wg < 32) { __builtin_amdgcn_fence(__ATOMIC_RELEASE, "agent"); (void)xb_add(F.ctl() + CW_CTXM, 1u); } }
            }
            { SchedOut S{(const char*)F.zm(), (const char*)(F.wout() + (size_t)l * DM * DM), (l == 0 ? 264 : 256) * 4, F.nwg, F.wg, split0 ? 1 : 0};
              PB_BEGIN(9); gm::gemm_phase<false>(F.lds, S, E); PB_END(9); }
            if (split0) {
                if (F.tid == 0 && F.wg >= 96 && F.wg < 128) { unsigned* barw = F.ctl() + CW_BAR; XB_SPIN(xb_ld(F.ctl() + CW_CTXM) < 32u, barw); __builtin_amdgcn_fence(__ATOMIC_ACQUIRE, "agent"); }
                __syncthreads();
                SchedOut SC{(const char*)F.zm(), (const char*)(F.wout() + (size_t)l * DM * DM), 0, F.nwg, F.wg, 2};
                gm::gemm_phase<false>(F.lds, SC, E);
            }
            SEAM(PB + 5);
        }
        if (EN(7) && IN(PB + 6)) {
            PB_BEGIN(11); launder(F); phase_norm2_route(F, P, l, nrows, dout); PB_END(11);
            asm volatile("s_waitcnt vmcnt(0)" ::: "memory");
            __syncthreads();
            if (F.tid == 0) { __builtin_amdgcn_fence(__ATOMIC_RELEASE, "agent"); (void)xb_add(F.ctl() + CW_ROUTED + l * 64, 1u); }
            PB_BEGIN(10); launder(F); cvt_experts(F, P, l); PB_END(10);
            if (F.tid == 0) { unsigned* barw = F.ctl() + CW_BAR; XB_SPIN(xb_ld(F.ctl() + CW_ROUTED + l * 64) < (unsigned)F.nwg, barw); __builtin_amdgcn_fence(__ATOMIC_ACQUIRE, "agent"); }
            __syncthreads();
            PB_BEGIN(12); launder(F); phase_positions(F, l, nrows); PB_END(12);
            SEAM(PB + 6);
        }
        if (EN(9) && IN(PB + 8)) {
            launder(F); moe_build_tb(F);
            const int G = F.nwg, c = (G % 8 == 0) ? (F.wg & 7) * (G / 8) + (F.wg >> 3) : F.wg;
            const int nfull = (moe_tb(F)[32] / G) * G, nrem8 = (moe_tb(F)[32] - nfull) * 8;
            unsigned* gudone = F.ctl() + CW_GUDONE + l * 64;
            {
                SchedMoeSplit<true> S2{(const char*)F.H(), (const char*)F.gu(), F.rtok(), moe_tb(F), nfull, G, F.wg};
                EpiMoe E2{(char*)F.acts2(), prm.b_e_gate + (size_t)l * NEXP * DM, prm.b_e_up + (size_t)l * NEXP * DM, prm.b_e_down + (size_t)l * NEXP * DM, F.rtok(), F.rw(), F.Y(), false};
                PB_BEGIN(14); gm::gemm_phase<true>(F.lds, S2, E2); PB_END(14);
                asm volatile("s_waitcnt vmcnt(0)" ::: "memory");
                __syncthreads();
                if (F.tid == 0) {
                    const int mine = (nrem8 > F.wg) ? (nrem8 - F.wg + G - 1) / G : 0;
                    if (mine > 0) { __builtin_amdgcn_fence(__ATOMIC_RELEASE, "agent"); (void)xb_add(gudone, (unsigned)mine); }
                }
            }
            {
                SchedMoeFused S{(const char*)F.H(), (const char*)F.gu(), (const char*)F.dn(), (const char*)F.acts(), F.rtok(), moe_tb(F), nfull, G, c, (unsigned)F.wg * (256u * 2048u)};
                EpiMoe E{(char*)F.acts(), prm.b_e_gate + (size_t)l * NEXP * DM, prm.b_e_up + (size_t)l * NEXP * DM, prm.b_e_down + (size_t)l * NEXP * DM, F.rtok(), F.rw(), F.Y(), true};
                PB_BEGIN(13); gm::gemm_phase<true>(F.lds, S, E); PB_END(13);
            }
            {
                if (F.tid == 0 && (nrem8 >> 1) > (G - 1 - F.wg)) {
                    unsigned* barw = F.ctl() + CW_BAR;
                    XB_SPIN(xb_ld(gudone) < (unsigned)nrem8, barw);
                    __builtin_amdgcn_fence(__ATOMIC_ACQUIRE, "agent");
                }
                __syncthreads();
                SchedMoeSplit<false> S3{(const char*)F.acts2(), (const char*)F.dn(), F.rtok(), moe_tb(F), nfull, G, G - 1 - F.wg};
                EpiMoe E3{(char*)F.acts(), prm.b_e_gate + (size_t)l * NEXP * DM, prm.b_e_up + (size_t)l * NEXP * DM, prm.b_e_down + (size_t)l * NEXP * DM, F.rtok(), F.rw(), F.Y(), false};
                PB_BEGIN(14); gm::gemm_phase<true>(F.lds, S3, E3); PB_END(14);
            }
            SEAM(PB + 8);
        }
    }
    if (EN(11) && IN(NPHASE - 1)) { PB_BEGIN(15); launder(F); phase_final(F, P); PB_END(15); }
#undef IN
#undef SEAM
}

#ifndef N_LAUNCH_MODE
#define N_LAUNCH_MODE 0
#endif
extern "C" void kernel_launch(void* const* d_in, const int* in_sizes, int n_in, void* d_out, int out_size, void* d_ws, size_t ws_size, hipStream_t stream) {
    static int grid = 0;
    if (grid == 0) {
        if (n_in != 27 || out_size != TL * DM || ws_size < WS_END) { fprintf(stderr, "kernel_launch: unexpected shapes (n_in %d out %d ws %zu need %zu)\n", n_in, out_size, ws_size, (size_t)WS_END); grid = -1; return; }
        int dev = 0, cus = 0, per_cu = 0;
        if (hipGetDevice(&dev) != hipSuccess || hipDeviceGetAttribute(&cus, hipDeviceAttributeMultiprocessorCount, dev) != hipSuccess) { grid = -1; return; }
        if (hipFuncSetAttribute((const void*)fwd_kernel, hipFuncAttributeMaxDynamicSharedMemorySize, LDS_BYTES) != hipSuccess) { fprintf(stderr, "kernel_launch: hipFuncSetAttribute failed\n"); grid = -1; return; }
        if (hipOccupancyMaxActiveBlocksPerMultiprocessor(&per_cu, (const void*)fwd_kernel, NTHR, LDS_BYTES) != hipSuccess || per_cu < 1) { fprintf(stderr, "kernel_launch: occupancy query says %d\n", per_cu); }
        (void)hipGetLastError();
        grid = cus;
    }
    if (grid < 0) return;
    (void)hipMemsetAsync((char*)d_ws + WS_CTL, 0, CTL_BYTES, stream);
    Params p{};
    const float** pf = (const float**)&p;
    for (int i = 0; i < 27; ++i) pf[i] = (const float*)d_in[i];
    p.out = (float*)d_out; p.ws = (unsigned char*)d_ws;
#if N_LAUNCH_MODE == 0
    p.ph_lo = 0; p.ph_hi = NPHASE;
    hipLaunchKernelGGL(fwd_kernel, dim3(grid), dim3(NTHR), LDS_BYTES, stream, p);
#else
    for (int ph = 0; ph < NPHASE; ++ph) { p.ph_lo = ph; p.ph_hi = ph + 1; hipLaunchKernelGGL(fwd_kernel, dim3(grid), dim3(NTHR), LDS_BYTES, stream, p); }
#endif
    const hipError_t le = hipPeekAtLastError();
    if (le != hipSuccess) fprintf(stderr, "kernel_launch: launch failed: %s\n", hipGetErrorName(le));
}
```

```cpp
#include <hip/hip_runtime.h>
#include <stdint.h>
#include <stdio.h>

#define LAS __attribute__((address_space(3)))
typedef unsigned short bf16_t;
typedef short bf16x8 __attribute__((ext_vector_type(8)));
typedef short s16x4 __attribute__((ext_vector_type(4)));
typedef float f32x2 __attribute__((ext_vector_type(2)));
typedef float f32x4 __attribute__((ext_vector_type(4)));
typedef float f32x16 __attribute__((ext_vector_type(16)));
typedef unsigned u32x2 __attribute__((ext_vector_type(2)));
typedef unsigned u32x4 __attribute__((ext_vector_type(4)));

constexpr int DM = 1024, NB = 8, SEQ = 8192, CTXL = 256, NLAYER = 2;
constexpr int TL = NB * SEQ;
constexpr int TC = NB * CTXL;
constexpr int TA = TL + TC;
constexpr int INW = 4096;
constexpr int C_Q = 0, C_K = 512, C_V = 1024, C_SX = 1536, C_SB = 2048, C_SC = 2560, C_FX = 3072, C_PX = 3584;
constexpr int NEXP = 32, TOPK = 4;
constexpr int MAXROWS = 4 * TA + NEXP * 256;
constexpr int WBR_K = 2560;
constexpr float EPS = 1e-6f;
constexpr int NTHR = 512;

constexpr size_t al256(size_t x) { return (x + 255) & ~(size_t)255; }
constexpr size_t WS_CTL = 0, CTL_BYTES = 256 * 1024;
constexpr size_t WS_MODS = WS_CTL + CTL_BYTES;
constexpr size_t WS_ROPE = al256(WS_MODS + (size_t)2 * 9 * 6144 * 4);
constexpr size_t WS_TW = al256(WS_ROPE + 2 * 128 * 16 * 4);
constexpr size_t WS_DFT = al256(WS_TW + 128 * 64 * 2 * 4);
constexpr size_t WS_DFT256 = al256(WS_DFT + (size_t)(2 * 128 * 128 + 3 * 64 * 64) * 2);
constexpr size_t WS_LAM = al256(WS_DFT256 + (size_t)2 * 256 * 256 * 2);
constexpr size_t WS_CTXB = al256(WS_LAM + 256);
constexpr size_t WS_WIN = al256(WS_CTXB + (size_t)TC * DM * 4);
constexpr size_t WS_WGATE = al256(WS_WIN + (size_t)2 * INW * DM * 2);
constexpr size_t WS_WBR = al256(WS_WGATE + (size_t)2 * INW * DM * 2);
constexpr size_t WS_WOUT = al256(WS_WBR + (size_t)2 * DM * WBR_K * 2);
constexpr size_t WS_GU = al256(WS_WOUT + (size_t)2 * DM * DM * 2);
constexpr size_t WS_DN = al256(WS_GU + (size_t)NEXP * 2048 * DM * 2);
constexpr size_t WS_ACT2 = al256(WS_DN + (size_t)NEXP * 1024 * DM * 2);
constexpr size_t WS_G8 = WS_GU;
constexpr size_t WS_H = al256(WS_GU + (size_t)TA * INW);
static_assert(WS_ACT2 + (size_t)64 * 256 * 1024 * 2 <= WS_H, "remainder act tiles must fit in the slack of the gate-byte region");
constexpr size_t WS_PROJ = al256(WS_H + (size_t)TA * DM * 2);
constexpr size_t WS_ZM = al256(WS_PROJ + (size_t)TA * INW * 2);
constexpr size_t WS_SELE = al256(WS_ZM + (size_t)TA * DM * 2);
constexpr size_t WS_SELW = al256(WS_SELE + (size_t)TA * 4 * 4);
constexpr size_t WS_RTOK = al256(WS_SELW + (size_t)TA * 4 * 4);
constexpr size_t WS_RW = al256(WS_RTOK + (size_t)MAXROWS * 4);
constexpr size_t WS_CNTW = al256(WS_RW + (size_t)MAXROWS * 4);
constexpr size_t WS_END = al256(WS_CNTW + (size_t)1024 * 32 * 4);
constexpr size_t WS_MST = WS_H;
static_assert((size_t)TA * INW >= (size_t)NEXP * 3 * DM * DM * 2, "experts fit under the gate bytes");
static_assert((size_t)256 * 128 * 512 * 4 <= (size_t)TA * DM * 2, "stash fits in H");
constexpr size_t WS_Y = WS_PROJ;
constexpr size_t WS_ACTS = WS_ZM;
static_assert((size_t)256 * 256 * DM * 2 <= (size_t)TA * DM * 2, "act tiles fit in ZM");

constexpr int CW_BAR = 1024;
constexpr int CW_GUDONE = 6144;
constexpr int CW_CTXM = 6336;
constexpr int CW_ROUTED = 6464;
constexpr int CW_CNT = 8192;

constexpr int LDS_BYTES = 147456;
constexpr int LDS_MISC = 131072 + 12288;

__device__ __forceinline__ unsigned cvt_pk_bf16(float lo, float hi) { unsigned r; asm volatile("v_cvt_pk_bf16_f32 %0, %1, %2" : "=v"(r) : "v"(lo), "v"(hi)); return r; }
__device__ __forceinline__ float bf_lo(unsigned w) { return __uint_as_float(w << 16); }
__device__ __forceinline__ float bf_hi(unsigned w) { return __uint_as_float(w & 0xffff0000u); }
__device__ __forceinline__ float bf2f(bf16_t b) { return __uint_as_float(((unsigned)b) << 16); }
__device__ __forceinline__ bf16_t f2bf(float f) { return (bf16_t)(cvt_pk_bf16(f, 0.f) & 0xffffu); }
template <int CTRL> __device__ __forceinline__ float dpp_f(float v) { return __int_as_float(__builtin_amdgcn_update_dpp(0, __float_as_int(v), CTRL, 0xF, 0xF, true)); }
template <int CTRL> __device__ __forceinline__ int dpp_i(int v) { return __builtin_amdgcn_update_dpp(0, v, CTRL, 0xF, 0xF, true); }
constexpr int DPP_X1 = 0xB1, DPP_X2 = 0x4E, DPP_HMIR = 0x141, DPP_MIR = 0x140;
__device__ __forceinline__ float row16_sum(float v) { v += dpp_f<DPP_X1>(v); v += dpp_f<DPP_X2>(v); v += dpp_f<DPP_HMIR>(v); v += dpp_f<DPP_MIR>(v); return v; }
__device__ __forceinline__ float half32_sum(float v) {
    v = row16_sum(v);
    const auto r = __builtin_amdgcn_permlane16_swap(__float_as_uint(v), __float_as_uint(v), false, false);
    return __uint_as_float(r[0]) + __uint_as_float(r[1]);
}
__device__ __forceinline__ float wave_sum(float v) {
    v = half32_sum(v);
    const auto r = __builtin_amdgcn_permlane32_swap(__float_as_uint(v), __float_as_uint(v), false, false);
    return __uint_as_float(r[0]) + __uint_as_float(r[1]);
}
__device__ __forceinline__ void ld8bf(const bf16_t* p, float (&v)[8]) {
    const u32x4 w = *(const u32x4*)p;
    v[0] = bf_lo(w.x); v[1] = bf_hi(w.x); v[2] = bf_lo(w.y); v[3] = bf_hi(w.y); v[4] = bf_lo(w.z); v[5] = bf_hi(w.z); v[6] = bf_lo(w.w); v[7] = bf_hi(w.w);
}
__device__ __forceinline__ void st8bf(bf16_t* p, const float (&v)[8]) {
    u32x4 w; w.x = cvt_pk_bf16(v[0], v[1]); w.y = cvt_pk_bf16(v[2], v[3]); w.z = cvt_pk_bf16(v[4], v[5]); w.w = cvt_pk_bf16(v[6], v[7]);
    *(u32x4*)p = w;
}

struct Params {
    const float* x; const float* c; const float* ctx; const float* c_ctx; const float* w_ada; const float* b_ada; const float* g_norm1;
    const float* w_in; const float* da_lambda; const float* g_subln; const float* w_conv; const float* w_pool; const float* pool_scale;
    const float* w_branch; const float* w_mgate; const float* b_mgate; const float* w_out; const float* g_norm2; const float* w_router; const float* b_router;
    const float* w_e_gate; const float* b_e_gate; const float* w_e_up; const float* b_e_up; const float* w_e_down; const float* b_e_down; const float* g_final;
    float* out; unsigned char* ws; int ph_lo, ph_hi;
};

#define XB_TMO      128
#define XB_XCNT(j)  (256  + 64 * (j))
#define XB_XSUB(j)  (1280 + 64 * (j))
#define XB_XGEN(j)  (2304 + 64 * (j))
#define XB_TOP      3328
#define XB_TOPGEN   3392
#define XCD_BAR_WORDS 3456
#define XB_SPIN_CAP (1u << 20)
__device__ __forceinline__ unsigned xb_ld(unsigned* p)              { return __hip_atomic_load(p, __ATOMIC_RELAXED, __HIP_MEMORY_SCOPE_AGENT); }
__device__ __forceinline__ unsigned xb_add(unsigned* p, unsigned v) { return __hip_atomic_fetch_add(p, v, __ATOMIC_RELAXED, __HIP_MEMORY_SCOPE_AGENT); }
__device__ __forceinline__ unsigned xb_xcc_id() { return (unsigned)__builtin_amdgcn_s_getreg((3 << 11) | 20) & 0xFu; }
#define XB_SPIN(cond, bar) do { unsigned _sp = 0; while (cond) { __builtin_amdgcn_s_sleep(1); \
    if ((++_sp & 255u) == 0u) { if (xb_ld(&(bar)[XB_TMO])) break; if (_sp > XB_SPIN_CAP) { atomicAdd(&(bar)[XB_TMO], 1u); break; } } } } while (0)
struct XcdBarrier { unsigned* bar; unsigned x; volatile LAS unsigned* st; };
__device__ __forceinline__ XcdBarrier xcd_barrier_post(unsigned* bar, volatile LAS unsigned* st) {
    XcdBarrier b; b.bar = bar; b.x = xb_xcc_id(); b.st = st;
    if (threadIdx.x == 0) (void)xb_add(&bar[XB_XCNT(b.x)], 1u);
    return b;
}
__device__ __forceinline__ void xcd_barrier_complete(unsigned* bar, unsigned x, unsigned& nloc, unsigned& nx) {
    const unsigned G = gridDim.x * gridDim.y * gridDim.z;
    unsigned sum, cnt, mine, sp = 0u;
    for (;;) {
        sum = 0u; cnt = 0u; mine = 0u;
#pragma unroll
        for (unsigned j = 0; j < 16; ++j) { const unsigned c = xb_ld(&bar[XB_XCNT(j)]); sum += c; cnt += (c > 0u) ? 1u : 0u; mine = (j == x) ? c : mine; }
        if (sum == G) break;
        __builtin_amdgcn_s_sleep(1);
        if ((++sp & 255u) == 0u) { if (xb_ld(&bar[XB_TMO])) break; if (sp > XB_SPIN_CAP) { atomicAdd(&bar[XB_TMO], 1u); break; } }
    }
    nloc = mine > 0u ? mine : 1u; nx = cnt > 0u ? cnt : 1u;
}
__device__ __forceinline__ void xcd_barrier(const XcdBarrier& b) {
    asm volatile("s_waitcnt vmcnt(0)" ::: "memory");
    __syncthreads();
    if (threadIdx.x == 0) {
        unsigned long long barw = (unsigned long long)b.bar;
        asm volatile("" : "+s"(barw));
        unsigned* bar = (unsigned*)(__attribute__((address_space(1))) unsigned*)barw;
        __builtin_amdgcn_s_waitcnt(0);
        unsigned nloc = b.st[0], nx = b.st[1];
        if (nloc == 0u) { xcd_barrier_complete(bar, b.x, nloc, nx); b.st[0] = nloc; b.st[1] = nx; }
        const unsigned old = xb_add(&bar[XB_XSUB(b.x)], 1u);
        const unsigned gen = old / nloc;
        if (old + 1u == (gen + 1u) * nloc) {
            __builtin_amdgcn_fence(__ATOMIC_RELEASE, "agent");
            asm volatile("s_waitcnt vmcnt(0)" ::: "memory");
            const unsigned og = xb_add(&bar[XB_TOP], 1u);
            const unsigned tg = og / nx;
            if (og + 1u == (tg + 1u) * nx) xb_add(&bar[XB_TOPGEN], 1u);
            else XB_SPIN(xb_ld(&bar[XB_TOPGEN]) == tg, bar);
            __builtin_amdgcn_fence(__ATOMIC_ACQUIRE, "agent");
            xb_add(&bar[XB_XGEN(b.x)], 1u);
            asm volatile("s_waitcnt vmcnt(0)" ::: "memory");
        } else {
            XB_SPIN(xb_ld(&bar[XB_XGEN(b.x)]) == gen, bar);
            __builtin_amdgcn_fence(__ATOMIC_ACQUIRE, "agent");
            asm volatile("s_waitcnt vmcnt(0)" ::: "memory");
        }
    }
    __syncthreads();
}

struct Frame {
    int tid, lane, wid, wg, nwg;
    LAS unsigned char* lds;
    unsigned char* ws;
    __device__ __forceinline__ unsigned* ctl() const { return (unsigned*)(ws + WS_CTL); }
    __device__ __forceinline__ float* mods() const { return (float*)(ws + WS_MODS); }
    __device__ __forceinline__ float* rope() const { return (float*)(ws + WS_ROPE); }
    __device__ __forceinline__ float* tw() const { return (float*)(ws + WS_TW); }
    __device__ __forceinline__ bf16_t* dft() const { return (bf16_t*)(ws + WS_DFT); }
    __device__ __forceinline__ float* lam() const { return (float*)(ws + WS_LAM); }
    __device__ __forceinline__ float* ctxb() const { return (float*)(ws + WS_CTXB); }
    __device__ __forceinline__ bf16_t* win() const { return (bf16_t*)(ws + WS_WIN); }
    __device__ __forceinline__ bf16_t* wgate() const { return (bf16_t*)(ws + WS_WGATE); }
    __device__ __forceinline__ bf16_t* wbr() const { return (bf16_t*)(ws + WS_WBR); }
    __device__ __forceinline__ bf16_t* wout() const { return (bf16_t*)(ws + WS_WOUT); }
    __device__ __forceinline__ bf16_t* gu() const { return (bf16_t*)(ws + WS_GU); }
    __device__ __forceinline__ bf16_t* dn() const { return (bf16_t*)(ws + WS_DN); }
    __device__ __forceinline__ bf16_t* H() const { return (bf16_t*)(ws + WS_H); }
    __device__ __forceinline__ bf16_t* proj() const { return (bf16_t*)(ws + WS_PROJ); }
    __device__ __forceinline__ bf16_t* zm() const { return (bf16_t*)(ws + WS_ZM); }
    __device__ __forceinline__ bf16_t* act() const { return (bf16_t*)(ws + WS_PROJ); }
    __device__ __forceinline__ int* sele() const { return (int*)(ws + WS_SELE); }
    __device__ __forceinline__ float* selw() const { return (float*)(ws + WS_SELW); }
    __device__ __forceinline__ int* rtok() const { return (int*)(ws + WS_RTOK); }
    __device__ __forceinline__ float* rw() const { return (float*)(ws + WS_RW); }
    __device__ __forceinline__ bf16_t* dft256() const { return (bf16_t*)(ws + WS_DFT256); }
    __device__ __forceinline__ int* cntw() const { return (int*)(ws + WS_CNTW); }
    __device__ __forceinline__ bf16_t* Y() const { return (bf16_t*)(ws + WS_Y); }
    __device__ __forceinline__ bf16_t* acts() const { return (bf16_t*)(ws + WS_ACTS); }
    __device__ __forceinline__ bf16_t* acts2() const { return (bf16_t*)(ws + WS_ACT2); }
    __device__ __forceinline__ unsigned char* g8() const { return ws + WS_G8; }
    __device__ __forceinline__ float* mst() const { return (float*)(ws + WS_MST) + (size_t)wg * 128 * NTHR; }
};

__device__ __forceinline__ int qk_rowmap(int n) {
    if (n >= 1024) return n;
    const int g = n & ~31, d = n & 31;
    const int p = d < 16 ? 8 * (d >> 2) + (d & 3) : 8 * ((d - 16) >> 2) + 4 + (d & 3);
    return g + p;
}
__device__ __forceinline__ int gu_rowmap(int c, int up) { return 32 * (c >> 4) + 8 * ((c & 15) >> 2) + (c & 3) + 4 * up; }

template <int MODE>
__device__ __forceinline__ void cvt_tile(const Frame& F, const float* __restrict__ src, int src_ld, int k0, int n0, bf16_t* __restrict__ dst, int dst_ld, int dst_k0) {
    LAS float* tile = (LAS float*)F.lds;
#pragma unroll
    for (int q = 0; q < 2; ++q) {
        const int idx = F.tid + q * NTHR, r = idx >> 4, c4 = idx & 15;
        const f32x4 v = *(const f32x4*)(src + (size_t)(k0 + r) * src_ld + n0 + c4 * 4);
        tile[r * 65 + c4 * 4 + 0] = v[0]; tile[r * 65 + c4 * 4 + 1] = v[1]; tile[r * 65 + c4 * 4 + 2] = v[2]; tile[r * 65 + c4 * 4 + 3] = v[3];
    }
    __syncthreads();
    {
        const int n = F.tid >> 3, kc = F.tid & 7;
        float v[8];
#pragma unroll
        for (int j = 0; j < 8; ++j) v[j] = tile[(kc * 8 + j) * 65 + n];
        int row = n0 + n;
        if (MODE == 1) row = qk_rowmap(row);
        if (MODE == 2) row = gu_rowmap(row, 0);
        if (MODE == 3) row = gu_rowmap(row, 1);
        st8bf(dst + (size_t)row * dst_ld + dst_k0 + k0 + kc * 8, v);
    }
    __syncthreads();
}

__device__ __forceinline__ void p0_mods(const Frame& F, const Params& P, int item) {
    LAS float* sl = (LAS float*)F.lds;
    LAS float* red = sl + 9 * 1024;
    for (int i = F.tid; i < 9 * 1024; i += NTHR) {
        const int r = i >> 10, d = i & 1023;
        const float v = (r < 8) ? P.c[r * 1024 + d] : P.c_ctx[d];
        sl[i] = v / (1.f + __expf(-v));
    }
    __syncthreads();
    const int col0 = item * 128, l = col0 / 6144, j0 = col0 % 6144;
    const int cq = F.tid & 31, ds = F.tid >> 5;
    f32x4 acc[9];
#pragma unroll
    for (int r = 0; r < 9; ++r) acc[r] = (f32x4){0.f, 0.f, 0.f, 0.f};
    const float* w = P.w_ada + (size_t)l * 1024 * 6144 + j0 + cq * 4;
#pragma unroll 16
    for (int i = 0; i < 64; ++i) {
        const int d = ds * 64 + i;
        const f32x4 wv = __builtin_nontemporal_load((const f32x4*)(w + (size_t)d * 6144));
#pragma unroll
        for (int r = 0; r < 9; ++r) acc[r] += wv * sl[r * 1024 + d];
    }
#pragma unroll
    for (int r = 0; r < 9; ++r) {
#pragma unroll
        for (int q = 0; q < 4; ++q) red[(ds * 9 + r) * 128 + cq * 4 + q] = acc[r][q];
    }
    __syncthreads();
    for (int i = F.tid; i < 9 * 128; i += NTHR) {
        const int r = i >> 7, c = i & 127;
        float s = 0.f;
#pragma unroll
        for (int k = 0; k < 16; ++k) s += red[(k * 9 + r) * 128 + c];
        F.mods()[(size_t)(l * 9 + r) * 6144 + j0 + c] = s + P.b_ada[l * 6144 + j0 + c];
    }
    __syncthreads();
}

__device__ __forceinline__ void p0_fold(const Frame& F, const Params& P, int item) {
    const int l = item / 192, rem = item % 192, which = rem / 64, c8 = rem % 64;
    const int cbase = c8 * 8, g = cbase >> 7, cl = cbase & 127;
    LAS float* coef = (LAS float*)F.lds;
    for (int i = F.tid; i < 1024; i += NTHR) {
        const int cp = i >> 3, j = i & 7, c = cl + j;
        float v;
        if (which == 2) v = P.w_pool[((size_t)(l * 4 + g) * 128 + c) * 128 + cp] * P.pool_scale[l * 512 + g * 128 + cp];
        else { float sn, cs; sincospif(2.f * (float)((c * cp) & 127) / 128.f, &sn, &cs); v = (which == 0 ? cs : -sn) * 0.08838834764831845f; }
        coef[i] = v;
    }
    __syncthreads();
    const float* wb = P.w_branch + ((size_t)(l * 4 + (which == 2 ? 3 : 2)) * 512 + g * 128) * 1024;
    const int kofs = (which == 0 ? 1024 : which == 1 ? 1536 : 2048) + cbase;
    {
        float acc0[8], acc1[8];
#pragma unroll
        for (int j = 0; j < 8; ++j) { acc0[j] = 0.f; acc1[j] = 0.f; }
#pragma unroll 1
        for (int cp0 = 0; cp0 < 128; cp0 += 16) {
            float w0[16], w1[16];
#pragma unroll
            for (int q = 0; q < 16; ++q) { w0[q] = wb[(size_t)(cp0 + q) * 1024 + F.tid]; w1[q] = wb[(size_t)(cp0 + q) * 1024 + F.tid + NTHR]; }
#pragma unroll
            for (int q = 0; q < 16; ++q)
#pragma unroll
                for (int j = 0; j < 8; ++j) { const float cf = coef[(cp0 + q) * 8 + j]; acc0[j] += cf * w0[q]; acc1[j] += cf * w1[q]; }
        }
        st8bf(F.wbr() + ((size_t)l * 1024 + F.tid) * WBR_K + kofs, acc0);
        st8bf(F.wbr() + ((size_t)l * 1024 + F.tid + NTHR) * WBR_K + kofs, acc1);
    }
    __syncthreads();
}

__device__ __forceinline__ void p0_tables(const Frame& F, const Params& P, int item) {
    const int idx = item * NTHR + F.tid;
    if (idx < 2048) {
        const int pos = idx >> 4, i = idx & 15;
        const float inv = powf(10000.f, -(float)(2 * i) / 32.f);
        const float ang = (float)pos * inv;
        F.rope()[idx] = cosf(ang); F.rope()[2048 + idx] = sinf(ang);
    }
    if (idx < 8192) {
        const int k1 = idx >> 6, n2 = idx & 63;
        float sn, cs; sincospif(2.f * (float)(k1 * n2) / 8192.f, &sn, &cs);
        F.tw()[idx * 2] = cs; F.tw()[idx * 2 + 1] = sn;
    }
    if (idx < 16384) {
        const int k = idx >> 7, n = idx & 127;
        float sn, cs; sincospif(2.f * (float)((k * n) & 127) / 128.f, &sn, &cs);
        F.dft()[idx] = f2bf(cs); F.dft()[16384 + idx] = f2bf(sn);
    }
    if (idx < 4096) {
        const int k = idx >> 6, n = idx & 63;
        float sn, cs; sincospif(2.f * (float)((k * n) & 63) / 64.f, &sn, &cs);
        F.dft()[32768 + idx] = f2bf(cs); F.dft()[32768 + 4096 + idx] = f2bf(sn); F.dft()[32768 + 8192 + idx] = f2bf(-sn);
    }
    if (idx < 2) {
        const float* lm = P.da_lambda + idx * 256;
        float s1 = 0.f, s2 = 0.f;
        for (int i = 0; i < 64; ++i) { s1 += lm[i] * lm[64 + i]; s2 += lm[128 + i] * lm[192 + i]; }
        const float lam_init = 0.8f - 0.6f * expf(-0.3f * (float)idx);
        F.lam()[idx] = expf(s1) - expf(s2) + lam_init;
    }
}

__device__ __forceinline__ void p0_prologue(const Frame& F, const Params& P) {
    for (int it = F.wg; it < 96 + 384 + 64; it += F.nwg) {
        if (it < 96) p0_mods(F, P, it);
        else if (it < 480) { const int f = it - 96; p0_fold(F, P, (f & 7) * 48 + (f >> 3)); }
        else p0_tables(F, P, it - 480);
    }
    for (int idx = F.wg * NTHR + F.tid; idx < 65536; idx += F.nwg * NTHR) {
        const int k = idx >> 8, n = idx & 255;
        float sn, cs; sincospif(2.f * (float)((k * n) & 255) / 256.f, &sn, &cs);
        F.dft256()[idx] = f2bf(cs); F.dft256()[65536 + idx] = f2bf(sn);
    }
    for (size_t i = (size_t)F.wg * NTHR + F.tid; i < (size_t)TC * DM / 4; i += (size_t)F.nwg * NTHR) ((f32x4*)F.ctxb())[i] = ((const f32x4*)P.ctx)[i];
    {
        constexpr int NWS = 2 * 640, TP = 257;
#define WS_DESC(it, src, sld, k0, n0) do { const int _l = (it) / 640; int _r = (it) % 640; \
            if (_r < 256) { src = P.w_in + (size_t)_l * DM * INW; sld = INW; k0 = (_r >> 4) * 64; n0 = (_r & 15) * 256; } \
            else if (_r < 512) { _r -= 256; src = P.w_mgate + (size_t)_l * DM * INW; sld = INW; k0 = (_r >> 4) * 64; n0 = (_r & 15) * 256; } \
            else if (_r < 576) { _r -= 512; src = P.w_out + (size_t)_l * DM * DM; sld = DM; k0 = (_r >> 2) * 64; n0 = (_r & 3) * 256; } \
            else { _r -= 576; const int _k = _r >> 5; _r &= 31; src = P.w_branch + (size_t)(_l * 4 + _k) * 512 * 1024; sld = 1024; k0 = (_r >> 2) * 64; n0 = (_r & 3) * 256; } } while (0)
#define WS_LOAD(it) do { const float* _s; int _sld, _k0, _n0; WS_DESC(it, _s, _sld, _k0, _n0); \
            _Pragma("unroll") for (int _q = 0; _q < 8; ++_q) { const int _i = F.tid + _q * NTHR; wv[_q] = __builtin_nontemporal_load((const f32x4*)(_s + (size_t)(_k0 + (_i >> 6)) * _sld + _n0 + (_i & 63) * 4)); } } while (0)
        LAS float* tile = (LAS float*)F.lds;
        f32x4 wv[8];
        int it = F.wg, par = 0;
        if (it < NWS) WS_LOAD(it);
        for (; it < NWS; it += F.nwg, par ^= 1) {
            LAS float* tl = tile + par * (64 * TP);
#pragma unroll
            for (int q = 0; q < 8; ++q) { const int i = F.tid + q * NTHR, r = i >> 6, c = (i & 63) * 4; tl[r * TP + c] = wv[q][0]; tl[r * TP + c + 1] = wv[q][1]; tl[r * TP + c + 2] = wv[q][2]; tl[r * TP + c + 3] = wv[q][3]; }
            __syncthreads();
            if (it + F.nwg < NWS) WS_LOAD(it + F.nwg);
            const int l = it / 640; int r = it % 640;
            bf16_t* dst; int dld, k0, n0, kofs = 0; bool qk = false;
            if (r < 256) { dst = F.win() + (size_t)l * INW * DM; dld = DM; k0 = (r >> 4) * 64; n0 = (r & 15) * 256; qk = true; }
            else if (r < 512) { r -= 256; dst = F.wgate() + (size_t)l * INW * DM; dld = DM; k0 = (r >> 4) * 64; n0 = (r & 15) * 256; }
            else if (r < 576) { r -= 512; dst = F.wout() + (size_t)l * DM * DM; dld = DM; k0 = (r >> 2) * 64; n0 = (r & 3) * 256; }
            else { r -= 576; const int k = r >> 5; r &= 31; dst = F.wbr() + (size_t)l * 1024 * WBR_K; dld = WBR_K; k0 = (r >> 2) * 64; n0 = (r & 3) * 256; kofs = k * 512; }
#pragma unroll
            for (int q = 0; q < 4; ++q) {
                const int p = F.tid + q * NTHR, n = p >> 3, kc = p & 7;
                float o[8];
#pragma unroll
                for (int j = 0; j < 8; ++j) o[j] = tl[(kc * 8 + j) * TP + n];
                const int row = qk ? qk_rowmap(n0 + n) : (n0 + n);
                st8bf(dst + (size_t)row * dld + kofs + k0 + kc * 8, o);
            }
        }
        __syncthreads();
#undef WS_DESC
#undef WS_LOAD
    }
}

__device__ __forceinline__ void cvt_experts(const Frame& F, const Params& P, int l) {
    constexpr int NS = NEXP * 3 * 64, TP = 257;
    LAS float* tile = (LAS float*)F.lds;
    f32x4 v[8];
#define CE_SRC(s, base, k0, n0) do { const int _e = (s) / 192, _r = (s) % 192, _w = _r >> 6, _t = _r & 63; k0 = (_t >> 2) * 64; n0 = (_t & 3) * 256; \
        base = (_w == 0 ? P.w_e_gate : _w == 1 ? P.w_e_up : P.w_e_down) + ((size_t)l * NEXP + _e) * DM * DM; } while (0)
#define CE_LOAD(s) do { const float* _b; int _k0, _n0; CE_SRC(s, _b, _k0, _n0); \
        _Pragma("unroll") for (int _q = 0; _q < 8; ++_q) { const int _i = F.tid + _q * NTHR; v[_q] = *(const f32x4*)(_b + (size_t)(_k0 + (_i >> 6)) * DM + _n0 + (_i & 63) * 4); } } while (0)
    int s = F.wg, par = 0;
    if (s < NS) CE_LOAD(s);
    for (; s < NS; s += F.nwg, par ^= 1) {
        LAS float* tl = tile + par * (64 * TP);
#pragma unroll
        for (int q = 0; q < 8; ++q) { const int i = F.tid + q * NTHR, r = i >> 6, c = (i & 63) * 4; tl[r * TP + c] = v[q][0]; tl[r * TP + c + 1] = v[q][1]; tl[r * TP + c + 2] = v[q][2]; tl[r * TP + c + 3] = v[q][3]; }
        __syncthreads();
        if (s + F.nwg < NS) CE_LOAD(s + F.nwg);
        const int e = s / 192, r = s % 192, w = r >> 6, t = r & 63, k0 = (t >> 2) * 64, n0 = (t & 3) * 256;
        bf16_t* dst = (w == 2) ? F.dn() + (size_t)e * DM * DM : F.gu() + (size_t)e * 2048 * DM;
#pragma unroll
        for (int q = 0; q < 4; ++q) {
            const int p = F.tid + q * NTHR, n = p >> 3, kc = p & 7;
            float o[8];
#pragma unroll
            for (int j = 0; j < 8; ++j) o[j] = tl[(kc * 8 + j) * TP + n];
            const int row = (w == 2) ? (n0 + n) : gu_rowmap(n0 + n, w);
            st8bf(dst + (size_t)row * DM + k0 + kc * 8, o);
        }
    }
#undef CE_SRC
#undef CE_LOAD
    __syncthreads();
}

__device__ __forceinline__ const float* xrow_ptr(const float* xs, long long dctx, int row) { return xs + (size_t)row * DM + (row >= TL ? dctx : 0ll); }
__device__ __forceinline__ void phase_norm1(const Frame& F, const Params& P, int l, const float* xs, long long dctx, bool combine, float* xw, long long dctxw) {
    const float* g = P.g_norm1 + l * DM;
    for (int row = F.wg * 8 + F.wid; row < TA; row += F.nwg * 8) {
        const float* xr = xrow_ptr(xs, dctx, row);
        const int b = row < TL ? (row >> 13) : 8;
        const float* md = F.mods() + (size_t)(l * 9 + b) * 6144;
        f32x4 v[4]; float ss = 0.f;
#pragma unroll
        for (int j = 0; j < 4; ++j) v[j] = *(const f32x4*)(xr + F.lane * 4 + 256 * j);
        if (combine) {
            const float* g5 = F.mods() + (size_t)((l - 1) * 9 + b) * 6144 + 5 * 1024;
            const bf16_t* yr = F.Y() + (size_t)row * 4 * DM;
            float* xo = xw + (size_t)row * DM + (row >= TL ? dctxw : 0ll);
#pragma unroll
            for (int j = 0; j < 4; ++j) {
                const int col = F.lane * 4 + 256 * j;
                f32x4 s = (f32x4){0.f, 0.f, 0.f, 0.f};
#pragma unroll
                for (int k = 0; k < 4; ++k) { const u32x2 w = __builtin_nontemporal_load((const u32x2*)(yr + (size_t)k * DM + col));     s[0] += bf_lo(w.x); s[1] += bf_hi(w.x); s[2] += bf_lo(w.y); s[3] += bf_hi(w.y); }
                v[j] += *(const f32x4*)(g5 + col) * s;
                *(f32x4*)(xo + col) = v[j];
            }
        }
#pragma unroll
        for (int j = 0; j < 4; ++j) ss += v[j][0] * v[j][0] + v[j][1] * v[j][1] + v[j][2] * v[j][2] + v[j][3] * v[j][3];
        ss = wave_sum(ss);
        const float rstd = rsqrtf(ss * (1.f / 1024.f) + EPS);
#pragma unroll
        for (int j = 0; j < 4; ++j) {
            const int col = F.lane * 4 + 256 * j;
            const f32x4 gg = *(const f32x4*)(g + col), sh = *(const f32x4*)(md + col), sc = *(const f32x4*)(md + 1024 + col);
            float o[4];
#pragma unroll
            for (int i = 0; i < 4; ++i) o[i] = v[j][i] * rstd * gg[i] * (1.f + sc[i]) + sh[i];
            u32x2 w; w.x = cvt_pk_bf16(o[0], o[1]); w.y = cvt_pk_bf16(o[2], o[3]);
            *(u32x2*)(F.H() + (size_t)row * DM + col) = w;
        }
    }
}

__device__ __forceinline__ void phase_final(const Frame& F, const Params& P) {
    for (int row = F.wg * 8 + F.wid; row < TL; row += F.nwg * 8) {
        float* xr = P.out + (size_t)row * DM;
        const float* g5 = F.mods() + (size_t)((NLAYER - 1) * 9 + (row >> 13)) * 6144 + 5 * 1024;
        const bf16_t* yr = F.Y() + (size_t)row * 4 * DM;
        f32x4 v[4]; float ss = 0.f;
#pragma unroll
        for (int j = 0; j < 4; ++j) {
            const int col = F.lane * 4 + 256 * j;
            v[j] = *(const f32x4*)(xr + col);
            f32x4 s = (f32x4){0.f, 0.f, 0.f, 0.f};
#pragma unroll
            for (int k = 0; k < 4; ++k) { const u32x2 w = __builtin_nontemporal_load((const u32x2*)(yr + (size_t)k * DM + col));     s[0] += bf_lo(w.x); s[1] += bf_hi(w.x); s[2] += bf_lo(w.y); s[3] += bf_hi(w.y); }
            v[j] += *(const f32x4*)(g5 + col) * s;
            ss += v[j][0] * v[j][0] + v[j][1] * v[j][1] + v[j][2] * v[j][2] + v[j][3] * v[j][3];
        }
        ss = wave_sum(ss);
        const float rstd = rsqrtf(ss * (1.f / 1024.f) + EPS);
#pragma unroll
        for (int j = 0; j < 4; ++j) {
            const int col = F.lane * 4 + 256 * j;
            const f32x4 gg = *(const f32x4*)(P.g_final + col);
            f32x4 o;
#pragma unroll
            for (int i = 0; i < 4; ++i) o[i] = v[j][i] * rstd * gg[i];
            *(f32x4*)(xr + col) = o;
        }
    }
}

__device__ __forceinline__ void seq_of(int row, int& s, int& n) { if (row < TL) { s = row & (SEQ - 1); n = SEQ; } else { s = (row - TL) & (CTXL - 1); n = CTXL; } }

__device__ __forceinline__ void phase_conv(const Frame& F, const Params& P, int l, int nrows) {
    const float* wc = P.w_conv + l * 3 * 512;
    for (size_t idx = (size_t)F.wg * NTHR + F.tid; idx < (size_t)(nrows / 4) * 64; idx += (size_t)F.nwg * NTHR) {
        const int row0 = (int)(idx >> 6) * 4, ch = (int)(idx & 63) * 8;
        int s0, n; seq_of(row0, s0, n);
        const char* pb = (const char*)F.proj();
        const unsigned off0 = (unsigned)(row0 * INW + ch) * 2u;
        u32x4 rx[6], rc[6], rb[4];
#pragma unroll
        for (int i = 0; i < 6; ++i) {
            const int s = s0 - 1 + i; const bool ok = s >= 0 && s < n; const unsigned o = off0 + (ok ? (unsigned)((i - 1) * INW * 2) : 0u);
            rx[i] = *(const u32x4*)(pb + (size_t)(o + C_SX * 2)); rc[i] = *(const u32x4*)(pb + (size_t)(o + C_SC * 2));
        }
#pragma unroll
        for (int i = 0; i < 4; ++i) rb[i] = *(const u32x4*)(pb + (size_t)(off0 + (unsigned)(i * INW * 2 + C_SB * 2)));
        bf16_t* base = F.proj() + (size_t)row0 * INW;
        float w0[8], w1[8], w2[8];
#pragma unroll
        for (int j = 0; j < 8; ++j) { w0[j] = wc[ch + j]; w1[j] = wc[512 + ch + j]; w2[j] = wc[1024 + ch + j]; }
        float u[6][8];
#pragma unroll
        for (int i = 0; i < 6; ++i) {
            const int s = s0 - 1 + i; const float z = (s >= 0 && s < n) ? 1.f : 0.f;
            u[i][0] = bf_lo(rx[i].x) * bf_lo(rc[i].x) * z; u[i][1] = bf_hi(rx[i].x) * bf_hi(rc[i].x) * z; u[i][2] = bf_lo(rx[i].y) * bf_lo(rc[i].y) * z; u[i][3] = bf_hi(rx[i].y) * bf_hi(rc[i].y) * z;
            u[i][4] = bf_lo(rx[i].z) * bf_lo(rc[i].z) * z; u[i][5] = bf_hi(rx[i].z) * bf_hi(rc[i].z) * z; u[i][6] = bf_lo(rx[i].w) * bf_lo(rc[i].w) * z; u[i][7] = bf_hi(rx[i].w) * bf_hi(rc[i].w) * z;
        }
#pragma unroll
        for (int i = 0; i < 4; ++i) {
            float bb[8], y[8];
            bb[0] = bf_lo(rb[i].x); bb[1] = bf_hi(rb[i].x); bb[2] = bf_lo(rb[i].y); bb[3] = bf_hi(rb[i].y); bb[4] = bf_lo(rb[i].z); bb[5] = bf_hi(rb[i].z); bb[6] = bf_lo(rb[i].w); bb[7] = bf_hi(rb[i].w);
#pragma unroll
            for (int j = 0; j < 8; ++j) y[j] = bb[j] * (w0[j] * u[i][j] + w1[j] * u[i + 1][j] + w2[j] * u[i + 2][j]);
            st8bf(base + (ptrdiff_t)i * INW + C_SB + ch, y);
        }
    }
}

template <int HW>
__device__ __forceinline__ void pool_group(const Frame& F, int nrows, int g, size_t idx) {
    constexpr int NR = 8 + 2 * HW - 1;
    {
        const int row0 = (int)(idx >> 4) * 8, ch = g * 128 + (int)(idx & 15) * 8;
        int s0, n; seq_of(row0, s0, n);
        const char* pb = (const char*)F.proj();
        const unsigned off0 = (unsigned)(row0 * INW + C_PX + ch) * 2u;
        u32x4 rx[NR];
#pragma unroll
        for (int i = 0; i < NR; ++i) {
            const int s = s0 - HW + i; const bool ok = s >= 0 && s < n;
            rx[i] = *(const u32x4*)(pb + (size_t)(off0 + (ok ? (unsigned)((i - HW) * INW * 2) : 0u)));
            if (!ok) rx[i] = (u32x4){0u, 0u, 0u, 0u};
        }
        float w[8];
#pragma unroll
        for (int j = 0; j < 8; ++j) w[j] = 0.f;
#pragma unroll
        for (int i = 0; i < 2 * HW; ++i) { w[0] += bf_lo(rx[i].x); w[1] += bf_hi(rx[i].x); w[2] += bf_lo(rx[i].y); w[3] += bf_hi(rx[i].y); w[4] += bf_lo(rx[i].z); w[5] += bf_hi(rx[i].z); w[6] += bf_lo(rx[i].w); w[7] += bf_hi(rx[i].w); }
#pragma unroll
        for (int t = 0; t < 8; ++t) {
            const int s = s0 + t, lo = max(s - HW, 0), hi = min(s + HW, n);
            const float ic = 1.f / (float)(hi - lo);
            u32x4 xc = rx[t + HW];
            asm volatile("" : "+v"(xc));
            float y[8];
            y[0] = w[0] * ic - bf_lo(xc.x); y[1] = w[1] * ic - bf_hi(xc.x); y[2] = w[2] * ic - bf_lo(xc.y); y[3] = w[3] * ic - bf_hi(xc.y);
            y[4] = w[4] * ic - bf_lo(xc.z); y[5] = w[5] * ic - bf_hi(xc.z); y[6] = w[6] * ic - bf_lo(xc.w); y[7] = w[7] * ic - bf_hi(xc.w);
            st8bf(F.proj() + (size_t)(row0 + t) * INW + C_FX + ch, y);
            if (t < 7) {
                u32x4 a = rx[t + 2 * HW], d = rx[t];
                asm volatile("" : "+v"(a), "+v"(d));
                w[0] += bf_lo(a.x) - bf_lo(d.x); w[1] += bf_hi(a.x) - bf_hi(d.x); w[2] += bf_lo(a.y) - bf_lo(d.y); w[3] += bf_hi(a.y) - bf_hi(d.y);
                w[4] += bf_lo(a.z) - bf_lo(d.z); w[5] += bf_hi(a.z) - bf_hi(d.z); w[6] += bf_lo(a.w) - bf_lo(d.w); w[7] += bf_hi(a.w) - bf_hi(d.w);
            }
        }
    }
}
__device__ __forceinline__ void phase_pool(const Frame& F, int nrows) {
    const size_t nit = (size_t)(nrows / 8) * 16 / 64;
    int it = 0;
    for (size_t base = (size_t)F.wg * 2 + (F.wid >> 2); base < nit; base += (size_t)F.nwg * 2, ++it) {
        const int g = __builtin_amdgcn_readfirstlane((F.wid + it) & 3);
        const size_t idx = base * 64 + F.lane;
        if (g == 0) pool_group<1>(F, nrows, 0, idx); else if (g == 1) pool_group<2>(F, nrows, 1, idx); else if (g == 2) pool_group<4>(F, nrows, 2, idx); else pool_group<8>(F, nrows, 3, idx);
    }
}

__device__ __forceinline__ void phase_ctx_dft_copy(const Frame& F) {
    for (size_t idx = (size_t)F.wg * NTHR + F.tid; idx < (size_t)TC * 128; idx += (size_t)F.nwg * NTHR) {
        const int r = (int)(idx >> 7), c = (int)(idx & 127) * 8;
        *(u32x4*)(F.proj() + (size_t)(TL + r) * INW + C_K + c) = *(const u32x4*)(F.zm() + (size_t)(TL + r) * DM + c);
    }
}

namespace gm {
constexpr int BM = 256, BK = 64, HALF = 128, HTB = HALF * BK * 2, STAGE_BYTES = 8 * HTB;
__device__ __forceinline__ int lds_byte(int r, int c) { const int st = (r >> 4) * 2 + (c >> 5), rr = r & 15, cc = c & 31, ob = rr * 64 + cc * 2; return st * 1024 + (ob ^ (((ob >> 9) & 1) << 5)); }
__device__ __forceinline__ void stage_rc(int b, int& R, int& C) { const int st = b / 1024, sb = b % 1024, swz = sb ^ (((sb >> 9) & 1) << 5); R = (st >> 1) * 16 + swz / 64; C = (st & 1) * 32 + (swz % 64) / 2; }
__device__ __forceinline__ int perm32(int rho) { const int n = rho >> 4, i = rho & 15; return 8 * (i >> 2) + 4 * n + (i & 3); }

struct GUnit {
    const char* A;
    const char* B;
    const int* gidx;
    unsigned lda, ldb;
    int nt;
    int pm, pn, sub, e;
    unsigned aux;
};

template <bool PERM, class Epi, class Sched>
__device__ __forceinline__ void gemm_phase(LAS unsigned char* lds, const Sched& S, const Epi& E) {
    int tid = threadIdx.x; asm volatile("" : "+v"(tid));
    const int wid = __builtin_amdgcn_readfirstlane(tid >> 6), lane = tid & 63, wr = wid >> 2, wc = wid & 3, fr = lane & 15, fq = lane >> 4;
    const unsigned ldsw = (unsigned)wid * 1024u;
    const int aoff = lds_byte(wr * 64 + fr, fq * 8), boff = lds_byte(wc * 32 + fr, fq * 8);
    const size_t kstep = (size_t)(BK * 2);
#define G_SA(b, h) (((b) * 2 + (h)) * gm::HTB)
#define G_SB(b, h) ((4 + (b) * 2 + (h)) * gm::HTB)
#define G_STAGE2(bufoff, gbase, v0, v1) do { \
        __builtin_amdgcn_global_load_lds((const unsigned*)((const char*)(gbase) + (v0)), (LAS unsigned*)(lds + (bufoff) + ldsw), 16, 0, 0); \
        __builtin_amdgcn_global_load_lds((const unsigned*)((const char*)(gbase) + (v1)), (LAS unsigned*)(lds + (bufoff) + ldsw + 8192), 16, 0, 0); } while (0)
#define G_LDA(dst, b, h) do { _Pragma("unroll") for (int m = 0; m < 4; ++m) _Pragma("unroll") for (int k = 0; k < 2; ++k) dst[m][k] = *(const LAS bf16x8*)(lds + G_SA(b, h) + aoff + m * 2048 + k * 1024); } while (0)
#define G_LDB(dst, b, h) do { _Pragma("unroll") for (int n = 0; n < 2; ++n) _Pragma("unroll") for (int k = 0; k < 2; ++k) dst[n][k] = *(const LAS bf16x8*)(lds + G_SB(b, h) + boff + n * 2048 + k * 1024); } while (0)
#define G_MMA(ai, bj, At, Bt) do { __builtin_amdgcn_s_setprio(1); _Pragma("unroll") for (int m = 0; m < 4; ++m) _Pragma("unroll") for (int n = 0; n < 2; ++n) _Pragma("unroll") for (int k = 0; k < 2; ++k) \
        acc[ai][bj][m][n] = __builtin_amdgcn_mfma_f32_16x16x32_bf16(Bt[n][k], At[m][k], acc[ai][bj][m][n], 0, 0, 0); __builtin_amdgcn_s_setprio(0); } while (0)
#define G_WAIT_V(n) asm volatile("s_waitcnt vmcnt(" #n ")" ::: "memory")
#define G_WAIT_L(n) asm volatile("s_waitcnt lgkmcnt(" #n ")" ::: "memory")
#define G_BAR __builtin_amdgcn_s_barrier()
#define G_SCHED __builtin_amdgcn_sched_barrier(0)
#define G_OFFS(u, va00, va01, va10, va11, vb0, vb1, hsB) do { \
        int _t = threadIdx.x; asm volatile("" : "+v"(_t));     \
        int R0, C0, R1, C1; gm::stage_rc(_t * 16, R0, C0); gm::stage_rc(_t * 16 + 8192, R1, C1); \
        const int Rb0 = PERM ? ((R0 & ~31) + gm::perm32(R0 & 31)) : R0, Rb1 = PERM ? ((R1 & ~31) + gm::perm32(R1 & 31)) : R1; \
        unsigned _lda = (u).lda, _ldb = (u).ldb; if (Sched::VAR_STRIDE) asm volatile("" : "+s"(_lda), "+s"(_ldb));     \
        int r00 = R0, r01 = R1, r10 = 128 + R0, r11 = 128 + R1; \
        if ((u).gidx) { r00 = (u).gidx[R0]; r01 = (u).gidx[R1]; r10 = (u).gidx[128 + R0]; r11 = (u).gidx[128 + R1]; r00 = r00 < 0 ? 0 : (r00 >> 2); r01 = r01 < 0 ? 0 : (r01 >> 2); r10 = r10 < 0 ? 0 : (r10 >> 2); r11 = r11 < 0 ? 0 : (r11 >> 2); }     \
        va00 = (unsigned)r00 * _lda + (unsigned)C0 * 2u; va01 = (unsigned)r01 * _lda + (unsigned)C1 * 2u; \
        va10 = (unsigned)r10 * _lda + (unsigned)C0 * 2u; va11 = (unsigned)r11 * _lda + (unsigned)C1 * 2u; \
        vb0 = (unsigned)Rb0 * _ldb + (unsigned)C0 * 2u; vb1 = (unsigned)Rb1 * _ldb + (unsigned)C1 * 2u; hsB = (size_t)128 * _ldb; } while (0)
    GUnit cur, nxt; int ui = 0;
    if (!S.next(0, cur)) return;
#ifndef GEMM_SKEW_TICKS
#define GEMM_SKEW_TICKS 0
#endif
    if (GEMM_SKEW_TICKS > 0 && Sched::SKEW) {
        const unsigned long long t0 = __builtin_amdgcn_s_memrealtime(), w = (unsigned long long)(blockIdx.x & 7u) * (GEMM_SKEW_TICKS);
        while (__builtin_amdgcn_s_memrealtime() - t0 < w) __builtin_amdgcn_s_sleep(8);
    }
    f32x4 acc[2][2][4][2];
#pragma unroll
    for (int a = 0; a < 2; ++a)
#pragma unroll
        for (int b = 0; b < 2; ++b)
#pragma unroll
            for (int m = 0; m < 4; ++m)
#pragma unroll
                for (int n = 0; n < 2; ++n) acc[a][b][m][n] = (f32x4){0.f, 0.f, 0.f, 0.f};
    bf16x8 At[4][2], B0[2][2], B1[2][2];
    unsigned va00, va01, va10, va11, vb0, vb1; size_t hsB;
    unsigned na00, na01, na10, na11, nb0, nb1; size_t nhsB;
    G_OFFS(cur, va00, va01, va10, va11, vb0, vb1, hsB);
    const char* cA = cur.A; const char* cB = cur.B;
    G_STAGE2(G_SB(0, 0), cB, vb0, vb1); G_STAGE2(G_SA(0, 0), cA, va00, va01); G_STAGE2(G_SB(0, 1), cB + hsB, vb0, vb1); G_STAGE2(G_SA(0, 1), cA, va10, va11);
    if (wr == 1) G_BAR;
    G_WAIT_V(4); G_BAR;
    G_STAGE2(G_SB(1, 0), cB + kstep, vb0, vb1); G_STAGE2(G_SA(1, 0), cA + kstep, va00, va01); G_STAGE2(G_SB(1, 1), cB + hsB + kstep, vb0, vb1);
    G_WAIT_V(6); G_BAR;
    for (;;) {
        const bool has_next = S.next(ui + 1, nxt);
        const char* nA = cA; const char* nB = cB;
        if (has_next) { nA = nxt.A; nB = nxt.B; }
        if (Sched::GATHER_A) {
            na00 = va00; na01 = va01; na10 = va10; na11 = va11; nb0 = vb0; nb1 = vb1; nhsB = hsB;
            if (has_next) {
                if (nxt.gidx != nullptr && nxt.gidx == cur.gidx) {
                    unsigned t0, t1, t2, t3; gm::GUnit ub = nxt; ub.gidx = nullptr; G_OFFS(ub, t0, t1, t2, t3, nb0, nb1, nhsB); (void)t0; (void)t1; (void)t2; (void)t3;
                } else G_OFFS(nxt, na00, na01, na10, na11, nb0, nb1, nhsB);
            }
        }
        const int nt = cur.nt;
        for (int t = 0; t < nt; t += 2) {
            const bool last = (t == nt - 2);
            const char* a1 = cA + (size_t)(t + 1) * kstep;
            G_LDB(B0, 0, 0); G_SCHED; G_LDA(At, 0, 0); G_STAGE2(G_SA(1, 1), a1, va10, va11);
            const char* a2 = last ? nA : cA + (size_t)(t + 2) * kstep; const char* b2 = last ? nB : cB + (size_t)(t + 2) * kstep;
            if (last) {
                if (Sched::GATHER_A) { va00 = na00; va01 = na01; va10 = na10; va11 = na11; vb0 = nb0; vb1 = nb1; hsB = nhsB; }
                else if (has_next) G_OFFS(nxt, va00, va01, va10, va11, vb0, vb1, hsB);
            }
            const char* a3 = a2 + kstep; const char* b3 = b2 + kstep;
            G_WAIT_L(8); G_BAR; G_WAIT_L(0); G_MMA(0, 0, At, B0); G_BAR; G_SCHED;
            G_LDB(B1, 0, 1); G_STAGE2(G_SB(0, 0), b2, vb0, vb1);
            G_BAR; G_WAIT_L(0); G_MMA(0, 1, At, B1); G_BAR;
            G_LDA(At, 0, 1); G_STAGE2(G_SA(0, 0), a2, va00, va01);
            G_BAR; G_WAIT_L(0); G_MMA(1, 0, At, B0); G_BAR; G_SCHED;
            G_STAGE2(G_SB(0, 1), b2 + hsB, vb0, vb1);
            G_WAIT_V(6); G_BAR; G_MMA(1, 1, At, B1); G_BAR;
            G_LDB(B0, 1, 0); G_SCHED; G_LDA(At, 1, 0); G_STAGE2(G_SA(0, 1), a2, va10, va11);
            G_WAIT_L(8); G_BAR; G_WAIT_L(0); G_MMA(0, 0, At, B0); G_BAR; G_SCHED;
            G_LDB(B1, 1, 1); G_STAGE2(G_SB(1, 0), b3, vb0, vb1);
            G_BAR; G_WAIT_L(0); G_MMA(0, 1, At, B1); G_BAR;
            G_LDA(At, 1, 1); G_STAGE2(G_SA(1, 0), a3, va00, va01);
            G_BAR; G_WAIT_L(0); G_MMA(1, 0, At, B0); G_BAR; G_SCHED;
            G_STAGE2(G_SB(1, 1), b3 + hsB, vb0, vb1);
            G_WAIT_V(6); G_BAR; G_MMA(1, 1, At, B1); G_BAR;
        }
        E(acc, cur, wr, wc, (int)(threadIdx.x & 15u), (int)((threadIdx.x >> 4) & 3u));
        if (!has_next) break;
        if constexpr (!Epi::MAYKEEP) {
#pragma unroll
            for (int a = 0; a < 2; ++a)
#pragma unroll
                for (int b = 0; b < 2; ++b)
#pragma unroll
                    for (int m = 0; m < 4; ++m)
#pragma unroll
                        for (int n = 0; n < 2; ++n) acc[a][b][m][n] = (f32x4){0.f, 0.f, 0.f, 0.f};
        }
        cur = nxt; cA = nA; cB = nB; ++ui;
    }
    G_WAIT_V(0);
    if (wr == 0) G_BAR;
    G_BAR;
}
}

__device__ __forceinline__ void grouped_order(int Ls, int nM, int nN, int& pm, int& pn) {
    const int n = nM * nN, q = n >> 3, r = n & 7, xcd = Ls & 7, off = Ls >> 3;
    const int wgid = (xcd < r ? xcd * (q + 1) : r * (q + 1) + (xcd - r) * q) + off;
    const int nig = 8 * nN, gid = wgid / nig, fm = gid * 8, gsz = (nM - fm) < 8 ? (nM - fm) : 8, w = wgid - gid * nig;
    pm = fm + (w % gsz); pn = w / gsz;
}
struct SchedProj {
    static constexpr bool VAR_STRIDE = false, GATHER_A = false, SKEW = true;
    const char* H; const char* W; const char* WG; int l, G, c;
    __device__ __forceinline__ bool next(int i, gm::GUnit& u) const {
        const int L = i * G + c, nlat = 256 * 16, nproj = nlat + (l == 0 ? 8 * 16 : 8 * 4), ngate = (l == 0 ? 264 : 256) * 16;
        if (L >= nproj + ngate) return false;
        int pm, pn, sub = 0;
        if (L < nlat) grouped_order(L, 256, 16, pm, pn);
        else if (L < nproj) { const int r = L - nlat; if (l == 0) { pm = 256 + (r >> 4); pn = r & 15; } else { pm = 256 + (r >> 2); pn = 2 + (r & 3); } }
        else { grouped_order(L - nproj, l == 0 ? 264 : 256, 16, pm, pn); sub = 1; }
        u.A = H + (size_t)pm * 256 * 2048; u.B = (sub ? WG : W) + (size_t)pn * 256 * 2048; u.gidx = nullptr; u.lda = 2048; u.ldb = 2048; u.nt = 16; u.pm = pm; u.pn = pn; u.sub = sub; u.e = 0; u.aux = 0;
        return true;
    }
};
struct SchedMerge {
    static constexpr bool VAR_STRIDE = true, GATHER_A = false, SKEW = false;
    const char* P; const char* WB; int ntile, G, c; bool ctxmode;
    __device__ __forceinline__ bool next(int i, gm::GUnit& u) const {
        const int k = i & 3;
        int pm, pn;
        if (ctxmode) { if (c >= 32 || i >= 4) return false; pm = 256 + (c >> 2); pn = c & 3; }
        else { const int L = (i >> 2) * G + c; if (L >= ntile) return false; grouped_order(L, ntile >> 2, 4, pm, pn); }
        u.gidx = nullptr; u.pm = pm; u.pn = pn; u.sub = k; u.e = 0; u.aux = 0;
        const int colofs = (k == 0) ? C_Q : (k == 1) ? C_SB : (k == 2) ? C_K : C_FX;
        const int kofs = (k == 0) ? 0 : (k == 1) ? 512 : (k == 2) ? 1024 : 2048;
        u.A = P + (size_t)pm * 256 * 8192 + colofs * 2; u.lda = 8192; u.B = WB + (size_t)pn * 256 * (WBR_K * 2) + kofs * 2; u.ldb = WBR_K * 2; u.nt = (k == 2) ? 16 : 8;
        return true;
    }
};
struct SchedOut {
    static constexpr bool VAR_STRIDE = false, GATHER_A = false, SKEW = false;
    const char* M; const char* W; int ntile, G, c, mode;
    __device__ __forceinline__ bool next(int i, gm::GUnit& u) const {
        int pm, pn;
        if (mode == 0) { const int L = i * G + c; if (L >= ntile) return false; grouped_order(L, ntile >> 2, 4, pm, pn); }
        else if (mode == 1) {
            const int w = c >> 3; int off;
            if (w < 4) { if (i >= 2) return false; off = w * 2 + i; }
            else if (i < 4) off = 8 + (w - 4) + 28 * i;
            else if (i == 4 && w < 12) off = 120 + (w - 4);
            else return false;
            grouped_order(off * 8 + (c & 7), 256, 4, pm, pn);
        } else {
            const int r = c - 96; if (i != 0 || r < 0 || r >= 32) return false;
            pm = 256 + (r >> 2); pn = r & 3;
        }
        u.A = M + (size_t)pm * 256 * 2048; u.B = W + (size_t)pn * 256 * 2048; u.gidx = nullptr; u.lda = 2048; u.ldb = 2048; u.nt = 16; u.pm = pm; u.pn = pn; u.sub = 0; u.e = 0;
        return true;
    }
};
__device__ __forceinline__ int moe_expert_of(const LAS int* tb, int rt) { int e = 0; while (tb[e + 1] <= rt) ++e; return e; }
struct SchedMoeFused {
    static constexpr bool VAR_STRIDE = false, GATHER_A = true, SKEW = true;
    const char* H; const char* GU; const char* DN; const char* act; const int* rtok; const LAS int* tb; int nfull, G, c; unsigned aux;
    __device__ __forceinline__ bool next(int i, gm::GUnit& u) const {
        const int ti = i / 12, s = i % 12, rt = ti * G + c;
        if (rt >= nfull) return false;
        const int e = moe_expert_of(tb, rt);
        u.pm = rt; u.sub = s; u.e = e; u.lda = 2048; u.ldb = 2048; u.nt = 16; u.aux = aux;
        if (s < 8) { u.pn = s; u.A = H; u.gidx = rtok + (size_t)rt * 256; u.B = GU + ((size_t)e * 2048 + s * 256) * 2048; }
        else { u.pn = s - 8; u.A = act + aux; u.gidx = nullptr; u.B = DN + ((size_t)e * 1024 + (s - 8) * 256) * 2048; }
        return true;
    }
};
template <bool GUPASS>
struct SchedMoeSplit {
    static constexpr bool VAR_STRIDE = false, GATHER_A = GUPASS, SKEW = false;
    const char* A; const char* W; const int* rtok; const LAS int* tb; int nfull, G, c;
    __device__ __forceinline__ bool next(int i, gm::GUnit& u) const {
        constexpr int NCT = GUPASS ? 8 : 4;
        const int L = i * G + c, rt = nfull + L / NCT, ct = L % NCT;
        if (rt >= tb[32]) return false;
        const int e = moe_expert_of(tb, rt);
        u.pm = rt; u.pn = ct; u.e = e; u.lda = 2048; u.ldb = 2048; u.nt = 16; u.aux = (unsigned)(rt - nfull) * (256u * 2048u);
        if (GUPASS) { u.sub = ct; u.A = A; u.gidx = rtok + (size_t)rt * 256; u.B = W + ((size_t)e * 2048 + ct * 256) * 2048; }
        else { u.sub = 8 + ct; u.A = A + u.aux; u.gidx = nullptr; u.B = W + ((size_t)e * 1024 + ct * 256) * 2048; }
        return true;
    }
};

typedef f32x4 AccT[2][2][4][2];
struct EpiProj {
    static constexpr bool MAYKEEP = false;
    bf16_t* P; const float* rope; unsigned char* G8; const float* bg;
    __device__ __forceinline__ void operator()(const AccT& acc, const gm::GUnit& u, int wr, int wc, int fr, int fq) const {
        asm volatile("" : "+v"(fr), "+v"(fq));
        if (u.sub == 1) {
            const float* bp = bg + u.pn * 256 + wc * 32 + 8 * fq;
            f32x4 bb[2][2];
#pragma unroll
            for (int bj = 0; bj < 2; ++bj) { bb[bj][0] = *(const f32x4*)(bp + bj * 128); bb[bj][1] = *(const f32x4*)(bp + bj * 128 + 4); }
            __builtin_amdgcn_sched_barrier(0);
#pragma unroll
            for (int bj = 0; bj < 2; ++bj) {
                const f32x4 b0 = bb[bj][0], b1 = bb[bj][1];
#pragma unroll
                for (int ai = 0; ai < 2; ++ai)
#pragma unroll
                    for (int m = 0; m < 4; ++m) {
                        const int row = u.pm * 256 + ai * 128 + wr * 64 + m * 16 + fr;
                        f32x4 v0 = (acc[ai][bj][m][0] + b0) * -1.4426950408889634f, v1 = (acc[ai][bj][m][1] + b1) * -1.4426950408889634f;
#pragma unroll
                        for (int j = 0; j < 4; ++j) { v0[j] = __builtin_amdgcn_exp2f(v0[j]); v1[j] = __builtin_amdgcn_exp2f(v1[j]); }
                        v0 = v0 + 1.f; v1 = v1 + 1.f;
#pragma unroll
                        for (int j = 0; j < 4; ++j) { v0[j] = __builtin_amdgcn_rcpf(v0[j]); v1[j] = __builtin_amdgcn_rcpf(v1[j]); }
                        v0 = v0 * 255.f + 0.5f; v1 = v1 * 255.f + 0.5f;
                        unsigned q[8];
#pragma unroll
                        for (int j = 0; j < 4; ++j) { q[j] = max((unsigned)v0[j], 1u); q[4 + j] = max((unsigned)v1[j], 1u); }
                        u32x2 w; w.x = q[0] | (q[1] << 8) | (q[2] << 16) | (q[3] << 24); w.y = q[4] | (q[5] << 8) | (q[6] << 16) | (q[7] << 24);
                        *(u32x2*)(G8 + (size_t)row * INW + u.pn * 256 + bj * 128 + wc * 32 + 8 * fq) = w;
                    }
            }
            return;
        }
        const bool dorope = (u.pn < 4) && (u.pm < 256);
f32x4 cs[2][4], sn[2][4];
#pragma unroll
        for (int ai = 0; ai < 2; ++ai)
#pragma unroll
            for (int m = 0; m < 4; ++m) { cs[ai][m] = (f32x4){1.f, 1.f, 1.f, 1.f}; sn[ai][m] = (f32x4){0.f, 0.f, 0.f, 0.f}; }
        if (dorope) {
#pragma unroll
            for (int ai = 0; ai < 2; ++ai)
#pragma unroll
                for (int m = 0; m < 4; ++m) {
                    const int row = u.pm * 256 + ai * 128 + wr * 64 + m * 16 + fr, s = row & (SEQ - 1), pos = (wc & 1) ? (s & 63) : (s >> 6);
                    cs[ai][m] = *(const f32x4*)(rope + pos * 16 + 4 * fq); sn[ai][m] = *(const f32x4*)(rope + 2048 + pos * 16 + 4 * fq);
                }
        }
        __builtin_amdgcn_sched_barrier(0);
#pragma unroll
        for (int ai = 0; ai < 2; ++ai)
#pragma unroll
            for (int m = 0; m < 4; ++m) {
                const int row = u.pm * 256 + ai * 128 + wr * 64 + m * 16 + fr;
                bf16_t* rowp = P + (size_t)row * INW + u.pn * 256 + wc * 32 + 8 * fq;
#pragma unroll
                for (int bj = 0; bj < 2; ++bj) {
                    const f32x4 x0 = acc[ai][bj][m][0], x1 = acc[ai][bj][m][1];
                    const f32x4 o0 = x0 * cs[ai][m] - x1 * sn[ai][m], o1 = x1 * cs[ai][m] + x0 * sn[ai][m];
                    u32x4 w; w.x = cvt_pk_bf16(o0[0], o0[1]); w.y = cvt_pk_bf16(o0[2], o0[3]); w.z = cvt_pk_bf16(o1[0], o1[1]); w.w = cvt_pk_bf16(o1[2], o1[3]);
                    *(u32x4*)(rowp + bj * 128) = w;
                }
            }
    }
};
struct EpiMerge {
    static constexpr bool MAYKEEP = true;
    const unsigned char* G8; bf16_t* M;
    __device__ __forceinline__ void operator()(AccT& acc, const gm::GUnit& u, int wr, int wc, int fr, int fq) const {
        asm volatile("" : "+v"(fr), "+v"(fq));
        const int k = u.sub;
        const unsigned char* gbase = G8 + (size_t)(u.pm * 256 + wr * 64 + fr) * INW + k * 1024 + u.pn * 256 + wc * 32 + 8 * fq;
#pragma unroll
        for (int q = 0; q < 4; ++q) {
            const int ai = q >> 1, m0 = (q & 1) * 2;
            u32x2 ga[2][2], gb[2][2];
#pragma unroll
            for (int mi = 0; mi < 2; ++mi)
#pragma unroll
                for (int bj = 0; bj < 2; ++bj) {
                    const unsigned char* gp = gbase + (size_t)(ai * 128 + (m0 + mi) * 16) * INW + bj * 128;
                    ga[mi][bj] = *(const u32x2*)gp;
                    gb[mi][bj] = (k < 3) ? *(const u32x2*)(gp + 1024) : (u32x2){0xffffffffu, 0xffffffffu};
                }
            __builtin_amdgcn_sched_barrier(0);
#pragma unroll
            for (int mi = 0; mi < 2; ++mi) {
                const int m = m0 + mi, row = u.pm * 256 + ai * 128 + wr * 64 + m * 16 + fr;
#pragma unroll
                for (int bj = 0; bj < 2; ++bj) {
                    const u32x2 a = ga[mi][bj], b = gb[mi][bj];
                    f32x4 r0, r1;
                    r0[0] = (float)(a.x & 255u) * __builtin_amdgcn_rcpf((float)(b.x & 255u)); r0[1] = (float)((a.x >> 8) & 255u) * __builtin_amdgcn_rcpf((float)((b.x >> 8) & 255u));
                    r0[2] = (float)((a.x >> 16) & 255u) * __builtin_amdgcn_rcpf((float)((b.x >> 16) & 255u)); r0[3] = (float)(a.x >> 24) * __builtin_amdgcn_rcpf((float)(b.x >> 24));
                    r1[0] = (float)(a.y & 255u) * __builtin_amdgcn_rcpf((float)(b.y & 255u)); r1[1] = (float)((a.y >> 8) & 255u) * __builtin_amdgcn_rcpf((float)((b.y >> 8) & 255u));
                    r1[2] = (float)((a.y >> 16) & 255u) * __builtin_amdgcn_rcpf((float)((b.y >> 16) & 255u)); r1[3] = (float)(a.y >> 24) * __builtin_amdgcn_rcpf((float)(b.y >> 24));
                    const f32x4 s0 = acc[ai][bj][m][0] * r0, s1 = acc[ai][bj][m][1] * r1;
                    if (k == 3) {
                        u32x4 w; w.x = cvt_pk_bf16(s0[0], s0[1]); w.y = cvt_pk_bf16(s0[2], s0[3]); w.z = cvt_pk_bf16(s1[0], s1[1]); w.w = cvt_pk_bf16(s1[2], s1[3]);
                        *(u32x4*)(M + (size_t)row * DM + u.pn * 256 + bj * 128 + wc * 32 + 8 * fq) = w;
                    }
                    const float kz = (k == 3) ? 0.f : 1.f;
                    acc[ai][bj][m][0] = s0 * kz; acc[ai][bj][m][1] = s1 * kz;
                }
            }
            __builtin_amdgcn_sched_barrier(0);
        }
    }
};
struct EpiOut {
    static constexpr bool MAYKEEP = false;
    const float* xin; float* xout; long long din, dout; const float* mods;
    __device__ __forceinline__ void operator()(const AccT& acc, const gm::GUnit& u, int wr, int wc, int fr, int fq) const {
        asm volatile("" : "+v"(fr), "+v"(fq));
        const bool lat = u.pm < 256;
        const int b = lat ? (u.pm >> 5) : 8;
        const float* gp = mods + (size_t)b * 6144 + 2 * 1024 + u.pn * 256 + wc * 32 + 4 * fq;
        f32x4 gv[2][2];
#pragma unroll
        for (int bj = 0; bj < 2; ++bj)
#pragma unroll
            for (int n = 0; n < 2; ++n) gv[bj][n] = *(const f32x4*)(gp + bj * 128 + n * 16);
#pragma unroll
        for (int q = 0; q < 4; ++q) {
            const int ai = q >> 1, m0 = (q & 1) * 2;
            f32x4 xv[2][2][2];
#pragma unroll
            for (int mi = 0; mi < 2; ++mi) {
                const int row = u.pm * 256 + ai * 128 + wr * 64 + (m0 + mi) * 16 + fr;
                const float* ip = xin + (size_t)row * DM + u.pn * 256 + wc * 32 + 4 * fq + (lat ? 0ll : din);
#pragma unroll
                for (int bj = 0; bj < 2; ++bj)
#pragma unroll
                    for (int n = 0; n < 2; ++n) xv[mi][bj][n] = *(const f32x4*)(ip + bj * 128 + n * 16);
            }
            __builtin_amdgcn_sched_barrier(0);
#pragma unroll
            for (int mi = 0; mi < 2; ++mi) {
                const int m = m0 + mi, row = u.pm * 256 + ai * 128 + wr * 64 + m * 16 + fr;
                float* op = xout + (size_t)row * DM + u.pn * 256 + wc * 32 + 4 * fq + (lat ? 0ll : dout);
#pragma unroll
                for (int bj = 0; bj < 2; ++bj)
#pragma unroll
                    for (int n = 0; n < 2; ++n) *(f32x4*)(op + bj * 128 + n * 16) = xv[mi][bj][n] + gv[bj][n] * acc[ai][bj][m][n];
            }
            __builtin_amdgcn_sched_barrier(0);
        }
    }
};
struct EpiMoe {
    static constexpr bool MAYKEEP = false;
    char* act; const float* bgate; const float* bup; const float* bd; const int* rtok; const float* rw; bf16_t* Y; bool fused;
    __device__ __forceinline__ void operator()(const AccT& acc, const gm::GUnit& u, int wr, int wc, int fr, int fq) const {
        asm volatile("" : "+v"(fr), "+v"(fq));
        if (u.sub < 8) {
            bf16_t* at = (bf16_t*)(act + u.aux);
            f32x4 bgs[2], bus[2];
#pragma unroll
            for (int bj = 0; bj < 2; ++bj) { const int col = u.pn * 128 + bj * 64 + wc * 16 + 4 * fq; bgs[bj] = *(const f32x4*)(bgate + u.e * 1024 + col); bus[bj] = *(const f32x4*)(bup + u.e * 1024 + col); }
            __builtin_amdgcn_sched_barrier(0);
#pragma unroll
            for (int bj = 0; bj < 2; ++bj) {
                const int col = u.pn * 128 + bj * 64 + wc * 16 + 4 * fq;
                const f32x4 bgv = bgs[bj], buv = bus[bj];
#pragma unroll
                for (int ai = 0; ai < 2; ++ai)
#pragma unroll
                    for (int m = 0; m < 4; ++m) {
                        const int row = ai * 128 + wr * 64 + m * 16 + fr;
                        f32x4 a4 = acc[ai][bj][m][0] + bgv, u4 = acc[ai][bj][m][1] + buv;
#pragma unroll
                        for (int j = 0; j < 4; ++j) { a4[j] = fminf(a4[j], 7.f); u4[j] = fminf(fmaxf(u4[j], -7.f), 7.f); }
                        f32x4 e4 = a4 * (-1.702f * 1.4426950408889634f);
#pragma unroll
                        for (int j = 0; j < 4; ++j) e4[j] = __builtin_amdgcn_exp2f(e4[j]);
                        e4 = e4 + 1.f;
#pragma unroll
                        for (int j = 0; j < 4; ++j) e4[j] = __builtin_amdgcn_rcpf(e4[j]);
                        const f32x4 g4 = a4 * e4, o = g4 * u4 + g4;
                        u32x2 w; w.x = cvt_pk_bf16(o[0], o[1]); w.y = cvt_pk_bf16(o[2], o[3]);
                        *(u32x2*)(at + (size_t)row * DM + col) = w;
                    }
            }
        } else {
            const int col = u.pn * 256 + wc * 32 + 8 * fq;
            f32x4 bv[2][2];
#pragma unroll
            for (int bj = 0; bj < 2; ++bj) { bv[bj][0] = *(const f32x4*)(bd + u.e * 1024 + col + bj * 128); bv[bj][1] = *(const f32x4*)(bd + u.e * 1024 + col + bj * 128 + 4); }
            int slots[8]; float ws8[8];
#pragma unroll
            for (int i = 0; i < 8; ++i) { const int row = u.pm * 256 + (i >> 2) * 128 + wr * 64 + (i & 3) * 16 + fr; slots[i] = rtok[row]; ws8[i] = rw[row]; }
            __builtin_amdgcn_sched_barrier(0);
#pragma unroll
            for (int ai = 0; ai < 2; ++ai)
#pragma unroll
                for (int m = 0; m < 4; ++m) {
                    const int slot = slots[ai * 4 + m];
                    if (slot >= 0) {
                        const float w = ws8[ai * 4 + m];
                        bf16_t* yp = Y + (size_t)slot * DM + col;
#pragma unroll
                        for (int bj = 0; bj < 2; ++bj) {
                            const f32x4 y0 = (acc[ai][bj][m][0] + bv[bj][0]) * w, y1 = (acc[ai][bj][m][1] + bv[bj][1]) * w;
                            u32x4 q; q.x = cvt_pk_bf16(y0[0], y0[1]); q.y = cvt_pk_bf16(y0[2], y0[3]); q.z = cvt_pk_bf16(y1[0], y1[1]); q.w = cvt_pk_bf16(y1[2], y1[3]);
                            *(u32x4*)(yp + bj * 128) = q;
                        }
                    }
                }
            if (fused && u.sub == 11) asm volatile("buffer_inv sc0\n\ts_waitcnt vmcnt(0)" ::: "memory");
        }
    }
};

struct EpiDry {
    static constexpr bool MAYKEEP = false;
    bf16_t* P;
    __device__ __forceinline__ void operator()(const AccT& acc, const gm::GUnit& u, int wr, int wc, int fr, int fq) const {
        float s = 0.f;
#pragma unroll
        for (int ai = 0; ai < 2; ++ai)
#pragma unroll
            for (int bj = 0; bj < 2; ++bj)
#pragma unroll
                for (int m = 0; m < 4; ++m)
#pragma unroll
                    for (int n = 0; n < 2; ++n) s += acc[ai][bj][m][n][0] + acc[ai][bj][m][n][1] + acc[ai][bj][m][n][2] + acc[ai][bj][m][n][3];
        if (s == 123456.789f) P[(size_t)u.pm * 256 * INW + fr] = 0;
    }
};

#ifndef DRY_NT
#define DRY_NT 16
#endif
struct SchedProjDry {
    static constexpr bool VAR_STRIDE = false, GATHER_A = false, SKEW = false;
    SchedProj S;
    __device__ __forceinline__ bool next(int i, gm::GUnit& u) const { const bool ok = S.next(i, u); u.nt = DRY_NT;
#ifdef DRY_SAME
        u.A = S.H; u.B = S.W;
#endif
        return ok; }
};

namespace at {
constexpr int SHM_V = 64 * 128 * 2, SHM_K = 64 * 64 * 2;
constexpr int SLOT = SHM_V + SHM_K;
constexpr int OFF_V = 0, OFF_K = 2 * SHM_V, OFF_WS = 3 * SLOT, OFF_STASH = OFF_WS + 8 * 64 * 4, OFF_FLAG = OFF_STASH + 65536;
constexpr float SCALE = 0.125f, THR = 8.f;
#define AT_KSWZ(row, colB) ((row) * 128 + ((colB) ^ ((((row) >> 1) & 7) << 4)))
#define AT_SBAR() __builtin_amdgcn_sched_barrier(0)
__device__ __forceinline__ int crow(int r, int hi) { return (r & 3) + 8 * (r >> 2) + 4 * hi; }

constexpr float THRL = THR * 1.4426950408889634f;
template <bool FIRST>
__device__ __forceinline__ void partialSM(f32x16& p0, f32x16& p1, float& m_reg, float& alpha) {
    float pmax = p0[0];
#pragma unroll
    for (int r = 1; r < 16; ++r) pmax = fmaxf(pmax, p0[r]);
#pragma unroll
    for (int r = 0; r < 16; ++r) pmax = fmaxf(pmax, p1[r]);
    { auto rr = __builtin_amdgcn_permlane32_swap(__float_as_uint(pmax), __float_as_uint(pmax), false, false);
      pmax = fmaxf(__uint_as_float(rr[0]), __uint_as_float(rr[1])); }
    if (!FIRST && __builtin_expect(__all(pmax <= THRL), 1)) { alpha = 1.f; }
    else {
        const float d = FIRST ? pmax : fmaxf(pmax, 0.f);
        alpha = FIRST ? 1.f : __builtin_amdgcn_exp2f(-d); m_reg += d;
#pragma unroll
        for (int r = 0; r < 16; ++r) { p0[r] -= d; p1[r] -= d; }
    }
#pragma unroll
    for (int r = 0; r < 16; ++r) p0[r] = __builtin_amdgcn_exp2f(p0[r]);
}
__device__ __forceinline__ void finishSM(f32x16& p0, f32x16& p1, float alpha, float& l_reg, bf16x8& pa0, bf16x8& pa1, bf16x8& pa2, bf16x8& pa3) {
#pragma unroll
    for (int r = 0; r < 16; ++r) p1[r] = __builtin_amdgcn_exp2f(p1[r]);
    float ps = 0;
#pragma unroll
    for (int r = 0; r < 16; ++r) ps += p0[r];
#pragma unroll
    for (int r = 0; r < 16; ++r) ps += p1[r];
    { auto rr = __builtin_amdgcn_permlane32_swap(__float_as_uint(ps), __float_as_uint(ps), false, false);
      ps = __uint_as_float(rr[0]) + __uint_as_float(rr[1]); }
    l_reg = l_reg * alpha + ps;
#define AT_PK4(P, BASE, OUT) do { unsigned a0 = cvt_pk_bf16(P[BASE + 0], P[BASE + 1]), a1 = cvt_pk_bf16(P[BASE + 2], P[BASE + 3]);   \
    unsigned b0 = cvt_pk_bf16(P[BASE + 4], P[BASE + 5]), b1 = cvt_pk_bf16(P[BASE + 6], P[BASE + 7]);                              \
    auto r0 = __builtin_amdgcn_permlane32_swap(a0, b0, false, false); auto r1 = __builtin_amdgcn_permlane32_swap(a1, b1, false, false); \
    u32x4 w = {r0[0], r1[0], r0[1], r1[1]}; OUT = *reinterpret_cast<bf16x8*>(&w); } while (0)
    AT_PK4(p0, 0, pa0); AT_PK4(p0, 8, pa1); AT_PK4(p1, 0, pa2); AT_PK4(p1, 8, pa3);
#undef AT_PK4
}
#ifndef AT_TOVF
#define AT_TOVF 1099511627776.f
#endif
constexpr float TOVF = AT_TOVF;
__device__ __forceinline__ void expSM(f32x16& p) {
#pragma unroll
    for (int r = 0; r < 16; ++r) p[r] = __builtin_amdgcn_exp2f(p[r]);
}
__device__ __forceinline__ void finishFast(f32x16& p0, f32x16& p1, bool& ovf, float& l_reg, bf16x8& pa0, bf16x8& pa1, bf16x8& pa2, bf16x8& pa3) {
    expSM(p1);
    typedef float f32x2_t __attribute__((ext_vector_type(2)));
    f32x2_t sa = {p0[0], p0[1]}, sb = {p0[8], p0[9]}, sc = {p1[0], p1[1]}, sd = {p1[8], p1[9]};
#pragma unroll
    for (int r = 2; r < 8; r += 2) { sa += f32x2_t{p0[r], p0[r + 1]}; sb += f32x2_t{p0[8 + r], p0[9 + r]}; sc += f32x2_t{p1[r], p1[r + 1]}; sd += f32x2_t{p1[8 + r], p1[9 + r]}; }
    const f32x2_t ps2 = (sa + sb) + (sc + sd);
    float ps = ps2.x + ps2.y;
    { auto rr = __builtin_amdgcn_permlane32_swap(__float_as_uint(ps), __float_as_uint(ps), false, false);
      ps = __uint_as_float(rr[0]) + __uint_as_float(rr[1]); }
    l_reg += ps;
#define AT_PK4(P, BASE, OUT) do { u32x4 w = {cvt_pk_bf16(P[BASE + 0], P[BASE + 1]), cvt_pk_bf16(P[BASE + 2], P[BASE + 3]), cvt_pk_bf16(P[BASE + 4], P[BASE + 5]), cvt_pk_bf16(P[BASE + 6], P[BASE + 7])}; \
    OUT = *reinterpret_cast<bf16x8*>(&w); } while (0)
    AT_PK4(p0, 0, pa0); AT_PK4(p0, 8, pa1); AT_PK4(p1, 0, pa2); AT_PK4(p1, 8, pa3);
#undef AT_PK4
}
__device__ __forceinline__ void qkt(f32x16& p0, f32x16& p1, const LAS char* Ks, const bf16x8* qr, int r32, int hi, float init) {
#pragma unroll
    for (int r = 0; r < 16; ++r) { p0[r] = init; p1[r] = init; }
#pragma unroll
    for (int d0 = 0; d0 < 4; ++d0) { const int cb = (d0 * 16 + hi * 8) * 2;
        const bf16x8 b0 = *(const LAS bf16x8*)(Ks + AT_KSWZ(r32, cb));
        const bf16x8 b1 = *(const LAS bf16x8*)(Ks + AT_KSWZ(32 + r32, cb));
        p0 = __builtin_amdgcn_mfma_f32_32x32x16_bf16(b0, qr[d0], p0, 0, 0, 0);
        p1 = __builtin_amdgcn_mfma_f32_32x32x16_bf16(b1, qr[d0], p1, 0, 0, 0); }
}
template <int OFF> __device__ __forceinline__ bf16x8 k_read(int ka) {
    bf16x8 r; asm volatile("ds_read_b128 %0, %1 offset:%2" : "=&v"(r) : "v"(ka), "i"(OFF) : "memory"); return r;
}
template <int BOFF>
__device__ __forceinline__ void qkt_pre(f32x16& p0, f32x16& p1, const int (&ka)[4], const bf16x8* qr, float init) {
    bf16x8 a0 = k_read<BOFF>(ka[0]), b0 = k_read<BOFF + 4096>(ka[0]), a1 = k_read<BOFF>(ka[1]), b1 = k_read<BOFF + 4096>(ka[1]);
    bf16x8 a2 = k_read<BOFF>(ka[2]), b2 = k_read<BOFF + 4096>(ka[2]), a3 = k_read<BOFF>(ka[3]), b3 = k_read<BOFF + 4096>(ka[3]);
#pragma unroll
    for (int r = 0; r < 16; ++r) { p0[r] = init; p1[r] = init; }
    asm volatile("s_waitcnt lgkmcnt(6)" : "+v"(a0), "+v"(b0) :: "memory");
    p0 = __builtin_amdgcn_mfma_f32_32x32x16_bf16(a0, qr[0], p0, 0, 0, 0); p1 = __builtin_amdgcn_mfma_f32_32x32x16_bf16(b0, qr[0], p1, 0, 0, 0);
    asm volatile("s_waitcnt lgkmcnt(4)" : "+v"(a1), "+v"(b1) :: "memory");
    p0 = __builtin_amdgcn_mfma_f32_32x32x16_bf16(a1, qr[1], p0, 0, 0, 0); p1 = __builtin_amdgcn_mfma_f32_32x32x16_bf16(b1, qr[1], p1, 0, 0, 0);
    asm volatile("s_waitcnt lgkmcnt(2)" : "+v"(a2), "+v"(b2) :: "memory");
    p0 = __builtin_amdgcn_mfma_f32_32x32x16_bf16(a2, qr[2], p0, 0, 0, 0); p1 = __builtin_amdgcn_mfma_f32_32x32x16_bf16(b2, qr[2], p1, 0, 0, 0);
    asm volatile("s_waitcnt lgkmcnt(0)" : "+v"(a3), "+v"(b3) :: "memory");
    p0 = __builtin_amdgcn_mfma_f32_32x32x16_bf16(a3, qr[3], p0, 0, 0, 0); p1 = __builtin_amdgcn_mfma_f32_32x32x16_bf16(b3, qr[3], p1, 0, 0, 0);
}
__device__ __forceinline__ int v_st(int k, int c) { const int kk = (k & ~0xC) | ((k & 4) << 1) | ((k & 8) >> 1); return ((kk >> 3) * 4 + (c >> 5)) * 512 + ((kk & 7) * 32 + (c & 31)) * 2; }
__device__ __forceinline__ int v_rd_base(int lane) { return ((lane & 3) << 3) | (((lane >> 2) & 3) << 6) | (((lane >> 4) & 1) << 5) | (((lane >> 5) & 1) << 8); }
constexpr int v_rd_off(int d0, int ks, int half) { return d0 * 512 + ks * 4096 + half * 2048; }
template <int OFF> __device__ __forceinline__ s16x4 tr_read(int vb) {
    s16x4 r; asm volatile("ds_read_b64_tr_b16 %0, %1 offset:%2" : "=&v"(r) : "v"(vb), "i"(OFF) : "memory"); return r;
}
#define AT_PKV(L, H) (bf16x8){L[0], L[1], L[2], L[3], H[0], H[1], H[2], H[3]}
template <int D0> __device__ __forceinline__ void pv_one(f32x16& od, int vb, bf16x8 pa0, bf16x8 pa1, bf16x8 pa2, bf16x8 pa3) {
    const s16x4 l0 = tr_read<v_rd_off(D0, 0, 0)>(vb), h0 = tr_read<v_rd_off(D0, 0, 1)>(vb), l1 = tr_read<v_rd_off(D0, 1, 0)>(vb), h1 = tr_read<v_rd_off(D0, 1, 1)>(vb);
    const s16x4 l2 = tr_read<v_rd_off(D0, 2, 0)>(vb), h2 = tr_read<v_rd_off(D0, 2, 1)>(vb), l3 = tr_read<v_rd_off(D0, 3, 0)>(vb), h3 = tr_read<v_rd_off(D0, 3, 1)>(vb);
    asm volatile("s_waitcnt lgkmcnt(0)" ::: "memory"); AT_SBAR();
    od = __builtin_amdgcn_mfma_f32_32x32x16_bf16(pa0, AT_PKV(l0, h0), od, 0, 0, 0);
    od = __builtin_amdgcn_mfma_f32_32x32x16_bf16(pa1, AT_PKV(l1, h1), od, 0, 0, 0);
    od = __builtin_amdgcn_mfma_f32_32x32x16_bf16(pa2, AT_PKV(l2, h2), od, 0, 0, 0);
    od = __builtin_amdgcn_mfma_f32_32x32x16_bf16(pa3, AT_PKV(l3, h3), od, 0, 0, 0);
}
#ifndef AT_PVPIPE
#define AT_PVPIPE 2
#endif
#define AT_TR8(D0, X) s16x4 X##l0 = tr_read<v_rd_off(D0, 0, 0)>(vb), X##h0 = tr_read<v_rd_off(D0, 0, 1)>(vb), X##l1 = tr_read<v_rd_off(D0, 1, 0)>(vb), X##h1 = tr_read<v_rd_off(D0, 1, 1)>(vb), \
    X##l2 = tr_read<v_rd_off(D0, 2, 0)>(vb), X##h2 = tr_read<v_rd_off(D0, 2, 1)>(vb), X##l3 = tr_read<v_rd_off(D0, 3, 0)>(vb), X##h3 = tr_read<v_rd_off(D0, 3, 1)>(vb)
#define AT_MF4(OD, X) do { OD = __builtin_amdgcn_mfma_f32_32x32x16_bf16(pa0, AT_PKV(X##l0, X##h0), OD, 0, 0, 0); OD = __builtin_amdgcn_mfma_f32_32x32x16_bf16(pa1, AT_PKV(X##l1, X##h1), OD, 0, 0, 0); \
    OD = __builtin_amdgcn_mfma_f32_32x32x16_bf16(pa2, AT_PKV(X##l2, X##h2), OD, 0, 0, 0); OD = __builtin_amdgcn_mfma_f32_32x32x16_bf16(pa3, AT_PKV(X##l3, X##h3), OD, 0, 0, 0); } while (0)
__device__ __forceinline__ void pv_d0(f32x16* o, int vb, bf16x8 pa0, bf16x8 pa1, bf16x8 pa2, bf16x8 pa3) {
#if AT_PVPIPE == 2
#define AT_W8(N, X) asm volatile("s_waitcnt lgkmcnt(" #N ")" : "+v"(X##l0), "+v"(X##h0), "+v"(X##l1), "+v"(X##h1), "+v"(X##l2), "+v"(X##h2), "+v"(X##l3), "+v"(X##h3) :: "memory")
    AT_TR8(0, a); AT_TR8(1, b);
    AT_W8(8, a); AT_TR8(2, c); AT_MF4(o[0], a);
    AT_W8(8, b); AT_TR8(3, d); AT_MF4(o[1], b);
    AT_W8(8, c); AT_MF4(o[2], c);
    AT_W8(0, d); AT_MF4(o[3], d);
#undef AT_W8
#elif AT_PVPIPE == 1
    AT_TR8(0, a);
    asm volatile("s_waitcnt lgkmcnt(0)" ::: "memory"); AT_SBAR(); AT_TR8(1, b); AT_SBAR(); AT_MF4(o[0], a);
    asm volatile("s_waitcnt lgkmcnt(0)" ::: "memory"); AT_SBAR(); AT_TR8(2, c); AT_SBAR(); AT_MF4(o[1], b);
    asm volatile("s_waitcnt lgkmcnt(0)" ::: "memory"); AT_SBAR(); AT_TR8(3, d); AT_SBAR(); AT_MF4(o[2], c);
    asm volatile("s_waitcnt lgkmcnt(0)" ::: "memory"); AT_SBAR(); AT_MF4(o[3], d);
#else
    pv_one<0>(o[0], vb, pa0, pa1, pa2, pa3); pv_one<1>(o[1], vb, pa0, pa1, pa2, pa3); pv_one<2>(o[2], vb, pa0, pa1, pa2, pa3); pv_one<3>(o[3], vb, pa0, pa1, pa2, pa3);
#endif
}

template <bool ROBUST>
__device__ __forceinline__ bool attn_pass(const bf16_t* __restrict__ proj, LAS char* lds, int qrow0, int ctxrow0, int latrow0, int NT, int h, int comp, f32x16 (&o)[4]) {
    int tid = threadIdx.x; asm volatile("" : "+v"(tid));
    const int wid = tid >> 6, lane = tid & 63, r32 = lane & 31, hi = lane >> 5;
    LAS char* V_lds = lds + OFF_V; LAS char* K_lds = lds + OFF_K;
    LAS float* ws = (LAS float*)(lds + OFF_WS) + wid * 64; LAS float* li_l = ws; LAS float* al_l = ws + 32;
    float m_reg = 0.f, l_reg = 0.f;
#pragma unroll
    for (int d = 0; d < 4; ++d) o[d] = f32x16{};
    bf16x8 qr[4];
    { const bf16_t* Qw = proj + (size_t)(qrow0 + wid * 32 + r32) * INW + C_Q + h * 128 + comp * 64 + hi * 8;
#pragma unroll
      for (int d0 = 0; d0 < 4; ++d0) {
          const u32x4 w = *(const u32x4*)(Qw + d0 * 16); constexpr float C = SCALE * 1.4426950408889634f; u32x4 s;
          s.x = cvt_pk_bf16(bf_lo(w.x) * C, bf_hi(w.x) * C); s.y = cvt_pk_bf16(bf_lo(w.y) * C, bf_hi(w.y) * C); s.z = cvt_pk_bf16(bf_lo(w.z) * C, bf_hi(w.z) * C); s.w = cvt_pk_bf16(bf_lo(w.w) * C, bf_hi(w.w) * C);
          qr[d0] = *reinterpret_cast<bf16x8*>(&s); } }
    const int sr = tid >> 4, sc = (tid & 15) * 8, vst0 = v_st(sr, sc), vst1 = v_st(32 + sr, sc);
    const int kr = tid >> 3, kc = (tid & 7) * 8, kst = AT_KSWZ(kr, kc * 2);
    const int vb0 = (int)(uintptr_t)V_lds + v_rd_base(lane);
    const char* pb = (const char*)proj;
    const unsigned voV0 = (unsigned)((sr * INW + C_V + h * 128 + sc) * 2), voV1 = voV0 + 32u * INW * 2u, voK = (unsigned)((kr * INW + C_K + h * 128 + comp * 64 + kc) * 2);
    bf16x8 vsA0, vsA1, ksA, vsB0, vsB1, ksB;
#define AT_ROW(j) ((j) < 4 ? ctxrow0 + (j) * 64 : latrow0 + ((j) - 4) * 64)
#define AT_SLOAD(S, j) do { const char* _p = pb + (size_t)__builtin_amdgcn_readfirstlane(AT_ROW(j)) * (INW * 2); vs##S##0 = *(const bf16x8*)(_p + voV0); vs##S##1 = *(const bf16x8*)(_p + voV1); \
        ks##S = *(const bf16x8*)(_p + voK); } while (0)
#define AT_SWRITE(b, S) do { *(LAS bf16x8*)(V_lds + (b) * SHM_V + vst0) = vs##S##0; *(LAS bf16x8*)(V_lds + (b) * SHM_V + vst1) = vs##S##1; \
        *(LAS bf16x8*)(K_lds + (b) * SHM_K + kst) = ks##S; } while (0)
#define AT_SWAIT() asm volatile("s_waitcnt vmcnt(3)" ::: "memory")
#define AT_RESC(a) do { if (__any((a) < 1.f)) { if (hi == 0) al_l[r32] = (a); asm volatile("s_waitcnt lgkmcnt(0)" ::: "memory"); \
        _Pragma("unroll") for (int d = 0; d < 4; ++d) _Pragma("unroll") for (int r = 0; r < 16; ++r) o[d][r] *= al_l[crow(r, hi)]; } } while (0)
    bool any_ovf = false;
    if constexpr (ROBUST) {
    f32x16 pA0, pA1, pB0, pB1; float alA, alB; bf16x8 pa0, pa1, pa2, pa3;
    AT_SLOAD(A, 0); asm volatile("s_waitcnt vmcnt(0)" ::: "memory"); AT_SWRITE(0, A); __syncthreads();
    qkt(pA0, pA1, K_lds, qr, r32, hi, 0.f); partialSM<true>(pA0, pA1, m_reg, alA);
    AT_SLOAD(B, 1); if (2 < NT) AT_SLOAD(A, 2);
    AT_SWAIT(); AT_SWRITE(1, B); __syncthreads();
    for (int j = 1; j + 1 < NT; j += 2) {
        AT_SBAR(); qkt(pB0, pB1, K_lds + SHM_K, qr, r32, hi, -m_reg);
        finishSM(pA0, pA1, alA, l_reg, pa0, pa1, pa2, pa3); AT_SBAR();
        AT_SLOAD(B, j + 2); AT_SBAR();
        pv_d0(o, vb0, pa0, pa1, pa2, pa3); partialSM<false>(pB0, pB1, m_reg, alB);
        __syncthreads(); AT_SWAIT(); AT_SWRITE(0, A);
        AT_RESC(alB); __syncthreads();
        AT_SBAR(); qkt(pA0, pA1, K_lds, qr, r32, hi, -m_reg);
        finishSM(pB0, pB1, alB, l_reg, pa0, pa1, pa2, pa3); AT_SBAR();
        if (j + 3 < NT) AT_SLOAD(A, j + 3); AT_SBAR();
        pv_d0(o, vb0 + SHM_V, pa0, pa1, pa2, pa3); partialSM<false>(pA0, pA1, m_reg, alA);
        __syncthreads(); AT_SWAIT(); AT_SWRITE(1, B);
        AT_RESC(alA); __syncthreads();
    }
    AT_SBAR(); qkt(pB0, pB1, K_lds + SHM_K, qr, r32, hi, -m_reg);
    finishSM(pA0, pA1, alA, l_reg, pa0, pa1, pa2, pa3); AT_SBAR();
    pv_d0(o, vb0, pa0, pa1, pa2, pa3); partialSM<false>(pB0, pB1, m_reg, alB);
    __syncthreads(); AT_RESC(alB);
    finishSM(pB0, pB1, alB, l_reg, pa0, pa1, pa2, pa3); AT_SBAR();
    pv_d0(o, vb0 + SHM_V, pa0, pa1, pa2, pa3);
    } else {
    f32x16 pA0, pA1, pB0, pB1; bf16x8 pa0, pa1, pa2, pa3; bool ovf = false; float alA;
    int ka[4];
#pragma unroll
    for (int d0 = 0; d0 < 4; ++d0) ka[d0] = (int)(uintptr_t)(lds + SHM_V) + AT_KSWZ(r32, (d0 * 16 + hi * 8) * 2);
    const int widu = __builtin_amdgcn_readfirstlane(wid), l5 = lane >> 5, lp = lane & 31;
    const int kv = wid * 8 + (lp >> 2);
    const unsigned dV0 = (unsigned)((kv * INW + C_V + h * 128 + l5 * 32 + (lp & 3) * 8) * 2), dV1 = dV0 + 128u;
    const int krow = wid * 8 + (lane >> 3);
    const unsigned dK = (unsigned)((krow * INW + C_K + h * 128 + comp * 64) * 2 + (((lane & 7) ^ ((krow >> 1) & 7)) << 4));
#define AT_DMA_K(j, so) do { const char* _p = pb + (size_t)__builtin_amdgcn_readfirstlane(AT_ROW(j)) * (INW * 2); \
        __builtin_amdgcn_global_load_lds((const unsigned*)(_p + dK), (LAS unsigned*)(lds + (so) + SHM_V + widu * 1024), 16, 0, 0); } while (0)
#define AT_DMA_V(j, so) do { const char* _p = pb + (size_t)__builtin_amdgcn_readfirstlane(AT_ROW(j)) * (INW * 2); \
        __builtin_amdgcn_global_load_lds((const unsigned*)(_p + dV0), (LAS unsigned*)(lds + (so) + widu * 2048), 16, 0, 0); \
        __builtin_amdgcn_global_load_lds((const unsigned*)(_p + dV1), (LAS unsigned*)(lds + (so) + widu * 2048 + 1024), 16, 0, 0); } while (0)
    s16x4 dl0, dh0, dl1, dh1, dl2, dh2, dl3, dh3;
    int sV = 0, sK = SLOT, sN = 2 * SLOT;
#define AT_TR8S(D0, X) do { X##l0 = tr_read<v_rd_off(D0, 0, 0)>(vb); X##h0 = tr_read<v_rd_off(D0, 0, 1)>(vb); X##l1 = tr_read<v_rd_off(D0, 1, 0)>(vb); X##h1 = tr_read<v_rd_off(D0, 1, 1)>(vb); \
        X##l2 = tr_read<v_rd_off(D0, 2, 0)>(vb); X##h2 = tr_read<v_rd_off(D0, 2, 1)>(vb); X##l3 = tr_read<v_rd_off(D0, 3, 0)>(vb); X##h3 = tr_read<v_rd_off(D0, 3, 1)>(vb); } while (0)
#define AT_W8(N, X) asm volatile("s_waitcnt lgkmcnt(" #N ")" : "+v"(X##l0), "+v"(X##h0), "+v"(X##l1), "+v"(X##h1), "+v"(X##l2), "+v"(X##h2), "+v"(X##l3), "+v"(X##h3) :: "memory")
    const bool grpB = widu >= 4;
#define AT_BARBLK(T) do { if ((T) + 2 < NT) asm volatile("s_waitcnt vmcnt(1) lgkmcnt(0)" ::: "memory"); else asm volatile("s_waitcnt vmcnt(0) lgkmcnt(0)" ::: "memory"); \
        __builtin_amdgcn_s_barrier();     \
        if ((T) + 1 < NT) AT_DMA_V((T) + 1, sN); if ((T) + 3 < NT) AT_DMA_K((T) + 3, sK); } while (0)
#define AT_HALF(TAIL, PC0, PC1, PP0, PP1, T) do { \
        const int kb0 = ka[0] + sK, kb1 = ka[1] + sK, kb2 = ka[2] + sK, kb3 = ka[3] + sK; \
        bf16x8 a0 = k_read<0>(kb0), b0 = k_read<4096>(kb0), a1 = k_read<0>(kb1), b1 = k_read<4096>(kb1); \
        bf16x8 a2 = k_read<0>(kb2), b2 = k_read<4096>(kb2), a3 = k_read<0>(kb3), b3 = k_read<4096>(kb3); \
        AT_SBAR(); \
        if (TAIL) { AT_MF4(o[3], d); } \
        { const float init = -m_reg; _Pragma("unroll") for (int r = 0; r < 16; ++r) { PC0[r] = init; PC1[r] = init; } } \
        asm volatile("s_waitcnt lgkmcnt(6)" : "+v"(a0), "+v"(b0) :: "memory"); \
        PC0 = __builtin_amdgcn_mfma_f32_32x32x16_bf16(a0, qr[0], PC0, 0, 0, 0); PC1 = __builtin_amdgcn_mfma_f32_32x32x16_bf16(b0, qr[0], PC1, 0, 0, 0); \
        asm volatile("s_waitcnt lgkmcnt(4)" : "+v"(a1), "+v"(b1) :: "memory"); \
        PC0 = __builtin_amdgcn_mfma_f32_32x32x16_bf16(a1, qr[1], PC0, 0, 0, 0); PC1 = __builtin_amdgcn_mfma_f32_32x32x16_bf16(b1, qr[1], PC1, 0, 0, 0); \
        asm volatile("s_waitcnt lgkmcnt(2)" : "+v"(a2), "+v"(b2) :: "memory"); \
        PC0 = __builtin_amdgcn_mfma_f32_32x32x16_bf16(a2, qr[2], PC0, 0, 0, 0); PC1 = __builtin_amdgcn_mfma_f32_32x32x16_bf16(b2, qr[2], PC1, 0, 0, 0); \
        asm volatile("s_waitcnt lgkmcnt(0)" : "+v"(a3), "+v"(b3) :: "memory"); \
        PC0 = __builtin_amdgcn_mfma_f32_32x32x16_bf16(a3, qr[3], PC0, 0, 0, 0); PC1 = __builtin_amdgcn_mfma_f32_32x32x16_bf16(b3, qr[3], PC1, 0, 0, 0); \
        finishFast(PP0, PP1, ovf, l_reg, pa0, pa1, pa2, pa3); AT_SBAR(); \
        if (grpB) AT_BARBLK(T); \
        AT_SBAR(); \
        { const int vb = vb0 + sV; AT_TR8(0, a); AT_TR8(1, b); \
          AT_W8(8, a); AT_TR8(2, c); AT_MF4(o[0], a); \
          AT_W8(8, b); AT_TR8S(3, d); AT_MF4(o[1], b); \
          AT_W8(8, c); AT_MF4(o[2], c); \
          AT_W8(0, d); } \
        expSM(PC0); \
        if (!grpB) AT_BARBLK(T); \
        { const int _t = sV; sV = sK; sK = sN; sN = _t; } } while (0)
    AT_DMA_K(0, 0); AT_DMA_V(0, 0); AT_DMA_K(1, SLOT); AT_DMA_V(1, SLOT); AT_DMA_K(2, 2 * SLOT);
    asm volatile("s_waitcnt vmcnt(4)" ::: "memory"); __syncthreads();
    if (tid == 0) *(LAS int*)(lds + OFF_FLAG) = 0;
    qkt(pA0, pA1, lds + SHM_V, qr, r32, hi, 0.f); partialSM<true>(pA0, pA1, m_reg, alA);
    asm volatile("s_waitcnt vmcnt(1)" ::: "memory"); __syncthreads();
    AT_DMA_K(3, 0);
    AT_HALF(false, pB0, pB1, pA0, pA1, 1);
    for (int j = 2; j + 1 < NT; j += 2) {
        AT_HALF(true, pA0, pA1, pB0, pB1, j);
        AT_HALF(true, pB0, pB1, pA0, pA1, j + 1);
    }
    AT_MF4(o[3], d);
    finishFast(pB0, pB1, ovf, l_reg, pa0, pa1, pa2, pa3); AT_SBAR();
    pv_d0(o, vb0 + sV, pa0, pa1, pa2, pa3);
#undef AT_HALF
#undef AT_BARBLK
#undef AT_W8
#undef AT_TR8S
#undef AT_DMA_K
#undef AT_DMA_V
    any_ovf = !(l_reg < TOVF);
    }
    if (hi == 0) li_l[r32] = l_reg;
    asm volatile("s_waitcnt lgkmcnt(0)" ::: "memory");
#pragma unroll
    for (int r = 0; r < 16; ++r) { const float rl = __builtin_amdgcn_rcpf(li_l[crow(r, hi)]);
#pragma unroll
        for (int d = 0; d < 4; ++d) o[d][r] *= rl; }
    if constexpr (!ROBUST) { if (__any(any_ovf) && lane == 0) *(LAS int*)(lds + OFF_FLAG) = 1; }
    __syncthreads();
    if constexpr (!ROBUST) return __builtin_amdgcn_readfirstlane(*(LAS int*)(lds + OFF_FLAG)) != 0;
    return false;
#undef AT_ROW
#undef AT_SLOAD
#undef AT_SWRITE
#undef AT_SWAIT
#undef AT_RESC
}

__device__ __forceinline__ void attn_unit(bf16_t* __restrict__ proj, LAS char* lds, int qrow0, int b, int h, int NT, float lam, float post, const float* __restrict__ gsub) {
    const int ctxrow0 = TL + b * CTXL, latrow0 = b * SEQ;
    LAS unsigned* stash = (LAS unsigned*)(lds + OFF_STASH);
    f32x16 o[4];
#pragma unroll 1
    for (int comp = 0; comp < 2; ++comp) {
        if (attn_pass<false>(proj, lds, qrow0, ctxrow0, latrow0, NT, h, comp, o)) attn_pass<true>(proj, lds, qrow0, ctxrow0, latrow0, NT, h, comp, o);
        if (comp == 0) {
            int tid = threadIdx.x; asm volatile("" : "+v"(tid));
#pragma unroll
            for (int d = 0; d < 4; ++d)
#pragma unroll
                for (int r = 0; r < 16; r += 2) stash[(d * 8 + (r >> 1)) * NTHR + tid] = cvt_pk_bf16(o[d][r], o[d][r + 1]);
        }
    }
    int tid = threadIdx.x; asm volatile("" : "+v"(tid));
    const int wid = tid >> 6, lane = tid & 63, r32 = lane & 31, hi = lane >> 5;
    float ss[16];
#pragma unroll
    for (int r = 0; r < 16; ++r) ss[r] = 0.f;
#pragma unroll
    for (int d = 0; d < 4; ++d)
#pragma unroll
        for (int r = 0; r < 16; r += 2) {
            const unsigned w = stash[(d * 8 + (r >> 1)) * NTHR + tid];
            const float a0 = bf_lo(w) - lam * o[d][r], a1 = bf_hi(w) - lam * o[d][r + 1];
            o[d][r] = a0; o[d][r + 1] = a1; ss[r] += a0 * a0; ss[r + 1] += a1 * a1;
        }
#pragma unroll
    for (int r = 0; r < 16; ++r) {
        const float v = half32_sum(ss[r]);
        ss[r] = rsqrtf(v * (1.f / 128.f) + EPS) * post;
    }
    bf16_t* Ow = proj + (size_t)(qrow0 + wid * 32) * INW + C_Q + h * 128;
#pragma unroll
    for (int d = 0; d < 4; ++d) { const float g = gsub[d * 32 + r32];
#pragma unroll
        for (int r = 0; r < 16; ++r) Ow[(size_t)crow(r, hi) * INW + d * 32 + r32] = f2bf(o[d][r] * ss[r] * g); }
}
}

__device__ __forceinline__ void phase_attn(const Frame& F, const Params& P, int l) {
    const float lam = F.lam()[l], lam_init = 0.8f - 0.6f * expf(-0.3f * (float)l), post = 1.f - lam_init;
    const float* gsub = P.g_subln + l * 128;
    const int nlat = NB * 4 * 32, nun = nlat + (l == 0 ? NB * 4 : 0);
    for (int i = 0;; ++i) {
        int u = i * F.nwg + F.wg;
        if (F.nwg == 256 && i < 4) u = ((i * 8 + (F.wg & 7)) << 5) + (F.wg >> 3);
        if (u >= nun) break;
        int qrow0, b, h, NT;
        if (u < nlat) { b = u >> 7; h = (u >> 5) & 3; qrow0 = b * SEQ + (u & 31) * 256; NT = 132; }
        else { const int v = u - nlat; b = v >> 2; h = v & 3; qrow0 = TL + b * CTXL; NT = 4; }
        at::attn_unit(F.proj(), (LAS char*)F.lds, qrow0, b, h, NT, lam, post, gsub);
    }
}

namespace ff {
using at::tr_read; using at::v_rd_off; using at::v_st; using at::v_rd_base; using at::crow;
template <int D0> __device__ __forceinline__ void xt_two(f32x16& od1, f32x16& od2, int vb, const bf16x8 (&b1)[4], const bf16x8 (&b2)[4]) {
    const s16x4 l0 = tr_read<v_rd_off(D0, 0, 0)>(vb), h0 = tr_read<v_rd_off(D0, 0, 1)>(vb), l1 = tr_read<v_rd_off(D0, 1, 0)>(vb), h1 = tr_read<v_rd_off(D0, 1, 1)>(vb);
    const s16x4 l2 = tr_read<v_rd_off(D0, 2, 0)>(vb), h2 = tr_read<v_rd_off(D0, 2, 1)>(vb), l3 = tr_read<v_rd_off(D0, 3, 0)>(vb), h3 = tr_read<v_rd_off(D0, 3, 1)>(vb);
    asm volatile("s_waitcnt lgkmcnt(0)" ::: "memory"); __builtin_amdgcn_sched_barrier(0);
    const bf16x8 a0 = AT_PKV(l0, h0), a1 = AT_PKV(l1, h1), a2 = AT_PKV(l2, h2), a3 = AT_PKV(l3, h3);
    od1 = __builtin_amdgcn_mfma_f32_32x32x16_bf16(a0, b1[0], od1, 0, 0, 0); od2 = __builtin_amdgcn_mfma_f32_32x32x16_bf16(a0, b2[0], od2, 0, 0, 0);
    od1 = __builtin_amdgcn_mfma_f32_32x32x16_bf16(a1, b1[1], od1, 0, 0, 0); od2 = __builtin_amdgcn_mfma_f32_32x32x16_bf16(a1, b2[1], od2, 0, 0, 0);
    od1 = __builtin_amdgcn_mfma_f32_32x32x16_bf16(a2, b1[2], od1, 0, 0, 0); od2 = __builtin_amdgcn_mfma_f32_32x32x16_bf16(a2, b2[2], od2, 0, 0, 0);
    od1 = __builtin_amdgcn_mfma_f32_32x32x16_bf16(a3, b1[3], od1, 0, 0, 0); od2 = __builtin_amdgcn_mfma_f32_32x32x16_bf16(a3, b2[3], od2, 0, 0, 0);
}
}

__device__ __forceinline__ void phase_fft_a(const Frame& F) {
    const int tid = F.tid, wid = F.wid, lane = F.lane, r32 = lane & 31, hi = lane >> 5;
    LAS char* Vt = (LAS char*)F.lds;
    const int sr = tid >> 4, sc = (tid & 15) * 8;
    const int rb = wid & 3, chh = wid >> 2, k1 = 32 * rb + r32;
    const bf16_t* dc = F.dft(); const bf16_t* ds = F.dft() + 16384;
    const int NU = NB * 64 * 4;
    bf16x8 pf[4];
#define FA_LOAD(u) do { const int _b = (u) >> 8, _n2 = ((u) >> 2) & 63, _cb = (u) & 3; \
        _Pragma("unroll") for (int _q = 0; _q < 4; ++_q) { const int _n1 = (_q >> 1) * 64 + (_q & 1) * 32 + sr; \
            pf[_q] = *(const bf16x8*)(F.proj() + (size_t)(_b * SEQ + 64 * _n1 + _n2) * INW + C_FX + _cb * 128 + sc); } } while (0)
    int u = F.wg, par = 0;
    if (u < NU) FA_LOAD(u);
    for (; u < NU; u += F.nwg, par ^= 1) {
        const int b = u >> 8, n2 = (u >> 2) & 63, cb = u & 3;
        LAS char* img = Vt + par * 32768;
#pragma unroll
        for (int q = 0; q < 4; ++q) *(LAS bf16x8*)(img + (q >> 1) * 16384 + ff::v_st((q & 1) * 32 + sr, sc)) = pf[q];
        __syncthreads();
        if (u + F.nwg < NU) FA_LOAD(u + F.nwg);
        f32x16 zc[2] = {f32x16{}, f32x16{}}, zs[2] = {f32x16{}, f32x16{}};
#pragma unroll
        for (int t = 0; t < 2; ++t) {
            bf16x8 bc[4], bs[4];
#pragma unroll
            for (int ks = 0; ks < 4; ++ks) { const int o = k1 * 128 + t * 64 + ks * 16 + hi * 8; bc[ks] = *(const bf16x8*)(dc + o); bs[ks] = *(const bf16x8*)(ds + o); }
            const int vb = (int)(uintptr_t)img + t * 16384 + ff::v_rd_base(lane) + chh * 1024;
            ff::xt_two<0>(zc[0], zs[0], vb, bc, bs);
            ff::xt_two<1>(zc[1], zs[1], vb, bc, bs);
        }
        const f32x2 t2 = *(const f32x2*)(F.tw() + (size_t)(k1 * 64 + n2) * 2);
        bf16_t* zp = F.zm() + (size_t)((b * 128 + k1) * 64 + n2) * DM + cb * 128 + 64 * chh + 4 * hi;
#pragma unroll
        for (int dd = 0; dd < 2; ++dd)
#pragma unroll
            for (int g = 0; g < 4; ++g) {
                float p[4], q[4];
#pragma unroll
                for (int j = 0; j < 4; ++j) { const float c = zc[dd][4 * g + j], s = zs[dd][4 * g + j]; p[j] = c * t2.x - s * t2.y; q[j] = c * t2.y + s * t2.x; }
                u32x2 wp, wq; wp.x = cvt_pk_bf16(p[0], p[1]); wp.y = cvt_pk_bf16(p[2], p[3]); wq.x = cvt_pk_bf16(q[0], q[1]); wq.y = cvt_pk_bf16(q[2], q[3]);
                *(u32x2*)(zp + dd * 32 + 8 * g) = wp; *(u32x2*)(zp + 512 + dd * 32 + 8 * g) = wq;
            }
    }
#undef FA_LOAD
    __syncthreads();
}

__device__ __forceinline__ void phase_fft_b(const Frame& F) {
    const int tid = F.tid, wid = F.wid, lane = F.lane, r32 = lane & 31, hi = lane >> 5;
    LAS char* Vt = (LAS char*)F.lds;
    const int sr = tid >> 4, sc = (tid & 15) * 8;
    const int rb = wid & 1, cq = wid >> 1, k2 = 32 * rb + r32;
    const bf16_t* dc = F.dft() + 32768; const bf16_t* ds = dc + 4096; const bf16_t* dn = dc + 8192;
    bf16x8 bc[4], bs[4], bn[4];
#pragma unroll
    for (int ks = 0; ks < 4; ++ks) { const int o = k2 * 64 + ks * 16 + hi * 8; bc[ks] = *(const bf16x8*)(dc + o); bs[ks] = *(const bf16x8*)(ds + o); bn[ks] = *(const bf16x8*)(dn + o); }
    const int NU = NB * 128 * 4;
    bf16x8 pf[4];
#define FB_LOAD(u) do { const int _b = (u) >> 9, _k1 = ((u) >> 2) & 127, _cb = (u) & 3; \
        _Pragma("unroll") for (int _q = 0; _q < 4; ++_q) pf[_q] = *(const bf16x8*)(F.zm() + (size_t)((_b * 128 + _k1) * 64 + (_q & 1) * 32 + sr) * DM + (_q >> 1) * 512 + _cb * 128 + sc); } while (0)
    int u = F.wg, par = 0;
    if (u < NU) FB_LOAD(u);
    for (; u < NU; u += F.nwg, par ^= 1) {
        const int b = u >> 9, k1 = (u >> 2) & 127, cb = u & 3;
        LAS char* img = Vt + par * 32768;
#pragma unroll
        for (int q = 0; q < 4; ++q) *(LAS bf16x8*)(img + (q >> 1) * 16384 + ff::v_st((q & 1) * 32 + sr, sc)) = pf[q];
        __syncthreads();
        if (u + F.nwg < NU) FB_LOAD(u + F.nwg);
        f32x16 ar = f32x16{}, bi = f32x16{};
        const int vbP = (int)(uintptr_t)img + ff::v_rd_base(lane) + cq * 512;
        ff::xt_two<0>(ar, bi, vbP, bc, bs);
        ff::xt_two<0>(ar, bi, vbP + 16384, bn, bc);
        bf16_t* op = F.proj() + (size_t)(b * SEQ + k1 + 128 * k2) * INW + cb * 128 + 32 * cq + 4 * hi;
#pragma unroll
        for (int g = 0; g < 4; ++g) {
            u32x2 wa, wb;
            wa.x = cvt_pk_bf16(ar[4 * g] * 0.011048543456039806f, ar[4 * g + 1] * 0.011048543456039806f); wa.y = cvt_pk_bf16(ar[4 * g + 2] * 0.011048543456039806f, ar[4 * g + 3] * 0.011048543456039806f);
            wb.x = cvt_pk_bf16(bi[4 * g] * 0.011048543456039806f, bi[4 * g + 1] * 0.011048543456039806f); wb.y = cvt_pk_bf16(bi[4 * g + 2] * 0.011048543456039806f, bi[4 * g + 3] * 0.011048543456039806f);
            *(u32x2*)(op + C_K + 8 * g) = wa; *(u32x2*)(op + C_V + 8 * g) = wb;
        }
    }
#undef FB_LOAD
    __syncthreads();
}

__device__ __forceinline__ void phase_ctx_dft(const Frame& F) {
    const int tid = F.tid, wid = F.wid, lane = F.lane, r32 = lane & 31, hi = lane >> 5;
    LAS char* Vt = (LAS char*)F.lds;
    const int sr = tid >> 4, sc = (tid & 15) * 8, np = 32 * wid + r32;
    const bf16_t* dc = F.dft256(); const bf16_t* ds = dc + 65536;
    for (int u = F.wg; u < NB * 4; u += F.nwg) {
        const int b = u >> 2, cb = u & 3;
#pragma unroll
        for (int q = 0; q < 8; ++q) {
            const int key = (q & 1) * 32 + sr, n = (q >> 1) * 64 + key;
            const bf16x8 v = *(const bf16x8*)(F.proj() + (size_t)(TL + b * CTXL + n) * INW + C_FX + cb * 128 + sc);
            *(LAS bf16x8*)(Vt + (q >> 1) * 16384 + ff::v_st(key, sc)) = v;
        }
        __syncthreads();
        bf16_t* op = F.zm() + (size_t)(TL + b * CTXL + np) * DM + cb * 128 + 4 * hi;
#pragma unroll 1
        for (int hf = 0; hf < 2; ++hf) {
            f32x16 ac[2] = {f32x16{}, f32x16{}}, as[2] = {f32x16{}, f32x16{}};
#pragma unroll
            for (int q = 0; q < 4; ++q) {
                bf16x8 bc[4], bs[4];
#pragma unroll
                for (int ks = 0; ks < 4; ++ks) { const int o = np * 256 + q * 64 + ks * 16 + hi * 8; bc[ks] = *(const bf16x8*)(dc + o); bs[ks] = *(const bf16x8*)(ds + o); }
                const int vb = (int)(uintptr_t)Vt + q * 16384 + ff::v_rd_base(lane) + hf * 1024;
                ff::xt_two<0>(ac[0], as[0], vb, bc, bs); ff::xt_two<1>(ac[1], as[1], vb, bc, bs);
            }
#pragma unroll
            for (int dd = 0; dd < 2; ++dd)
#pragma unroll
                for (int g = 0; g < 4; ++g) {
                    u32x2 wa, wb;
                    wa.x = cvt_pk_bf16(ac[dd][4 * g] * 0.0625f, ac[dd][4 * g + 1] * 0.0625f); wa.y = cvt_pk_bf16(ac[dd][4 * g + 2] * 0.0625f, ac[dd][4 * g + 3] * 0.0625f);
                    wb.x = cvt_pk_bf16(as[dd][4 * g] * 0.0625f, as[dd][4 * g + 1] * 0.0625f); wb.y = cvt_pk_bf16(as[dd][4 * g + 2] * 0.0625f, as[dd][4 * g + 3] * 0.0625f);
                    *(u32x2*)(op + 64 * hf + 32 * dd + 8 * g) = wa; *(u32x2*)(op + 512 + 64 * hf + 32 * dd + 8 * g) = wb;
                }
        }
        __syncthreads();
    }
}

__device__ __forceinline__ int moe_rows_per_wg(int nrows, int nwg) { return (nrows + nwg - 1) / nwg; }
__device__ __forceinline__ void phase_norm2_route(const Frame& F, const Params& P, int l, int nrows, long long dctx) {
    constexpr int WROW = 1024 + 8;
    LAS bf16_t* whi = (LAS bf16_t*)F.lds; LAS bf16_t* wlo = whi + 32 * WROW;
    LAS int* hist = (LAS int*)(F.lds + 2 * 32 * WROW * 2);
    const float* wr = P.w_router + (size_t)l * DM * NEXP;
    for (int i = F.tid; i < DM * NEXP; i += NTHR) {
        const int d = i >> 5, e = i & 31; const float w = wr[i]; const bf16_t h = f2bf(w);
        whi[e * WROW + d] = h; wlo[e * WROW + d] = f2bf(w - bf2f(h));
    }
    if (F.tid < 32) hist[F.tid] = 0;
    const float* g = P.g_norm2 + l * DM;
    const int per = moe_rows_per_wg(nrows, F.nwg), r0 = F.wg * per, r1 = min(nrows, r0 + per);
    bf16_t* LO = F.proj();
    for (int rowA = r0 + F.wid; rowA < r1; rowA += 16) {
        const int rowB = rowA + 8; const bool hasB = rowB < r1; const int rowBs = hasB ? rowB : rowA;
        const float* xa = xrow_ptr(P.out, dctx, rowA); const float* xb = xrow_ptr(P.out, dctx, rowBs);
        f32x4 va[4], vb[4]; float sa = 0.f, sb = 0.f;
#pragma unroll
        for (int j = 0; j < 4; ++j) { va[j] = *(const f32x4*)(xa + F.lane * 4 + 256 * j); vb[j] = *(const f32x4*)(xb + F.lane * 4 + 256 * j); }
#pragma unroll
        for (int j = 0; j < 4; ++j) { sa += va[j][0] * va[j][0] + va[j][1] * va[j][1] + va[j][2] * va[j][2] + va[j][3] * va[j][3]; sb += vb[j][0] * vb[j][0] + vb[j][1] * vb[j][1] + vb[j][2] * vb[j][2] + vb[j][3] * vb[j][3]; }
        sa = wave_sum(sa); sb = wave_sum(sb);
        const float ra = rsqrtf(sa * (1.f / 1024.f) + EPS), rb = rsqrtf(sb * (1.f / 1024.f) + EPS);
        const float* mda = F.mods() + (size_t)(l * 9 + (rowA < TL ? (rowA >> 13) : 8)) * 6144;
        const float* mdb = F.mods() + (size_t)(l * 9 + (rowBs < TL ? (rowBs >> 13) : 8)) * 6144;
#pragma unroll
        for (int j = 0; j < 4; ++j) {
            const int col = F.lane * 4 + 256 * j;
            const f32x4 gg = *(const f32x4*)(g + col);
            const f32x4 sha = *(const f32x4*)(mda + 3 * 1024 + col), sca = *(const f32x4*)(mda + 4 * 1024 + col);
            const f32x4 shb = *(const f32x4*)(mdb + 3 * 1024 + col), scb = *(const f32x4*)(mdb + 4 * 1024 + col);
            float oa[4], ob[4];
#pragma unroll
            for (int i = 0; i < 4; ++i) { oa[i] = va[j][i] * ra * gg[i] * (1.f + sca[i]) + sha[i]; ob[i] = vb[j][i] * rb * gg[i] * (1.f + scb[i]) + shb[i]; }
            u32x2 ha, hb, la, lb;
            ha.x = cvt_pk_bf16(oa[0], oa[1]); ha.y = cvt_pk_bf16(oa[2], oa[3]); hb.x = cvt_pk_bf16(ob[0], ob[1]); hb.y = cvt_pk_bf16(ob[2], ob[3]);
            la.x = cvt_pk_bf16(oa[0] - bf_lo(ha.x), oa[1] - bf_hi(ha.x)); la.y = cvt_pk_bf16(oa[2] - bf_lo(ha.y), oa[3] - bf_hi(ha.y));
            lb.x = cvt_pk_bf16(ob[0] - bf_lo(hb.x), ob[1] - bf_hi(hb.x)); lb.y = cvt_pk_bf16(ob[2] - bf_lo(hb.y), ob[3] - bf_hi(hb.y));
            *(u32x2*)(F.H() + (size_t)rowA * DM + col) = ha; *(u32x2*)(LO + (size_t)rowA * DM + col) = la;
            if (hasB) { *(u32x2*)(F.H() + (size_t)rowB * DM + col) = hb; *(u32x2*)(LO + (size_t)rowB * DM + col) = lb; }
        }
    }
    asm volatile("s_waitcnt vmcnt(0)" ::: "memory");
    __syncthreads();
    const int r32 = F.lane & 31, hi = F.lane >> 5;
    const float bias = P.b_router[l * NEXP + r32];
    const int ntile = (r1 - r0 + 31) >> 5;
    for (int t = F.wid; t < ntile; t += 8) {
        const int rowbase = r0 + t * 32, myrow = min(rowbase + r32, r1 - 1);
        const bf16_t* ph = F.H() + (size_t)myrow * DM + hi * 8; const bf16_t* pl = LO + (size_t)myrow * DM + hi * 8;
        const LAS bf16_t* bh = whi + r32 * WROW + hi * 8; const LAS bf16_t* bl = wlo + r32 * WROW + hi * 8;
        f32x16 acc = f32x16{};
        bf16x8 ahA[8], alA[8], ahB[8], alB[8];
#pragma unroll
        for (int q = 0; q < 8; ++q) { ahA[q] = *(const bf16x8*)(ph + q * 16); alA[q] = *(const bf16x8*)(pl + q * 16); }
#pragma unroll
        for (int bt = 0; bt < 8; bt += 2) {
#pragma unroll
            for (int q = 0; q < 8; ++q) { ahB[q] = *(const bf16x8*)(ph + ((bt + 1) * 8 + q) * 16); alB[q] = *(const bf16x8*)(pl + ((bt + 1) * 8 + q) * 16); }
#pragma unroll
            for (int q = 0; q < 8; ++q) { const int ks = bt * 8 + q;
                const bf16x8 wh = *(const LAS bf16x8*)(bh + ks * 16), wl = *(const LAS bf16x8*)(bl + ks * 16);
                acc = __builtin_amdgcn_mfma_f32_32x32x16_bf16(ahA[q], wh, acc, 0, 0, 0); acc = __builtin_amdgcn_mfma_f32_32x32x16_bf16(ahA[q], wl, acc, 0, 0, 0); acc = __builtin_amdgcn_mfma_f32_32x32x16_bf16(alA[q], wh, acc, 0, 0, 0); }
            if (bt + 2 < 8) {
#pragma unroll
                for (int q = 0; q < 8; ++q) { ahA[q] = *(const bf16x8*)(ph + ((bt + 2) * 8 + q) * 16); alA[q] = *(const bf16x8*)(pl + ((bt + 2) * 8 + q) * 16); }
            }
#pragma unroll
            for (int q = 0; q < 8; ++q) { const int ks = (bt + 1) * 8 + q;
                const bf16x8 wh = *(const LAS bf16x8*)(bh + ks * 16), wl = *(const LAS bf16x8*)(bl + ks * 16);
                acc = __builtin_amdgcn_mfma_f32_32x32x16_bf16(ahB[q], wh, acc, 0, 0, 0); acc = __builtin_amdgcn_mfma_f32_32x32x16_bf16(ahB[q], wl, acc, 0, 0, 0); acc = __builtin_amdgcn_mfma_f32_32x32x16_bf16(alB[q], wh, acc, 0, 0, 0); }
        }
#pragma unroll
        for (int r = 0; r < 16; ++r) {
            float v = acc[r] + bias;
            float tv[4]; int ti[4];
#pragma unroll
            for (int k = 0; k < 4; ++k) {
                float bv = v; int bi = r32;
#define RT_STEP(CTRL) do { const float ov = dpp_f<CTRL>(bv); const int oi = dpp_i<CTRL>(bi); const bool take = (ov > bv) || (ov == bv && oi < bi); bv = take ? ov : bv; bi = take ? oi : bi; } while (0)
                RT_STEP(DPP_X1); RT_STEP(DPP_X2); RT_STEP(DPP_HMIR); RT_STEP(DPP_MIR);
#undef RT_STEP
                {
                    const auto rv = __builtin_amdgcn_permlane16_swap(__float_as_uint(bv), __float_as_uint(bv), false, false);
                    const auto ri = __builtin_amdgcn_permlane16_swap((unsigned)bi, (unsigned)bi, false, false);
                    const float v0 = __uint_as_float(rv[0]), v1 = __uint_as_float(rv[1]); const int i0 = (int)ri[0], i1 = (int)ri[1];
                    const bool take1 = (v1 > v0) || (v1 == v0 && i1 < i0);
                    bv = take1 ? v1 : v0; bi = take1 ? i1 : i0;
                }
                tv[k] = bv; ti[k] = bi;
                v = (r32 == bi) ? -3.0e38f : v;
            }
            const int row = rowbase + at::crow(r, hi);
            if (r32 == r && row < r1) {
                float w4[4], den = 0.f;
#pragma unroll
                for (int k = 0; k < 4; ++k) { w4[k] = __expf(tv[k] - tv[0]); den += w4[k]; }
                const float inv = 1.f / den;
#pragma unroll
                for (int k = 0; k < 4; ++k) {
                    F.sele()[(size_t)row * 4 + k] = ti[k]; F.selw()[(size_t)row * 4 + k] = w4[k] * inv;
                    __hip_atomic_fetch_add(&hist[ti[k]], 1, __ATOMIC_RELAXED, __HIP_MEMORY_SCOPE_WORKGROUP);
                }
            }
        }
    }
    __syncthreads();
    if (F.tid < 32) F.cntw()[F.wg * 32 + F.tid] = hist[F.tid];
    __syncthreads();
}

__device__ __forceinline__ LAS int* moe_tb(const Frame& F) { return (LAS int*)(F.lds + LDS_MISC + 64); }
__device__ __forceinline__ void moe_sum_counts(const Frame& F, LAS int* tot, LAS int* pre, LAS int* scratch) {
    const int e = F.tid & 31, q = F.tid >> 5;
    int st = 0, sp = 0;
    for (int w = q; w < F.nwg; w += 16) { const int c = F.cntw()[w * 32 + e]; st += c; sp += (w < F.wg) ? c : 0; }
    scratch[q * 32 + e] = st; scratch[512 + q * 32 + e] = sp;
    __syncthreads();
    if (F.tid < 32) { int a = 0, b = 0;
        for (int k = 0; k < 16; ++k) { a += scratch[k * 32 + F.tid]; b += scratch[512 + k * 32 + F.tid]; }
        tot[F.tid] = a; pre[F.tid] = b; }
    __syncthreads();
}
__device__ __forceinline__ void moe_build_tb(const Frame& F) {
    LAS int* tb = moe_tb(F); LAS int* tot = tb + 40; LAS int* pre = tb + 80; LAS int* scratch = (LAS int*)F.lds;
    moe_sum_counts(F, tot, pre, scratch);
    if (F.tid == 0) { int acc = 0; tb[0] = 0; for (int e = 0; e < 32; ++e) { acc += (tot[e] + 255) >> 8; tb[e + 1] = acc; } }
    __syncthreads();
}
__device__ __forceinline__ void phase_positions(const Frame& F, int l, int nrows) {
    LAS int* tb = moe_tb(F); LAS int* tot = tb + 40; LAS int* pre = tb + 80;
    LAS int* rank = (LAS int*)(F.lds + 8192);
    moe_build_tb(F);
    if (F.tid < 32) rank[F.tid] = 0;
    __syncthreads();
    const int per = moe_rows_per_wg(nrows, F.nwg), r0 = F.wg * per, r1 = min(nrows, r0 + per);
    for (int i = r0 * 4 + F.tid; i < r1 * 4; i += NTHR) {
        const int e = F.sele()[i], r = __hip_atomic_fetch_add(&rank[e], 1, __ATOMIC_RELAXED, __HIP_MEMORY_SCOPE_WORKGROUP);
        const int pos = tb[e] * 256 + pre[e] + r;
        F.rtok()[pos] = i; F.rw()[pos] = F.selw()[i];
    }
    for (int e = F.wg; e < 32; e += F.nwg) {
        const int base = tb[e] * 256 + tot[e], end = tb[e + 1] * 256;
        for (int p = base + F.tid; p < end; p += NTHR) { F.rtok()[p] = -1; F.rw()[p] = 0.f; }
    }
    __syncthreads();
}

constexpr int NPHL = 11;
constexpr int NPHASE = 1 + 2 * NPHL + 1;

__device__ __forceinline__ void launder(Frame& F) { int t = threadIdx.x; asm volatile("" : "+v"(t)); F.tid = t; F.lane = t & 63; F.wid = __builtin_amdgcn_readfirstlane(t >> 6);
    unsigned long long w = (unsigned long long)F.ws; asm volatile("" : "+s"(w)); F.ws = (unsigned char*)(__attribute__((address_space(1))) unsigned char*)w; }
__global__ void __launch_bounds__(NTHR, 2) fwd_kernel(Params prm) {
    extern __shared__ __attribute__((aligned(16))) unsigned char lds_raw[];
    Frame F;
    const Params& P = prm;
    F.tid = threadIdx.x; F.lane = F.tid & 63; F.wid = __builtin_amdgcn_readfirstlane(F.tid >> 6); F.wg = blockIdx.x; F.nwg = gridDim.x;
    F.lds = (LAS unsigned char*)lds_raw;
    F.ws = prm.ws;

    volatile LAS unsigned* misc = (volatile LAS unsigned*)(F.lds + LDS_MISC);
    if (F.tid < 16) misc[F.tid] = 0u;
    __syncthreads();
    const int lo = prm.ph_lo, hi = prm.ph_hi;
    XcdBarrier bar; bar.bar = F.ctl() + CW_BAR; bar.x = 0; bar.st = misc;
    if (hi - lo > 1) bar = xcd_barrier_post(F.ctl() + CW_BAR, misc);
#ifndef PH_MASK
#define PH_MASK 0xFFF
#endif
#define EN(g) (((PH_MASK) >> (g)) & 1)
#define IN(k) (lo <= (k) && (k) < hi)
#ifdef PROBE_DOUBLE_BARRIER
#define SEAM(k) do { if (IN((k) + 1)) { xcd_barrier(bar); xcd_barrier(bar); } } while (0)
#else
#define SEAM(k) do { if (IN((k) + 1)) xcd_barrier(bar); } while (0)
#endif
#ifdef PROBE_MASK
#define PB_BEGIN(id) unsigned long long _pt0_##id = (((PROBE_MASK) >> (id)) & 1) ? __builtin_amdgcn_s_memrealtime() : 0ull
#define PB_END(id) do { if (((PROBE_MASK) >> (id)) & 1) { __syncthreads(); const unsigned long long _t1 = __builtin_amdgcn_s_memrealtime(), _w = (_t1 - _pt0_##id) * (PROBE_MUL); \
        while (__builtin_amdgcn_s_memrealtime() - _t1 < _w) __builtin_amdgcn_s_sleep(8); } } while (0)
#else
#define PB_BEGIN(id) do {} while (0)
#define PB_END(id) do {} while (0)
#endif

    if (EN(0) && IN(0)) { PB_BEGIN(0); launder(F); p0_prologue(F, P); PB_END(0); SEAM(0); }

    for (int l = 0; l < NLAYER; ++l) {
        const int PB = 1 + l * NPHL;
        const int nrows = (l == 0) ? TA : TL;
        const float* modl = F.mods() + (size_t)l * 9 * 6144;
        const int cx = (F.nwg % 8 == 0) ? (F.wg & 7) * (F.nwg / 8) + (F.wg >> 3) : F.wg;
        const float* xs = (l == 0) ? prm.x : prm.out;
        const long long dxs = (long long)(F.ctxb() - xs) - (long long)TL * DM;
        const long long dout = (long long)(F.ctxb() - prm.out) - (long long)TL * DM;
        const long long dcin = (l == 0) ? (long long)(prm.ctx - xs) - (long long)TL * DM : dxs;
        if (EN(1) && IN(PB + 0)) { PB_BEGIN(1); launder(F); phase_norm1(F, P, l, xs, dxs, l > 0, prm.out, dout); PB_END(1); SEAM(PB + 0); }
        if (EN(2) && IN(PB + 1)) {
            SchedProj S{(const char*)F.H(), (const char*)(F.win() + (size_t)l * INW * DM), (const char*)(F.wgate() + (size_t)l * INW * DM), l, F.nwg, F.wg};
            EpiProj E{F.proj(), F.rope(), F.g8(), prm.b_mgate + l * INW};
#ifdef DRY_GEMM1
            { EpiDry ED{F.proj()}; SchedProjDry SD{S}; gm::gemm_phase<true>(F.lds, SD, ED); }
#endif
            PB_BEGIN(2); gm::gemm_phase<true>(F.lds, S, E); PB_END(2);
            SEAM(PB + 1);
        }
        if (EN(3) && IN(PB + 2)) {
#ifndef SUB3
#define SUB3 15
#endif
            PB_BEGIN(3); launder(F); if (SUB3 & 1) phase_conv(F, P, l, nrows); launder(F); PB_END(3); PB_BEGIN(4);
            if (SUB3 & 2) phase_fft_a(F);
            launder(F); if ((SUB3 & 4) && l == 0) phase_ctx_dft(F); launder(F); PB_END(4); PB_BEGIN(5);
            if (SUB3 & 8) phase_attn(F, P, l);
            PB_END(5);
            SEAM(PB + 2);
        }
        if (EN(4) && IN(PB + 3)) {
            PB_BEGIN(6); launder(F); phase_fft_b(F); PB_END(6);
            PB_BEGIN(7); launder(F); phase_pool(F, nrows);
            launder(F); if (l == 0) phase_ctx_dft_copy(F); PB_END(7);
            SEAM(PB + 3);
        }
        if (EN(5) && IN(PB + 4)) {
            const bool split0 = (l == 0) && (F.nwg == 256);
            SchedMerge S{(const char*)F.proj(), (const char*)(F.wbr() + (size_t)l * DM * WBR_K), ((l == 0 && !split0) ? 264 : 256) * 4, F.nwg, F.wg, false};
            EpiMerge E{F.g8(), F.zm()};
            PB_BEGIN(8); gm::gemm_phase<true>(F.lds, S, E); PB_END(8);
            SEAM(PB + 4);
        }
        if (EN(6) && IN(PB + 5)) {
            const bool split0 = (l == 0) && (F.nwg == 256);
            EpiOut E{xs, prm.out, dcin, dout, modl};
            if (split0) {
                { SchedMerge SM{(const char*)F.proj(), (const char*)(F.wbr() + (size_t)l * DM * WBR_K), 0, F.nwg, F.wg, true};
                  EpiMerge EM{F.g8(), F.zm()};
                  gm::gemm_phase<true>(F.lds, SM, EM);
                  asm volatile("s_waitcnt vmcnt(0)" ::: "memory");
                  __syncthreads();
                  if (F.tid == 0 && F.wg < 32) { __builtin_amdgcn_fence(__ATOMIC_RELEASE, "agent"); (void)xb_add(F.ctl() + CW_CTXM, 1u); } }
            }
            { SchedOut S{(const char*)F.zm(), (const char*)(F.wout() + (size_t)l * DM * DM), (l == 0 ? 264 : 256) * 4, F.nwg, F.wg, split0 ? 1 : 0};
              PB_BEGIN(9); gm::gemm_phase<false>(F.lds, S, E); PB_END(9); }
            if (split0) {
                if (F.tid == 0 && F.wg >= 96 && F.wg < 128) { unsigned* barw = F.ctl() + CW_BAR; XB_SPIN(xb_ld(F.ctl() + CW_CTXM) < 32u, barw); __builtin_amdgcn_fence(__ATOMIC_ACQUIRE, "agent"); }
                __syncthreads();
                SchedOut SC{(const char*)F.zm(), (const char*)(F.wout() + (size_t)l * DM * DM), 0, F.nwg, F.wg, 2};
                gm::gemm_phase<false>(F.lds, SC, E);
            }
            SEAM(PB + 5);
        }
        if (EN(7) && IN(PB + 6)) {
            PB_BEGIN(11); launder(F); phase_norm2_route(F, P, l, nrows, dout); PB_END(11);
            asm volatile("s_waitcnt vmcnt(0)" ::: "memory");
            __syncthreads();
            if (F.tid == 0) { __builtin_amdgcn_fence(__ATOMIC_RELEASE, "agent"); (void)xb_add(F.ctl() + CW_ROUTED + l * 64, 1u); }
            PB_BEGIN(10); launder(F); cvt_experts(F, P, l); PB_END(10);
            if (F.tid == 0) { unsigned* barw = F.ctl() + CW_BAR; XB_SPIN(xb_ld(F.ctl() + CW_ROUTED + l * 64) < (unsigned)F.nwg, barw); __builtin_amdgcn_fence(__ATOMIC_ACQUIRE, "agent"); }
            __syncthreads();
            PB_BEGIN(12); launder(F); phase_positions(F, l, nrows); PB_END(12);
            SEAM(PB + 6);
        }
        if (EN(9) && IN(PB + 8)) {
            launder(F); moe_build_tb(F);
            const int G = F.nwg, c = (G % 8 == 0) ? (F.wg & 7) * (G / 8) + (F.wg >> 3) : F.wg;
            const int nfull = (moe_tb(F)[32] / G) * G, nrem8 = (moe_tb(F)[32] - nfull) * 8;
            unsigned* gudone = F.ctl() + CW_GUDONE + l * 64;
            {
                SchedMoeSplit<true> S2{(const char*)F.H(), (const char*)F.gu(), F.rtok(), moe_tb(F), nfull, G, F.wg};
                EpiMoe E2{(char*)F.acts2(), prm.b_e_gate + (size_t)l * NEXP * DM, prm.b_e_up + (size_t)l * NEXP * DM, prm.b_e_down + (size_t)l * NEXP * DM, F.rtok(), F.rw(), F.Y(), false};
                PB_BEGIN(14); gm::gemm_phase<true>(F.lds, S2, E2); PB_END(14);
                asm volatile("s_waitcnt vmcnt(0)" ::: "memory");
                __syncthreads();
                if (F.tid == 0) {
                    const int mine = (nrem8 > F.wg) ? (nrem8 - F.wg + G - 1) / G : 0;
                    if (mine > 0) { __builtin_amdgcn_fence(__ATOMIC_RELEASE, "agent"); (void)xb_add(gudone, (unsigned)mine); }
                }
            }
            {
                SchedMoeFused S{(const char*)F.H(), (const char*)F.gu(), (const char*)F.dn(), (const char*)F.acts(), F.rtok(), moe_tb(F), nfull, G, c, (unsigned)F.wg * (256u * 2048u)};
                EpiMoe E{(char*)F.acts(), prm.b_e_gate + (size_t)l * NEXP * DM, prm.b_e_up + (size_t)l * NEXP * DM, prm.b_e_down + (size_t)l * NEXP * DM, F.rtok(), F.rw(), F.Y(), true};
                PB_BEGIN(13); gm::gemm_phase<true>(F.lds, S, E); PB_END(13);
            }
            {
                if (F.tid == 0) {
                    unsigned* barw = F.ctl() + CW_BAR;
                    XB_SPIN(xb_ld(gudone) < (unsigned)nrem8, barw);
                    __builtin_amdgcn_fence(__ATOMIC_ACQUIRE, "agent");
                }
                __syncthreads();
                SchedMoeSplit<false> S3{(const char*)F.acts2(), (const char*)F.dn(), F.rtok(), moe_tb(F), nfull, G, G - 1 - F.wg};
                EpiMoe E3{(char*)F.acts(), prm.b_e_gate + (size_t)l * NEXP * DM, prm.b_e_up + (size_t)l * NEXP * DM, prm.b_e_down + (size_t)l * NEXP * DM, F.rtok(), F.rw(), F.Y(), false};
                PB_BEGIN(14); gm::gemm_phase<true>(F.lds, S3, E3); PB_END(14);
            }
            SEAM(PB + 8);
        }
    }
    if (EN(11) && IN(NPHASE - 1)) { PB_BEGIN(15); launder(F); phase_final(F, P); PB_END(15); }
#undef IN
#undef SEAM
}

#ifndef N_LAUNCH_MODE
#define N_LAUNCH_MODE 0
#endif
extern "C" void kernel_launch(void* const* d_in, const int* in_sizes, int n_in, void* d_out, int out_size, void* d_ws, size_t ws_size, hipStream_t stream) {
    static int grid = 0;
    if (grid == 0) {
        if (n_in != 27 || out_size != TL * DM || ws_size < WS_END) { fprintf(stderr, "kernel_launch: unexpected shapes (n_in %d out %d ws %zu need %zu)\n", n_in, out_size, ws_size, (size_t)WS_END); grid = -1; return; }
        int dev = 0, cus = 0, per_cu = 0;
        if (hipGetDevice(&dev) != hipSuccess || hipDeviceGetAttribute(&cus, hipDeviceAttributeMultiprocessorCount, dev) != hipSuccess) { grid = -1; return; }
        if (hipFuncSetAttribute((const void*)fwd_kernel, hipFuncAttributeMaxDynamicSharedMemorySize, LDS_BYTES) != hipSuccess) { fprintf(stderr, "kernel_launch: hipFuncSetAttribute failed\n"); grid = -1; return; }
        if (hipOccupancyMaxActiveBlocksPerMultiprocessor(&per_cu, (const void*)fwd_kernel, NTHR, LDS_BYTES) != hipSuccess || per_cu < 1) { fprintf(stderr, "kernel_launch: occupancy query says %d\n", per_cu); }
        (void)hipGetLastError();
        grid = cus;
    }
    if (grid < 0) return;
    (void)hipMemsetAsync((char*)d_ws + WS_CTL, 0, CTL_BYTES, stream);
    Params p{};
    const float** pf = (const float**)&p;
    for (int i = 0; i < 27; ++i) pf[i] = (const float*)d_in[i];
    p.out = (float*)d_out; p.ws = (unsigned char*)d_ws;
#if N_LAUNCH_MODE == 0
    p.ph_lo = 0; p.ph_hi = NPHASE;
    hipLaunchKernelGGL(fwd_kernel, dim3(grid), dim3(NTHR), LDS_BYTES, stream, p);
#else
    for (int ph = 0; ph < NPHASE; ++ph) { p.ph_lo = ph; p.ph_hi = ph + 1; hipLaunchKernelGGL(fwd_kernel, dim3(grid), dim3(NTHR), LDS_BYTES, stream, p); }
#endif
    const hipError_t le = hipPeekAtLastError();
    if (le != hipSuccess) fprintf(stderr, "kernel_launch: launch failed: %s\n", hipGetErrorName(le));
}
```
